# Optimizing an MI355X kernel written in HIP

```python
import math
import jax, jax.numpy as jnp
from jax import lax
import numpy as np

D_MODEL = 1024
BATCH = 8
SEQ = 4096
DEPTH = 2
DEC_BATCH = 8
DEC_SEQ = 64
PAST_LEN = 1024

CHUNK = 64
D_MIX = D_MODEL
D_A = D_MIX // 2
DK_A = 128
DV_A = 128
H_A = D_A // DV_A
A_CONV = 4
D_B = D_MIX // 4
B_BLOCKS = 4
B_BW = D_B // B_BLOCKS
B_CONV = 4
RG_C = 8.0
D_C = D_MIX - D_A - D_B
H_C = 4
DK_C = D_C // H_C
DV_C = D_C // H_C
N_MEM = 256
MEM_HEADS = 4
MEM_HEAD_DIM = D_MODEL // MEM_HEADS
D_FF = 2816
FFN_CONV = 3
RMS_EPS = 1e-6
IN_SIZES = (3 * D_A, D_A, H_A, H_A, D_B, D_B, H_C * DK_C, H_C * DK_C, D_C, D_C)
N_IN = sum(IN_SIZES)

kernel_name = "hybrid_gdn_rglru_hgrn2_stream_step"


def rmsnorm(x, w):
    xf = x.astype(jnp.float32)
    y = xf * lax.rsqrt(jnp.mean(xf * xf, axis=-1, keepdims=True) + RMS_EPS)
    return (y * w.astype(jnp.float32)).astype(x.dtype)


def l2norm(x):
    xf = x.astype(jnp.float32)
    return xf * lax.rsqrt(jnp.sum(xf * xf, axis=-1, keepdims=True) + 1e-6)


def causal_dwconv(x, prev, w):
    width, length = w.shape[0], x.shape[1]
    xp = jnp.concatenate([prev.astype(x.dtype), x], axis=1)
    y = xp[:, 0:length] * w[0]
    for j in range(1, width):
        y = y + xp[:, j:j + length] * w[j]
    return y, xp[:, length:]


def to_chunks(t, c):
    b, l = t.shape[:2]
    t = t.reshape((b, l // c, c) + t.shape[2:])
    return jnp.moveaxis(jnp.moveaxis(t, 1, 0), 2, 3)


def from_chunks(t):
    t = jnp.moveaxis(jnp.moveaxis(t, 3, 2), 0, 1)
    return t.reshape((t.shape[0], t.shape[1] * t.shape[2]) + t.shape[3:])


def gated_delta_rule(q, k, v, g, beta, s0):
    c = math.gcd(q.shape[1], CHUNK)
    q, k, v = to_chunks(q, c), to_chunks(k, c), to_chunks(v, c)
    g, beta = to_chunks(g, c), to_chunks(beta, c)
    incl = jnp.tril(jnp.ones((c, c), dtype=bool))
    strict = jnp.tril(jnp.ones((c, c), dtype=bool), -1)
    gcum = jnp.cumsum(g, axis=-1)
    gamma = jnp.exp(jnp.where(incl, gcum[..., :, None] - gcum[..., None, :], -jnp.inf))
    kk = jnp.einsum('nbhid,nbhjd->nbhij', k, k)
    m = jnp.eye(c, dtype=q.dtype) + jnp.where(strict, beta[..., :, None] * kk * gamma, 0.0)
    rhs = jnp.concatenate([v * beta[..., None], k * (beta * jnp.exp(gcum))[..., None]], axis=-1)
    sol = lax.linalg.triangular_solve(m, rhs, left_side=True, lower=True, unit_diagonal=True)
    dv = v.shape[-1]
    u, w = sol[..., :dv], sol[..., dv:]
    qk = jnp.einsum('nbhid,nbhjd->nbhij', q, k) * gamma
    q_dec = q * jnp.exp(gcum)[..., None]
    k_dec = k * jnp.exp(gcum[..., -1:] - gcum)[..., None]
    g_last = jnp.exp(gcum[..., -1])

    def step(s, inp):
        u_c, w_c, qk_c, qd_c, kd_c, gl_c = inp
        v_new = u_c - jnp.einsum('bhcd,bhdv->bhcv', w_c, s)
        o = jnp.einsum('bhcd,bhdv->bhcv', qd_c, s) + jnp.einsum('bhij,bhjv->bhiv', qk_c, v_new)
        s = gl_c[..., None, None] * s + jnp.einsum('bhcd,bhcv->bhdv', kd_c, v_new)
        return s, o

    s_last, o = lax.scan(step, s0, (u, w, qk, q_dec, k_dec, g_last))
    return from_chunks(o), s_last


def hgrn2_recurrence(q, k, v, log_f, s0):
    c = math.gcd(q.shape[1], CHUNK)
    q, k, v, log_f = [to_chunks(t, c) for t in (q, k, v, log_f)]
    incl = jnp.tril(jnp.ones((c, c), dtype=bool))

    def step(s, inp):
        q_c, k_c, v_c, lf_c = inp
        bc = jnp.cumsum(lf_c, axis=2)
        decay = jnp.exp(jnp.where(incl[..., None], bc[:, :, :, None, :] - bc[:, :, None, :, :], -jnp.inf))
        att = jnp.einsum('bhid,bhjd,bhijd->bhij', q_c, k_c, decay)
        o = jnp.einsum('bhij,bhjv->bhiv', att, v_c) + jnp.einsum('bhid,bhdv->bhiv', q_c * jnp.exp(bc), s)
        b_last = bc[:, :, -1:, :]
        s = jnp.exp(b_last[:, :, 0, :])[..., None] * s + jnp.einsum('bhjd,bhjv->bhdv', k_c * jnp.exp(b_last - bc), v_c)
        return s, o

    s_last, o = lax.scan(step, s0, (q, k, v, log_f))
    return from_chunks(o), s_last


def rg_lru_scan(a, u, h0):
    u = u.at[:, 0].add(a[:, 0] * h0)

    def combine(left, right):
        return left[0] * right[0], right[0] * left[1] + right[1]

    _, h = lax.associative_scan(combine, (a, u), axis=1)
    return h, h[:, -1]


def mixing_block(h, a_conv_prev, a_s, b_conv_prev, b_h, c_s,
                 w_in, a_conv_w, a_A_log, a_dt_bias, a_norm,
                 b_conv_w, b_conv_b, b_w_r, b_b_r, b_w_i, b_b_i, b_lambda,
                 c_lb, c_norm, w_out):
    bsz, length, _ = h.shape
    f32 = jnp.float32
    dt = h.dtype
    proj = h @ w_in
    splits = np.cumsum(IN_SIZES)[:-1].tolist()
    a_qkv, a_z, a_b, a_a, b_x, b_gate, c_q, c_f, c_i, c_g = jnp.split(proj, splits, axis=-1)

    qkv, a_conv_new = causal_dwconv(a_qkv, a_conv_prev, a_conv_w)
    qkv = jax.nn.silu(qkv)
    q, k, v = [t.reshape(bsz, length, H_A, -1) for t in jnp.split(qkv, 3, axis=-1)]
    q = l2norm(q) * (DK_A ** -0.5)
    k = l2norm(k)
    beta = jax.nn.sigmoid(a_b.astype(f32))
    g = -jnp.exp(a_A_log.astype(f32)) * jax.nn.softplus(a_a.astype(f32) + a_dt_bias.astype(f32))
    o_a, a_s_new = gated_delta_rule(q, k, v.astype(f32), g, beta, a_s.astype(f32))
    o_a = rmsnorm(o_a, a_norm) * jax.nn.silu(a_z.astype(f32).reshape(bsz, length, H_A, DV_A))
    o_a = o_a.reshape(bsz, length, D_A).astype(dt)

    xb, b_conv_new = causal_dwconv(b_x, b_conv_prev, b_conv_w)
    xb = (xb + b_conv_b).astype(f32)
    xblk = xb.reshape(bsz, length, B_BLOCKS, B_BW)
    r = jax.nn.sigmoid(jnp.einsum('blni,nij->blnj', xblk, b_w_r.astype(f32)).reshape(bsz, length, D_B) + b_b_r)
    i_gate = jax.nn.sigmoid(jnp.einsum('blni,nij->blnj', xblk, b_w_i.astype(f32)).reshape(bsz, length, D_B) + b_b_i)
    log_a = -RG_C * r * jax.nn.softplus(-b_lambda.astype(f32))
    mult = jnp.sqrt(jnp.maximum(-jnp.expm1(2.0 * log_a), 0.0))
    hb, b_h_new = rg_lru_scan(jnp.exp(log_a), mult * i_gate * xb, b_h.astype(f32))
    y_b = (hb * jax.nn.gelu(b_gate.astype(f32))).astype(dt)

    q_c = jax.nn.silu(c_q.astype(f32)).reshape(bsz, length, H_C, DK_C)
    lb = c_lb.reshape(H_C, DK_C)
    forget = lb + (1.0 - lb) * jax.nn.sigmoid(c_f.astype(f32).reshape(bsz, length, H_C, DK_C))
    v_c = c_i.astype(f32).reshape(bsz, length, H_C, DV_C)
    o_c, c_s_new = hgrn2_recurrence(q_c, 1.0 - forget, v_c, jnp.log(forget), c_s.astype(f32))
    o_c = rmsnorm(o_c, c_norm) * jax.nn.silu(c_g.astype(f32).reshape(bsz, length, H_C, DV_C))
    o_c = o_c.reshape(bsz, length, D_C).astype(dt)

    out = jnp.concatenate([o_a, y_b, o_c], axis=-1) @ w_out
    return out, (a_conv_new, a_s_new.astype(dt), b_conv_new, b_h_new.astype(dt), c_s_new.astype(dt))


def memory_kv(mem, norm_mem, w_k, w_v):
    bsz = mem.shape[0]
    mn = rmsnorm(mem, norm_mem)
    k = (mn @ w_k).reshape(bsz, -1, MEM_HEADS, MEM_HEAD_DIM)
    v = (mn @ w_v).reshape(bsz, -1, MEM_HEADS, MEM_HEAD_DIM)
    return k, v


def memory_cross_attention(h, mem_k, mem_v, w_q, w_o):
    bsz, length, _ = h.shape
    q = (h @ w_q).reshape(bsz, length, MEM_HEADS, MEM_HEAD_DIM)
    s = jnp.einsum('blhd,bmhd->bhlm', q, mem_k).astype(jnp.float32) * (MEM_HEAD_DIM ** -0.5)
    p = jax.nn.softmax(s, axis=-1).astype(h.dtype)
    o = jnp.einsum('bhlm,bmhd->blhd', p, mem_v).reshape(bsz, length, D_MODEL)
    return o @ w_o


def conv_ffn(h, conv_prev, w_up, conv_w, conv_b, w_down):
    u, conv_new = causal_dwconv(h @ w_up, conv_prev, conv_w)
    gate, val = jnp.split(u + conv_b, 2, axis=-1)
    return (jax.nn.silu(gate) * val) @ w_down, conv_new


def setup_inputs(seed: int = 0) -> dict:
    key = jax.random.key(seed)
    ks = jax.random.split(key, 48)
    idx = iter(range(48))

    def nrm(shape, scale=1.0):
        return scale * jax.random.normal(ks[next(idx)], shape, jnp.float32)

    def gain(shape):
        return 1.0 + nrm(shape, 0.02)

    def unif(shape, lo, hi):
        return jax.random.uniform(ks[next(idx)], shape, jnp.float32, lo, hi)

    a_A_log = jnp.log(unif((DEPTH, H_A), 1.0, 16.0))
    dt = jnp.exp(unif((DEPTH, H_A), math.log(1e-3), math.log(1e-1)))
    a_dt_bias = dt + jnp.log(-jnp.expm1(-dt))
    lru_s = unif((DEPTH, D_B), 0.9, 0.999) ** (1.0 / RG_C)
    b_lambda = jnp.log(lru_s) - jnp.log1p(-lru_s)
    return {
        'x_prompt': nrm((BATCH, SEQ, D_MODEL)),
        'x_sample': nrm((DEC_BATCH, DEC_SEQ, D_MODEL)),
        'cache_mem_k': nrm((DEPTH, DEC_BATCH, N_MEM, MEM_HEADS, MEM_HEAD_DIM)),
        'cache_mem_v': nrm((DEPTH, DEC_BATCH, N_MEM, MEM_HEADS, MEM_HEAD_DIM)),
        'state_a_conv': nrm((DEPTH, DEC_BATCH, A_CONV - 1, 3 * D_A)),
        'state_a_S': nrm((DEPTH, DEC_BATCH, H_A, DK_A, DV_A), 0.1),
        'state_b_conv': nrm((DEPTH, DEC_BATCH, B_CONV - 1, D_B)),
        'state_b_h': nrm((DEPTH, DEC_BATCH, D_B), 0.5),
        'state_c_S': nrm((DEPTH, DEC_BATCH, H_C, DK_C, DV_C), 0.5),
        'state_ffn_conv': nrm((DEPTH, DEC_BATCH, FFN_CONV - 1, 2 * D_FF)),
        'mem_prompt': nrm((BATCH, N_MEM, D_MODEL)),
        'norm_mix': gain((DEPTH, D_MODEL)),
        'w_in': nrm((DEPTH, D_MODEL, N_IN), D_MODEL ** -0.5),
        'a_conv_w': nrm((DEPTH, A_CONV, 3 * D_A), A_CONV ** -0.5),
        'a_A_log': a_A_log,
        'a_dt_bias': a_dt_bias,
        'a_norm': gain((DEPTH, DV_A)),
        'b_conv_w': nrm((DEPTH, B_CONV, D_B), B_CONV ** -0.5),
        'b_conv_b': nrm((DEPTH, D_B), 0.02),
        'b_w_r': nrm((DEPTH, B_BLOCKS, B_BW, B_BW), B_BW ** -0.5),
        'b_b_r': nrm((DEPTH, D_B), 0.02),
        'b_w_i': nrm((DEPTH, B_BLOCKS, B_BW, B_BW), B_BW ** -0.5),
        'b_b_i': nrm((DEPTH, D_B), 0.02),
        'b_lambda': b_lambda,
        'c_lb_logits': nrm((DEPTH, D_C), 0.1),
        'c_norm': gain((DEPTH, DV_C)),
        'w_out': nrm((DEPTH, D_MIX, D_MODEL), D_MIX ** -0.5),
        'norm_attn': gain((DEPTH, D_MODEL)),
        'norm_mem': gain((DEPTH, D_MODEL)),
        'w_q': nrm((DEPTH, D_MODEL, D_MODEL), D_MODEL ** -0.5),
        'w_k': nrm((DEPTH, D_MODEL, D_MODEL), D_MODEL ** -0.5),
        'w_v': nrm((DEPTH, D_MODEL, D_MODEL), D_MODEL ** -0.5),
        'w_o': nrm((DEPTH, D_MODEL, D_MODEL), D_MODEL ** -0.5),
        'norm_ffn': gain((DEPTH, D_MODEL)),
        'w_up': nrm((DEPTH, D_MODEL, 2 * D_FF), D_MODEL ** -0.5),
        'ffn_conv_w': nrm((DEPTH, FFN_CONV, 2 * D_FF), FFN_CONV ** -0.5),
        'ffn_conv_b': nrm((DEPTH, 2 * D_FF), 0.02),
        'w_down': nrm((DEPTH, D_FF, D_MODEL), D_FF ** -0.5),
        'norm_final': gain((D_MODEL,)),
    }


def reference(x_prompt, x_sample, cache_mem_k, cache_mem_v, state_a_conv, state_a_S, state_b_conv,
              state_b_h, state_c_S, state_ffn_conv, mem_prompt, norm_mix, w_in, a_conv_w, a_A_log,
              a_dt_bias, a_norm, b_conv_w, b_conv_b, b_w_r, b_b_r, b_w_i, b_b_i, b_lambda,
              c_lb_logits, c_norm, w_out, norm_attn, norm_mem, w_q, w_k, w_v, w_o, norm_ffn,
              w_up, ffn_conv_w, ffn_conv_b, w_down, norm_final):
    sm = jax.nn.softmax(c_lb_logits.astype(jnp.float32), axis=0)
    lower_bounds = jnp.cumsum(sm, axis=0) - sm[0]

    def layer(l, x, mem_k, mem_v, a_conv, a_s, b_conv, b_h, c_s, f_conv):
        mix, mix_state = mixing_block(
            rmsnorm(x, norm_mix[l]), a_conv, a_s, b_conv, b_h, c_s,
            w_in[l], a_conv_w[l], a_A_log[l], a_dt_bias[l], a_norm[l],
            b_conv_w[l], b_conv_b[l], b_w_r[l], b_b_r[l], b_w_i[l], b_b_i[l], b_lambda[l],
            lower_bounds[l], c_norm[l], w_out[l])
        x = x + mix
        x = x + memory_cross_attention(rmsnorm(x, norm_attn[l]), mem_k, mem_v, w_q[l], w_o[l])
        f, f_conv_new = conv_ffn(rmsnorm(x, norm_ffn[l]), f_conv, w_up[l], ffn_conv_w[l], ffn_conv_b[l], w_down[l])
        return x + f, mix_state + (f_conv_new,)

    x = x_prompt
    bsz, dt = x.shape[0], x.dtype

    def zeros(*shape):
        return jnp.zeros((bsz,) + shape, dt)

    prompt_kv, prompt_states = [], []
    for l in range(DEPTH):
        mk, mv = memory_kv(mem_prompt, norm_mem[l], w_k[l], w_v[l])
        x, st = layer(l, x, mk, mv, zeros(A_CONV - 1, 3 * D_A), zeros(H_A, DK_A, DV_A),
                      zeros(B_CONV - 1, D_B), zeros(D_B), zeros(H_C, DK_C, DV_C),
                      zeros(FFN_CONV - 1, 2 * D_FF))
        prompt_kv.append((mk, mv))
        prompt_states.append(st)
    y_prompt = rmsnorm(x, norm_final)
    p_mem_k, p_mem_v = [jnp.stack(t, axis=0) for t in zip(*prompt_kv)]
    pa_conv, pa_s, pb_conv, pb_h, pc_s, pf_conv = [jnp.stack(t, axis=0) for t in zip(*prompt_states)]

    x = x_sample
    sample_states = []
    for l in range(DEPTH):
        x, st = layer(l, x, cache_mem_k[l], cache_mem_v[l], state_a_conv[l], state_a_S[l],
                      state_b_conv[l], state_b_h[l], state_c_S[l], state_ffn_conv[l])
        sample_states.append(st)
    y_sample = rmsnorm(x, norm_final)
    sa_conv, sa_s, sb_conv, sb_h, sc_s, sf_conv = [jnp.stack(t, axis=0) for t in zip(*sample_states)]

    return (y_prompt, y_sample, p_mem_k, p_mem_v, pa_conv, pa_s, pb_conv, pb_h, pc_s, pf_conv,
            sa_conv, sa_s, sb_conv, sb_h, sc_s, sf_conv)
```

```cpp
#include <hip/hip_runtime.h>
#include <hip/hip_cooperative_groups.h>
#include <cstdio>
#include <type_traits>
namespace cg = cooperative_groups;

#define LAS __attribute__((address_space(3)))
typedef unsigned short bf16_t;
typedef short bf16x8 __attribute__((ext_vector_type(8)));
typedef short bf16x4 __attribute__((ext_vector_type(4)));
typedef float f32x4 __attribute__((ext_vector_type(4)));
typedef unsigned u32x4 __attribute__((ext_vector_type(4)));
typedef unsigned u32x2 __attribute__((ext_vector_type(2)));

constexpr int T_ALL = 33280, T_P = 32768, NCHUNK = 520, DM = 1024, NINP = 3840, DFF = 2816, DFF2 = 5632;
constexpr float EPS = 1e-6f;
constexpr size_t OUT_Y = 0;
constexpr size_t OUT_PMK = OUT_Y + (size_t)T_ALL * 1024;
constexpr size_t OUT_PMV = OUT_PMK + 2ull * 8 * 256 * 1024;
constexpr size_t SZ_AC = 2ull * 8 * 3 * 1536, SZ_AS = 2ull * 8 * 4 * 128 * 128, SZ_BC = 2ull * 8 * 3 * 256, SZ_BH = 2ull * 8 * 256, SZ_CS = 2ull * 8 * 4 * 64 * 64, SZ_FC = 2ull * 8 * 2 * 5632;
constexpr size_t OUT_PAC = OUT_PMV + 2ull * 8 * 256 * 1024;
constexpr size_t OUT_PAS = OUT_PAC + SZ_AC;
constexpr size_t OUT_PBC = OUT_PAS + SZ_AS;
constexpr size_t OUT_PBH = OUT_PBC + SZ_BC;
constexpr size_t OUT_PCS = OUT_PBH + SZ_BH;
constexpr size_t OUT_PFC = OUT_PCS + SZ_CS;
constexpr size_t OUT_SAC = OUT_PFC + SZ_FC;
constexpr size_t OUT_SAS = OUT_SAC + SZ_AC;
constexpr size_t OUT_SBC = OUT_SAS + SZ_AS;
constexpr size_t OUT_SBH = OUT_SBC + SZ_BC;
constexpr size_t OUT_SCS = OUT_SBH + SZ_BH;
constexpr size_t OUT_SFC = OUT_SCS + SZ_CS;
constexpr size_t OUT_TOTAL = OUT_SFC + SZ_FC;

constexpr size_t AL(size_t x) { return (x + 255) & ~(size_t)255; }
constexpr size_t W_BIN = 0;
constexpr size_t W_BOUT = W_BIN + 2ull * NINP * 1024 * 2;
constexpr size_t W_BQ = W_BOUT + 2ull * 1024 * 1024 * 2;
constexpr size_t W_BO = W_BQ + 2ull * 1024 * 1024 * 2;
constexpr size_t W_BKV = W_BO + 2ull * 1024 * 1024 * 2;
constexpr size_t W_BUP = W_BKV + 4096ull * 1024 * 2;
constexpr size_t W_BDN = W_BUP + 2ull * DFF2 * 1024 * 2;
constexpr size_t W_MEMB = W_BDN + 2ull * 1024 * DFF * 2;
constexpr size_t W_KB = W_MEMB + 2048ull * 1024 * 2;
constexpr size_t W_VT = W_KB + 2ull * 16 * 256 * 1024 * 2;
constexpr size_t XB_PRE = 2, XB_ROWS = (size_t)T_ALL + 2 + 318;
constexpr size_t W_XB = W_VT + 2ull * 16 * 256 * 1024 * 2;
constexpr size_t W_SSQ = W_XB + XB_ROWS * 1024 * 2;
constexpr size_t W_GL = W_SSQ + 8ull * T_ALL * 4;
constexpr size_t W_EH = AL(W_GL + 2080 * 4);
constexpr size_t W_SUMA = W_EH + 2080ull * 64 * 4;
constexpr size_t W_SUMH = W_SUMA + 520ull * 256 * 4;
constexpr size_t W_R = AL(W_SUMH + 520ull * 256 * 4);
constexpr size_t GITEM = 36864;
constexpr size_t HITEM = 16384;
constexpr size_t R_GBUF = W_R;
constexpr size_t R_HBUF = R_GBUF + 2080ull * GITEM * 2;
constexpr size_t R_ZBUF = R_HBUF + 2080ull * HITEM * 2;
constexpr size_t R_BX = R_ZBUF + (size_t)T_ALL * 1024 * 2;
constexpr size_t R_HLOC = R_BX + (size_t)T_ALL * 256 * 2;
constexpr size_t R_PCUM = R_HLOC + (size_t)T_ALL * 256 * 2;
constexpr size_t R_HALO = R_PCUM + (size_t)T_ALL * 256 * 2;
constexpr size_t R_GATES = AL(R_HALO + 520ull * 3 * 1536 * 2);
constexpr size_t R_END1 = R_GATES + (size_t)T_ALL * 8 * 4;
constexpr size_t R_QBUF = W_R;
constexpr size_t R_OATT = R_QBUF + (size_t)T_ALL * 1024 * 2;
constexpr size_t R_ACT = W_R;
constexpr size_t R_END3 = R_ACT + ((size_t)T_ALL + 256) * DFF * 2;
constexpr size_t WS_NEED = (R_END1 > R_END3 ? R_END1 : R_END3);
static_assert(WS_NEED <= 512ull * 1024 * 1024, "workspace map exceeds 512 MiB");

constexpr int LDS_BYTES = 147456;
#ifndef STOP_AFTER
#define STOP_AFTER 99
#endif

struct Params {
    const float* in[39];
    float* out;
    unsigned char* ws;
};

__device__ __forceinline__ float bf2f(bf16_t b) { return __uint_as_float(((unsigned)b) << 16); }
typedef float f32x2_t __attribute__((ext_vector_type(2)));
typedef __bf16 bf16x2_t __attribute__((ext_vector_type(2)));
__device__ __forceinline__ unsigned cvt_pk_bf16(float lo, float hi) { const f32x2_t v = {lo, hi}; const bf16x2_t r = __builtin_convertvector(v, bf16x2_t); return __builtin_bit_cast(unsigned, r); }
__device__ __forceinline__ bf16_t f2bf(float f) { return (bf16_t)(cvt_pk_bf16(f, 0.f) & 0xffffu); }
__device__ __forceinline__ float lo_bf(unsigned w) { return __uint_as_float(w << 16); }
__device__ __forceinline__ float hi_bf(unsigned w) { return __uint_as_float(w & 0xffff0000u); }
__device__ __forceinline__ float sigmoidf_(float x) { return 1.0f / (1.0f + __expf(-x)); }
__device__ __forceinline__ float siluf_(float x) { return x / (1.0f + __expf(-x)); }
__device__ __forceinline__ float softplusf_(float x) { return x > 20.f ? x : log1pf(__expf(x)); }
__device__ __forceinline__ float gelu_tanh(float x) { const float u = 0.7978845608028654f * (x + 0.044715f * x * x * x); return 0.5f * x * (1.0f + tanhf(u)); }
__device__ __forceinline__ f32x4 mfma16(bf16x8 a, bf16x8 b, f32x4 c) { return __builtin_amdgcn_mfma_f32_16x16x32_bf16(a, b, c, 0, 0, 0); }
__device__ __forceinline__ void unpack8(u32x4 w, float* f) { f[0] = lo_bf(w.x); f[1] = hi_bf(w.x); f[2] = lo_bf(w.y); f[3] = hi_bf(w.y); f[4] = lo_bf(w.z); f[5] = hi_bf(w.z); f[6] = lo_bf(w.w); f[7] = hi_bf(w.w); }
__device__ __forceinline__ u32x4 pack8(const float* f) { u32x4 w; w.x = cvt_pk_bf16(f[0], f[1]); w.y = cvt_pk_bf16(f[2], f[3]); w.z = cvt_pk_bf16(f[4], f[5]); w.w = cvt_pk_bf16(f[6], f[7]); return w; }

namespace pg8 {
constexpr int BM = 256, BK = 64, HALF = 128, HTB = HALF * BK * 2, STAGE_BYTES = 8 * HTB, NXCD = 8, WGM = 8;
__device__ __forceinline__ int lds_byte(int r, int c) { const int st = (r >> 4) * 2 + (c >> 5), rr = r & 15, cc = c & 31, ob = rr * 64 + cc * 2; return st * 1024 + (ob ^ (((ob >> 9) & 1) << 5)); }
__device__ __forceinline__ void stage_rc(int b, int& R, int& C) { const int st = b / 1024, sb = b % 1024, swz = sb ^ (((sb >> 9) & 1) << 5); R = (st >> 1) * 16 + swz / 64; C = (st & 1) * 32 + (swz % 64) / 2; }
__device__ __forceinline__ int perm32(int rho) { const int n = rho >> 4, i = rho & 15; return 8 * (i >> 2) + 4 * n + (i & 3); }
struct Unit { int pm, pn; };
struct Order {
    int nM, nN, nwg, G, c;
    __device__ void init(int nM_, int nN_, int G_, int c_) { nM = nM_; nN = nN_; nwg = nM * nN; G = G_; c = c_; }
    __device__ bool next(int i, Unit& u) const {
        const long L = (long)i * G + c; if (L >= nwg) return false;
        int wgid = (int)L; { const int q = nwg / NXCD, r = nwg % NXCD, xcd = wgid % NXCD, off = wgid / NXCD; wgid = (xcd < r ? xcd * (q + 1) : r * (q + 1) + (xcd - r) * q) + off; }
        const int nig = WGM * nN, gid = wgid / nig, fm = gid * WGM, gsz = (nM - fm) < WGM ? (nM - fm) : WGM;
        u.pm = fm + ((wgid % nig) % gsz); u.pn = (wgid % nig) / gsz; return true;
    }
};
template <class Epi, int AMODE>
__device__ __forceinline__ void gemm_phase(LAS unsigned char* lds, const bf16_t* A, const bf16_t* Bt, int K, int nM, int nN, const Epi& E) {
    int tid = threadIdx.x; asm volatile("" : "+v"(tid)); const int wid = __builtin_amdgcn_readfirstlane(tid >> 6), lane = tid & 63, wr = wid >> 2, wc = wid & 3, fr = lane & 15, fq = lane >> 4;
    const int nt = K / BK;
    unsigned voffA[2], voffB[2];
#pragma unroll
    for (int i = 0; i < 2; ++i) { int R, C; stage_rc(tid * 16 + i * 8192, R, C); const int Rb = Epi::PERM ? ((R & ~31) + perm32(R & 31)) : R;
        const int Ra = AMODE ? ((R >> 6) * 126 + (R & 63)) : R;
        voffA[i] = (unsigned)(Ra * K + C) * 2u; voffB[i] = (unsigned)(Rb * K + C) * 2u; }
    const size_t kstep = (size_t)(BK * 2);
    const size_t hstepB = (size_t)HALF * K * 2, tstepB = 2 * hstepB;
    const size_t hstepA = AMODE ? (size_t)64 * K * 2 : hstepB, tstepA = AMODE ? (size_t)252 * K * 2 : tstepB;
    const unsigned ldsw = (unsigned)wid * 1024u;
    const int aoff = lds_byte(wr * 64 + fr, fq * 8), boff = lds_byte(wc * 32 + fr, fq * 8);
#define PG8_SA(b, h) (((b) * 2 + (h)) * HTB)
#define PG8_SB(b, h) ((4 + (b) * 2 + (h)) * HTB)
#define PG8_STAGE(bufoff, gbase, voff) do { _Pragma("unroll") for (int _i = 0; _i < 2; ++_i) \
        __builtin_amdgcn_global_load_lds((const unsigned*)((const char*)(gbase) + (voff)[_i]), (LAS unsigned*)(lds + (bufoff) + ldsw + _i * 8192), 16, 0, 0); } while (0)
#define PG8_LDA(dst, b, h) do { _Pragma("unroll") for (int m = 0; m < 4; ++m) _Pragma("unroll") for (int k = 0; k < 2; ++k) dst[m][k] = *(const LAS bf16x8*)(lds + PG8_SA(b, h) + aoff + m * 2048 + k * 1024); } while (0)
#define PG8_LDB(dst, b, h) do { _Pragma("unroll") for (int n = 0; n < 2; ++n) _Pragma("unroll") for (int k = 0; k < 2; ++k) dst[n][k] = *(const LAS bf16x8*)(lds + PG8_SB(b, h) + boff + n * 2048 + k * 1024); } while (0)
#define PG8_MMA(ai, bj, At, Bt_) do { __builtin_amdgcn_s_setprio(1); _Pragma("unroll") for (int m = 0; m < 4; ++m) _Pragma("unroll") for (int n = 0; n < 2; ++n) _Pragma("unroll") for (int k = 0; k < 2; ++k) \
        acc[ai][bj][m][n] = __builtin_amdgcn_mfma_f32_16x16x32_bf16(Bt_[n][k], At[m][k], acc[ai][bj][m][n], 0, 0, 0); __builtin_amdgcn_s_setprio(0); } while (0)
#define PG8_WAIT_V(n) asm volatile("s_waitcnt vmcnt(" #n ")" ::: "memory")
#define PG8_WAIT_L(n) asm volatile("s_waitcnt lgkmcnt(" #n ")" ::: "memory")
#define PG8_BAR __builtin_amdgcn_s_barrier()
#define PG8_SCHED __builtin_amdgcn_sched_barrier(0)
    int bid_ = blockIdx.x; asm volatile("" : "+s"(bid_));
    Order S; S.init(nM, nN, gridDim.x, bid_);
    Unit cur, nxt; int ui = 0;
    if (!S.next(0, cur)) return;
    f32x4 acc[2][2][4][2];
#pragma unroll
    for (int a = 0; a < 2; ++a)
#pragma unroll
        for (int b = 0; b < 2; ++b)
#pragma unroll
            for (int m = 0; m < 4; ++m)
#pragma unroll
                for (int n = 0; n < 2; ++n) acc[a][b][m][n] = (f32x4){0.f, 0.f, 0.f, 0.f};
    bf16x8 At[4][2], B0[2][2], B1[2][2];
    const char* cA = (const char*)A + (size_t)cur.pm * tstepA; const char* cB = (const char*)Bt + (size_t)cur.pn * tstepB;
    PG8_STAGE(PG8_SB(0, 0), cB, voffB); PG8_STAGE(PG8_SA(0, 0), cA, voffA); PG8_STAGE(PG8_SB(0, 1), cB + hstepB, voffB); PG8_STAGE(PG8_SA(0, 1), cA + hstepA, voffA);
    if (wr == 1) PG8_BAR;
    PG8_WAIT_V(4); PG8_BAR;
    PG8_STAGE(PG8_SB(1, 0), cB + kstep, voffB); PG8_STAGE(PG8_SA(1, 0), cA + kstep, voffA); PG8_STAGE(PG8_SB(1, 1), cB + hstepB + kstep, voffB);
    PG8_WAIT_V(6); PG8_BAR;
    for (;;) {
        const bool has_next = S.next(ui + 1, nxt);
        const char* nA = has_next ? (const char*)A + (size_t)nxt.pm * tstepA : cA; const char* nB = has_next ? (const char*)Bt + (size_t)nxt.pn * tstepB : cB;
        for (int t = 0; t < nt; t += 2) {
            const bool last = (t == nt - 2);
            const char* a1 = cA + (size_t)(t + 1) * kstep;
            const char* a2 = last ? nA : cA + (size_t)(t + 2) * kstep; const char* b2 = last ? nB : cB + (size_t)(t + 2) * kstep;
            const char* a3 = a2 + kstep; const char* b3 = b2 + kstep;
            PG8_LDB(B0, 0, 0); PG8_SCHED; PG8_LDA(At, 0, 0); PG8_STAGE(PG8_SA(1, 1), a1 + hstepA, voffA);
            PG8_WAIT_L(8); PG8_BAR; PG8_WAIT_L(0); PG8_MMA(0, 0, At, B0); PG8_BAR; PG8_SCHED;
            PG8_LDB(B1, 0, 1); PG8_STAGE(PG8_SB(0, 0), b2, voffB);
            PG8_BAR; PG8_WAIT_L(0); PG8_MMA(0, 1, At, B1); PG8_BAR;
            PG8_LDA(At, 0, 1); PG8_STAGE(PG8_SA(0, 0), a2, voffA);
            PG8_BAR; PG8_WAIT_L(0); PG8_MMA(1, 0, At, B0); PG8_BAR; PG8_SCHED;
            PG8_STAGE(PG8_SB(0, 1), b2 + hstepB, voffB);
            PG8_WAIT_V(6); PG8_BAR; PG8_MMA(1, 1, At, B1); PG8_BAR;
            PG8_LDB(B0, 1, 0); PG8_SCHED; PG8_LDA(At, 1, 0); PG8_STAGE(PG8_SA(0, 1), a2 + hstepA, voffA);
            PG8_WAIT_L(8); PG8_BAR; PG8_WAIT_L(0); PG8_MMA(0, 0, At, B0); PG8_BAR; PG8_SCHED;
            PG8_LDB(B1, 1, 1); PG8_STAGE(PG8_SB(1, 0), b3, voffB);
            PG8_BAR; PG8_WAIT_L(0); PG8_MMA(0, 1, At, B1); PG8_BAR;
            PG8_LDA(At, 1, 1); PG8_STAGE(PG8_SA(1, 0), a3, voffA);
            PG8_BAR; PG8_WAIT_L(0); PG8_MMA(1, 0, At, B0); PG8_BAR; PG8_SCHED;
            PG8_STAGE(PG8_SB(1, 1), b3 + hstepB, voffB);
            PG8_WAIT_V(6); PG8_BAR; PG8_MMA(1, 1, At, B1); PG8_BAR;
        }
        E(acc, cur, wr, wc, fr, fq);
        if (!has_next) break;
#pragma unroll
        for (int a = 0; a < 2; ++a)
#pragma unroll
            for (int b = 0; b < 2; ++b)
#pragma unroll
                for (int m = 0; m < 4; ++m)
#pragma unroll
                    for (int n = 0; n < 2; ++n) acc[a][b][m][n] = (f32x4){0.f, 0.f, 0.f, 0.f};
        cur = nxt; cA = nA; cB = nB; ++ui;
    }
    PG8_WAIT_V(0);
    if (wr == 0) PG8_BAR;
    PG8_BAR;
#undef PG8_SA
#undef PG8_SB
#undef PG8_STAGE
#undef PG8_LDA
#undef PG8_LDB
#undef PG8_MMA
#undef PG8_WAIT_V
#undef PG8_WAIT_L
#undef PG8_BAR
#undef PG8_SCHED
}
}
using pg8::Unit;
typedef f32x4 AccT[2][2][4][2];

struct EpiKV {
    static constexpr bool PERM = false;
    float* out; const float* ssq;
    __device__ __forceinline__ void operator()(const AccT& acc, const Unit& u, int wr, int wc, int fr, int fq) const {
        asm volatile("" : "+v"(fr), "+v"(fq));
        const int which = u.pn >> 2;
        float* base = out + ((which & 1) ? OUT_PMV : OUT_PMK) + (size_t)(which >> 1) * 2048 * 1024 + (u.pn & 3) * 256 + wc * 32 + 4 * fq;
#pragma unroll
        for (int ai = 0; ai < 2; ++ai)
#pragma unroll
            for (int m = 0; m < 4; ++m) { const int row = u.pm * 256 + ai * 128 + wr * 64 + m * 16 + fr; const float rs = rsqrtf(ssq[row] * (1.0f / 1024.0f) + EPS);
                float* rowp = base + (size_t)row * 1024;
#pragma unroll
                for (int bj = 0; bj < 2; ++bj)
#pragma unroll
                    for (int n = 0; n < 2; ++n) *(f32x4*)(rowp + bj * 128 + n * 16) = acc[ai][bj][m][n] * rs; }
    }
};
struct EpiRes {
    static constexpr bool PERM = false;
    float* xf; bf16_t* xb; float* ssq;
    __device__ __forceinline__ void operator()(const AccT& acc, const Unit& u, int wr, int wc, int fr, int fq) const {
        asm volatile("" : "+v"(fr), "+v"(fq));
        const int col0 = u.pn * 256 + wc * 32 + 4 * fq;
#pragma unroll
        for (int ai = 0; ai < 2; ++ai)
#pragma unroll
            for (int m = 0; m < 4; ++m) { const int row = u.pm * 256 + ai * 128 + wr * 64 + m * 16 + fr; float* rowp = xf + (size_t)row * 1024 + col0; bf16_t* rowb = xb + (size_t)row * 1024 + col0;
                float s = 0.f;
#pragma unroll
                for (int bj = 0; bj < 2; ++bj)
#pragma unroll
                    for (int n = 0; n < 2; ++n) { const f32x4 x = *(const f32x4*)(rowp + bj * 128 + n * 16) + acc[ai][bj][m][n];
                        *(f32x4*)(rowp + bj * 128 + n * 16) = x; u32x2 w; w.x = cvt_pk_bf16(x[0], x[1]); w.y = cvt_pk_bf16(x[2], x[3]); *(u32x2*)(rowb + bj * 128 + n * 16) = w;
                        s += (x[0] * x[0] + x[1] * x[1]) + (x[2] * x[2] + x[3] * x[3]); }
                s += __shfl_xor(s, 16); s += __shfl_xor(s, 32);
                if (fq == 0) atomicAdd(ssq + row, s); }
    }
};
struct EpiQ {
    static constexpr bool PERM = true;
    bf16_t* q; const float* ssq;
    __device__ __forceinline__ void operator()(const AccT& acc, const Unit& u, int wr, int wc, int fr, int fq) const {
        asm volatile("" : "+v"(fr), "+v"(fq));
        const int col0 = u.pn * 256 + wc * 32 + 8 * fq;
#pragma unroll
        for (int ai = 0; ai < 2; ++ai)
#pragma unroll
            for (int m = 0; m < 4; ++m) { const int row = u.pm * 256 + ai * 128 + wr * 64 + m * 16 + fr; const float rs = rsqrtf(ssq[row] * (1.0f / 1024.0f) + EPS);
                bf16_t* rowp = q + (size_t)row * 1024 + col0;
#pragma unroll
                for (int bj = 0; bj < 2; ++bj) { const f32x4 v0 = acc[ai][bj][m][0] * rs, v1 = acc[ai][bj][m][1] * rs; u32x4 w; w.x = cvt_pk_bf16(v0[0], v0[1]); w.y = cvt_pk_bf16(v0[2], v0[3]); w.z = cvt_pk_bf16(v1[0], v1[1]); w.w = cvt_pk_bf16(v1[2], v1[3]);
                    *(u32x4*)(rowp + bj * 128) = w; } }
    }
};
struct EpiProj {
    static constexpr bool PERM = true;
    unsigned char* ws; const float* ssq;
    __device__ __forceinline__ void operator()(const AccT& acc, const Unit& u, int wr, int wc, int fr, int fq) const {
        asm volatile("" : "+v"(fr), "+v"(fq));
        bf16_t* gbuf = (bf16_t*)(ws + R_GBUF); bf16_t* hbuf = (bf16_t*)(ws + R_HBUF); bf16_t* zbuf = (bf16_t*)(ws + R_ZBUF); bf16_t* bx = (bf16_t*)(ws + R_BX); bf16_t* halo = (bf16_t*)(ws + R_HALO); float* gates = (float*)(ws + R_GATES);
        const int pn = u.pn;
#pragma unroll
        for (int ai = 0; ai < 2; ++ai)
#pragma unroll
            for (int m = 0; m < 4; ++m) { const int row = u.pm * 256 + ai * 128 + wr * 64 + m * 16 + fr; const float rs = rsqrtf(ssq[row] * (1.0f / 1024.0f) + EPS);
                const int chunk = row >> 6, t = row & 63;
#pragma unroll
                for (int bj = 0; bj < 2; ++bj) { const f32x4 v0 = acc[ai][bj][m][0] * rs, v1 = acc[ai][bj][m][1] * rs;
                    const int cc = bj * 128 + wc * 32 + 8 * fq;
                    if (pn == 14) { if (cc == 0) { *(f32x4*)(gates + (size_t)row * 8) = v0; *(f32x4*)(gates + (size_t)row * 8 + 4) = v1; } continue; }
                    u32x4 w; w.x = cvt_pk_bf16(v0[0], v0[1]); w.y = cvt_pk_bf16(v0[2], v0[3]); w.z = cvt_pk_bf16(v1[0], v1[1]); w.w = cvt_pk_bf16(v1[2], v1[3]);
                    if (pn < 6) { const int which = pn >> 1, head = (pn & 1) * 2 + bj, d = wc * 32 + 8 * fq;
                        *(u32x4*)(gbuf + (size_t)(chunk * 4 + head) * GITEM + which * 8192 + t * 128 + d) = w;
                        if (t >= 61) *(u32x4*)(halo + (size_t)(chunk * 3 + (t - 61)) * 1536 + which * 512 + head * 128 + d) = w; }
                    else if (pn < 8) *(u32x4*)(zbuf + (size_t)row * 1024 + (pn - 6) * 256 + cc) = w;
                    else if (pn == 8) *(u32x4*)(bx + (size_t)row * 256 + cc) = w;
                    else if (pn == 9) *(u32x4*)(zbuf + (size_t)row * 1024 + 512 + cc) = w;
                    else if (pn < 13) { const int which = pn - 10, head = cc >> 6, d = cc & 63;
                        *(u32x4*)(hbuf + (size_t)(chunk * 4 + head) * HITEM + which * 4096 + t * 64 + d) = w; }
                    else *(u32x4*)(zbuf + (size_t)row * 1024 + 768 + cc) = w; } }
    }
};
struct EpiUp {
    static constexpr bool PERM = true;
    bf16_t* act; const float* ssq; const float* convw; const float* convb; const float* state; float* outp; float* outs;
    __device__ __forceinline__ void operator()(const AccT& acc, const Unit& u, int wr, int wc, int fr, int fq) const {
        asm volatile("" : "+v"(fr), "+v"(fq));
        const int lane = fq * 16 + fr;
        const int src1 = fq * 16 + ((fr + 15) & 15), src2 = fq * 16 + ((fr + 14) & 15);
        const int grow0 = u.pm * 252 + wr * 126 - 2;
        const int cbase = u.pn * 128 + wc * 32 + 8 * fq;
        (void)lane;
        float rsv[8];
#pragma unroll
        for (int g = 0; g < 8; ++g) { int grow = grow0 + g * 16 + fr; grow = grow < 0 ? 0 : (grow >= T_ALL ? T_ALL - 1 : grow); rsv[g] = rsqrtf(ssq[grow] * (1.0f / 1024.0f) + EPS); }
#pragma unroll
        for (int n = 0; n < 2; ++n) {
            const int c = cbase + 4 * n;
            f32x4 wg[3], wv[3];
#pragma unroll
            for (int j = 0; j < 3; ++j) { wg[j] = *(const f32x4*)(convw + j * DFF2 + c); wv[j] = *(const f32x4*)(convw + j * DFF2 + DFF + c); }
            const f32x4 bg = *(const f32x4*)(convb + c), bv = *(const f32x4*)(convb + DFF + c);
            f32x4 pg_g = (f32x4){0.f, 0.f, 0.f, 0.f}, pg_v = pg_g;
#pragma unroll
            for (int g = 0; g < 8; ++g) {
                const int ai = g >> 2, m = g & 3;
                const f32x4 cg_ = acc[ai][0][m][n] * rsv[g], cv_ = acc[ai][1][m][n] * rsv[g];
                f32x4 p1g, p2g, p1v, p2v;
#pragma unroll
                for (int j = 0; j < 4; ++j) {
                    const float a1 = __shfl(cg_[j], src1), b1 = __shfl(pg_g[j], src1), a2 = __shfl(cg_[j], src2), b2 = __shfl(pg_g[j], src2);
                    p1g[j] = fr >= 1 ? a1 : b1; p2g[j] = fr >= 2 ? a2 : b2;
                    const float c1 = __shfl(cv_[j], src1), d1 = __shfl(pg_v[j], src1), c2 = __shfl(cv_[j], src2), d2 = __shfl(pg_v[j], src2);
                    p1v[j] = fr >= 1 ? c1 : d1; p2v[j] = fr >= 2 ? c2 : d2;
                }
                const int rho = g * 16 + fr, grow = grow0 + rho;
                if (rho >= 2 && grow < T_ALL) {
                    const bool samp = grow >= T_P; const int s = samp ? ((grow - T_P) & 63) : (grow & 4095); const int b = samp ? ((grow - T_P) >> 6) : (grow >> 12); const int L = samp ? 64 : 4096;
                    if (s < 2) {
                        f32x4 s0g = (f32x4){0.f, 0.f, 0.f, 0.f}, s1g = s0g, s0v = s0g, s1v = s0g;
                        if (samp) { const float* st = state + (size_t)b * 2 * DFF2; s0g = *(const f32x4*)(st + c); s1g = *(const f32x4*)(st + DFF2 + c); s0v = *(const f32x4*)(st + DFF + c); s1v = *(const f32x4*)(st + DFF2 + DFF + c); }
                        if (s == 0) { p1g = s1g; p2g = s0g; p1v = s1v; p2v = s0v; } else { p2g = s1g; p2v = s1v; }
                    }
                    const f32x4 yg = wg[0] * p2g + wg[1] * p1g + wg[2] * cg_ + bg;
                    const f32x4 yv = wv[0] * p2v + wv[1] * p1v + wv[2] * cv_ + bv;
                    u32x2 w; w.x = cvt_pk_bf16(siluf_(yg[0]) * yv[0], siluf_(yg[1]) * yv[1]); w.y = cvt_pk_bf16(siluf_(yg[2]) * yv[2], siluf_(yg[3]) * yv[3]);
                    *(u32x2*)(act + (size_t)grow * DFF + c) = w;
                    if (s >= L - 2) { float* o = (samp ? outs : outp) + ((size_t)b * 2 + (s - (L - 2))) * DFF2; *(f32x4*)(o + c) = cg_; *(f32x4*)(o + DFF + c) = cv_; }
                }
                pg_g = cg_; pg_v = cv_;
            }
        }
    }
};

__device__ __forceinline__ int src_col8(int mode, int j0) {
    if (mode == 1) { if (j0 < 2048) return j0; if (j0 < 3584) return j0 + 8; if (j0 < 3592) return 2048; return -1; }
    if (mode == 2) { const int pn = j0 >> 8, w = j0 & 255; return w < 128 ? pn * 128 + w : DFF + pn * 128 + (w - 128); }
    return j0;
}
__device__ __noinline__ void transpose_job(const float* W, int ldw, int Kdim, int Nout, int mode, const float* gain, float scale, bf16_t* Bt, LAS unsigned char* lds, int rot) {
    LAS bf16_t* tile = (LAS bf16_t*)lds;
    int tid = threadIdx.x; asm volatile("" : "+v"(tid)); const int ntn = Nout >> 6, ntiles = ntn * (Kdim >> 6);
    for (int t = (int)((blockIdx.x + gridDim.x - (rot % gridDim.x)) % gridDim.x); t < ntiles; t += gridDim.x) {
        const int kt = t / ntn, ntl = t % ntn, k0 = kt * 64, n0 = ntl * 64;
        { const int kk = tid >> 3, ng = tid & 7; const int s = src_col8(mode, n0 + ng * 8);
          f32x4 a = (f32x4){0.f, 0.f, 0.f, 0.f}, b = a;
          if (s >= 0) { const float* p = W + (size_t)(k0 + kk) * ldw + s; a = *(const f32x4*)p; b = *(const f32x4*)(p + 4); }
          const float g = (gain ? gain[k0 + kk] : 1.0f) * scale;
          const float v[8] = {a[0] * g, a[1] * g, a[2] * g, a[3] * g, b[0] * g, b[1] * g, b[2] * g, b[3] * g};
#pragma unroll
          for (int i = 0; i < 8; ++i) tile[(ng * 8 + i) * 72 + kk] = f2bf(v[i]); }
        __syncthreads();
        { const int nl = tid >> 3, kg = tid & 7; const u32x4 w = *(const LAS u32x4*)(tile + nl * 72 + kg * 8); *(u32x4*)(Bt + (size_t)(n0 + nl) * Kdim + k0 + kg * 8) = w; }
        __syncthreads();
    }
}
__device__ __forceinline__ void rows_to_bf16(const float* src, int nrows, bf16_t* dst, float* copy, float* ssq) {
    int tidl = threadIdx.x; asm volatile("" : "+v"(tidl)); const int lane = tidl & 63, gw = blockIdx.x * 8 + (tidl >> 6), nw = gridDim.x * 8;
    for (int r = gw; r < nrows; r += nw) {
        float s = 0.f;
#pragma unroll
        for (int i = 0; i < 4; ++i) { const int c = i * 256 + lane * 4; const f32x4 x = *(const f32x4*)(src + (size_t)r * 1024 + c);
            if (copy) *(f32x4*)(copy + (size_t)r * 1024 + c) = x;
            u32x2 w; w.x = cvt_pk_bf16(x[0], x[1]); w.y = cvt_pk_bf16(x[2], x[3]); *(u32x2*)(dst + (size_t)r * 1024 + c) = w;
            s += (x[0] * x[0] + x[1] * x[1]) + (x[2] * x[2] + x[3] * x[3]); }
#pragma unroll
        for (int o = 32; o >= 1; o >>= 1) s += __shfl_xor(s, o);
        if (lane == 0) ssq[r] = s;
    }
}
__device__ __forceinline__ void convert_flat(const float* src, bf16_t* dst, size_t n8) {
    int tidl = threadIdx.x; asm volatile("" : "+v"(tidl)); for (size_t i = (size_t)blockIdx.x * 512 + tidl; i < n8; i += (size_t)gridDim.x * 512) { const f32x4 a = *(const f32x4*)(src + i * 8), b = *(const f32x4*)(src + i * 8 + 4);
        u32x4 w; w.x = cvt_pk_bf16(a[0], a[1]); w.y = cvt_pk_bf16(a[2], a[3]); w.z = cvt_pk_bf16(b[0], b[1]); w.w = cvt_pk_bf16(b[2], b[3]); *(u32x4*)(dst + i * 8) = w; }
}

__device__ __forceinline__ void phase0(const Params& p, LAS unsigned char* lds) {
    unsigned char* ws = p.ws; asm volatile("" : "+s"(ws));
    int rot = 0;
    for (int l = 0; l < 2; ++l) {
        transpose_job(p.in[12] + (size_t)l * 1024 * 3592, 3592, 1024, NINP, 1, p.in[11] + l * 1024, 1.0f, (bf16_t*)(ws + W_BIN) + (size_t)l * NINP * 1024, lds, rot); rot += 60 * 16;
        transpose_job(p.in[26] + (size_t)l * 1024 * 1024, 1024, 1024, 1024, 0, nullptr, 1.0f, (bf16_t*)(ws + W_BOUT) + (size_t)l * 1024 * 1024, lds, rot); rot += 256;
        transpose_job(p.in[29] + (size_t)l * 1024 * 1024, 1024, 1024, 1024, 0, p.in[27] + l * 1024, 0.0625f, (bf16_t*)(ws + W_BQ) + (size_t)l * 1024 * 1024, lds, rot); rot += 256;
        transpose_job(p.in[32] + (size_t)l * 1024 * 1024, 1024, 1024, 1024, 0, nullptr, 1.0f, (bf16_t*)(ws + W_BO) + (size_t)l * 1024 * 1024, lds, rot); rot += 256;
        transpose_job(p.in[30] + (size_t)l * 1024 * 1024, 1024, 1024, 1024, 0, p.in[28] + l * 1024, 1.0f, (bf16_t*)(ws + W_BKV) + (size_t)(l * 2048) * 1024, lds, rot); rot += 256;
        transpose_job(p.in[31] + (size_t)l * 1024 * 1024, 1024, 1024, 1024, 0, p.in[28] + l * 1024, 1.0f, (bf16_t*)(ws + W_BKV) + (size_t)(l * 2048 + 1024) * 1024, lds, rot); rot += 256;
        transpose_job(p.in[34] + (size_t)l * 1024 * DFF2, DFF2, 1024, DFF2, 2, p.in[33] + l * 1024, 1.0f, (bf16_t*)(ws + W_BUP) + (size_t)l * DFF2 * 1024, lds, rot); rot += 88 * 16;
        transpose_job(p.in[37] + (size_t)l * DFF * 1024, 1024, DFF, 1024, 0, nullptr, 1.0f, (bf16_t*)(ws + W_BDN) + (size_t)l * 1024 * DFF, lds, rot); rot += 16 * 44;
        for (int b = 0; b < 8; ++b) for (int h = 0; h < 4; ++h) {
            transpose_job(p.in[3] + ((size_t)(l * 8 + b) * 256) * 1024 + h * 256, 1024, 256, 256, 0, nullptr, 1.0f, (bf16_t*)(ws + W_VT) + ((size_t)((l * 16 + 8 + b) * 4 + h)) * 65536, lds, rot); rot += 16; }
        convert_flat(p.in[2] + (size_t)l * 8 * 256 * 1024, (bf16_t*)(ws + W_KB) + (size_t)(l * 16 + 8) * 256 * 1024, 8ull * 256 * 1024 / 8);
    }
    float* ssq = (float*)(ws + W_SSQ);
    bf16_t* xb = (bf16_t*)(ws + W_XB) + XB_PRE * 1024;
    rows_to_bf16(p.in[0], T_P, xb, p.out + OUT_Y, ssq);
    rows_to_bf16(p.in[1], 512, xb + (size_t)T_P * 1024, p.out + OUT_Y + (size_t)T_P * 1024, ssq + T_P);
    rows_to_bf16(p.in[10], 2048, (bf16_t*)(ws + W_MEMB), nullptr, ssq + 7ull * T_ALL);
    int tidz = threadIdx.x; asm volatile("" : "+v"(tidz)); for (size_t i = (size_t)blockIdx.x * 512 + tidz; i < 6ull * T_ALL; i += (size_t)gridDim.x * 512) ssq[T_ALL + i] = 0.f;
}
__device__ __forceinline__ void kv_prompt_convert(const Params& p, LAS unsigned char* lds) {
    unsigned char* ws = p.ws; asm volatile("" : "+s"(ws)); int rot = 0;
    for (int l = 0; l < 2; ++l) {
        convert_flat(p.out + OUT_PMK + (size_t)l * 2048 * 1024, (bf16_t*)(ws + W_KB) + (size_t)(l * 16) * 256 * 1024, 2048ull * 1024 / 8);
        for (int b = 0; b < 8; ++b) for (int h = 0; h < 4; ++h) {
            transpose_job(p.out + OUT_PMV + ((size_t)(l * 8 + b) * 256) * 1024 + h * 256, 1024, 256, 256, 0, nullptr, 1.0f, (bf16_t*)(ws + W_VT) + ((size_t)((l * 16 + b) * 4 + h)) * 65536, lds, rot); rot += 16; }
    }
}

__device__ __forceinline__ void gdn_prep(const Params& p, int l, LAS unsigned char* lds) {
    unsigned char* ws = p.ws; asm volatile("" : "+s"(ws));
    bf16_t* gbuf = (bf16_t*)(ws + R_GBUF); const bf16_t* halo = (const bf16_t*)(ws + R_HALO); const float* gates = (const float*)(ws + R_GATES); float* glb = (float*)(ws + W_GL);
    LAS bf16_t* qs = (LAS bf16_t*)lds;
    LAS bf16_t* ks = qs + 64 * 136; LAS bf16_t* vs = ks + 64 * 136;
    LAS float* Mm = (LAS float*)(lds + 52224);
    LAS float* gc = (LAS float*)(lds + 69632);
    LAS bf16_t* raw = (LAS bf16_t*)(lds + 70400);
    LAS float* solL = (LAS float*)(lds + 70400);
    int tid = threadIdx.x; asm volatile("" : "+v"(tid)); const int lane = tid & 63, wid = tid >> 6, fr = lane & 15, fq = lane >> 4;
    const float* convw = p.in[13] + (size_t)l * 4 * 1536;
    for (int item = blockIdx.x; item < 2080; item += gridDim.x) {
        const int chunk = item >> 2, h = item & 3; const bool samp = chunk >= 512; const int b = samp ? chunk - 512 : chunk >> 6, n = samp ? 0 : (chunk & 63);
        bf16_t* gi = gbuf + (size_t)item * GITEM;
        for (int pc = tid; pc < 67 * 48; pc += 512) { const int r = pc / 48, cp = pc % 48, which = cp >> 4, c8 = (cp & 15) * 8; u32x4 w = (u32x4){0u, 0u, 0u, 0u};
            if (r >= 3) w = *(const u32x4*)(gi + which * 8192 + (r - 3) * 128 + c8);
            else if (n > 0) w = *(const u32x4*)(halo + (size_t)((chunk - 1) * 3 + r) * 1536 + which * 512 + h * 128 + c8);
            else if (samp) { const float* st = p.in[4] + ((size_t)(l * 8 + b) * 3 + r) * 1536 + which * 512 + h * 128 + c8; const f32x4 a = *(const f32x4*)st, bb = *(const f32x4*)(st + 4);
                w.x = cvt_pk_bf16(a[0], a[1]); w.y = cvt_pk_bf16(a[2], a[3]); w.z = cvt_pk_bf16(bb[0], bb[1]); w.w = cvt_pk_bf16(bb[2], bb[3]); }
            *(LAS u32x4*)(raw + r * 392 + which * 128 + c8) = w; }
        __syncthreads();
        if (samp || n == 63) { float* o = p.out + (samp ? OUT_SAC : OUT_PAC) + (size_t)(l * 8 + b) * 3 * 1536;
            for (int i = tid; i < 3 * 384; i += 512) { const int j = i / 384, c = i % 384, which = c >> 7, d = c & 127; o[j * 1536 + which * 512 + h * 128 + d] = bf2f(raw[(64 + j) * 392 + c]); } }
        { const int row = tid >> 3, cgp = tid & 7;
#pragma unroll 1
          for (int which = 0; which < 3; ++which) { float y[16]; float ss = 0.f;
#pragma unroll
              for (int hf = 0; hf < 2; ++hf) { const int c = cgp * 16 + hf * 8; float a8[8] = {0.f, 0.f, 0.f, 0.f, 0.f, 0.f, 0.f, 0.f};
#pragma unroll
                  for (int j = 0; j < 4; ++j) { float x8[8]; unpack8(*(const LAS u32x4*)(raw + (row + j) * 392 + which * 128 + c), x8); const float* wp = convw + j * 1536 + which * 512 + h * 128 + c; const f32x4 w0 = *(const f32x4*)wp, w1 = *(const f32x4*)(wp + 4);
                      a8[0] += w0[0] * x8[0]; a8[1] += w0[1] * x8[1]; a8[2] += w0[2] * x8[2]; a8[3] += w0[3] * x8[3]; a8[4] += w1[0] * x8[4]; a8[5] += w1[1] * x8[5]; a8[6] += w1[2] * x8[6]; a8[7] += w1[3] * x8[7]; }
#pragma unroll
                  for (int i = 0; i < 8; ++i) { const float v = siluf_(a8[i]); y[hf * 8 + i] = v; ss += v * v; } }
              float sc = 1.0f;
              if (which < 2) { ss += __shfl_xor(ss, 1); ss += __shfl_xor(ss, 2); ss += __shfl_xor(ss, 4); sc = rsqrtf(ss + 1e-6f) * (which == 0 ? 0.08838834764831845f : 1.0f); }
#pragma unroll
              for (int i = 0; i < 16; ++i) y[i] *= sc;
              LAS bf16_t* dst = (which == 0 ? qs : (which == 1 ? ks : vs)) + row * 136 + cgp * 16;
              *(LAS u32x4*)dst = pack8(y); *(LAS u32x4*)(dst + 8) = pack8(y + 8); } }
        if (wid == 0) { const size_t rowg = (size_t)chunk * 64 + lane; const float ab = gates[rowg * 8 + h], aa = gates[rowg * 8 + 4 + h];
            const float beta = sigmoidf_(ab); float g = -__expf(p.in[14][l * 4 + h]) * softplusf_(aa + p.in[15][l * 4 + h]);
#pragma unroll
            for (int o = 1; o < 64; o <<= 1) { const float v = __shfl_up(g, o); if (lane >= o) g += v; }
            gc[lane] = g; gc[64 + lane] = beta; gc[128 + lane] = __expf(g); }
        __syncthreads();
        { const int ti = wid >> 1;
#pragma unroll
          for (int tjj = 0; tjj < 2; ++tjj) { const int tj = (wid & 1) * 2 + tjj;
              f32x4 akk = (f32x4){0.f, 0.f, 0.f, 0.f}, aqk = akk;
              if (tj <= ti) {
#pragma unroll
                  for (int kk = 0; kk < 4; ++kk) { const bf16x8 ak = *(const LAS bf16x8*)(ks + (ti * 16 + fr) * 136 + kk * 32 + fq * 8), aq = *(const LAS bf16x8*)(qs + (ti * 16 + fr) * 136 + kk * 32 + fq * 8), bk = *(const LAS bf16x8*)(ks + (tj * 16 + fr) * 136 + kk * 32 + fq * 8);
                      akk = mfma16(ak, bk, akk); aqk = mfma16(aq, bk, aqk); } }
              f32x4 mrow;
#pragma unroll
              for (int jj = 0; jj < 4; ++jj) { const int i = ti * 16 + fq * 4 + jj, j = tj * 16 + fr; float mval = 0.f, qv = 0.f;
                  if (j <= i) { const float dec = __expf(gc[i] - gc[j]); qv = aqk[jj] * dec; if (j < i) mval = gc[64 + i] * akk[jj] * dec; }
                  mrow[jj] = mval;
                  gi[32768 + i * 64 + j] = f2bf(qv); }
              if (tj <= ti) *(LAS f32x4*)(Mm + (tj * 16 + fr) * 68 + ti * 16 + fq * 4) = mrow; } }
        __syncthreads();
        if (tid < 256) { const int col = tid, isw = col >> 7, cc = col & 127; LAS const bf16_t* src = isw ? ks : vs;
#pragma unroll 1
            for (int I = 0; I < 4; ++I) { float r[16];
#pragma unroll
                for (int ii = 0; ii < 16; ++ii) { const int i = I * 16 + ii; float v = bf2f(src[i * 136 + cc]) * gc[64 + i]; if (isw) v *= gc[128 + i]; r[ii] = v; }
#pragma unroll 2
                for (int j = 0; j < I * 16; ++j) { const float sj = solL[j * 256 + col];
#pragma unroll
                    for (int q4 = 0; q4 < 4; ++q4) { const f32x4 mv = *(const LAS f32x4*)(Mm + j * 68 + I * 16 + q4 * 4); r[q4 * 4] -= mv[0] * sj; r[q4 * 4 + 1] -= mv[1] * sj; r[q4 * 4 + 2] -= mv[2] * sj; r[q4 * 4 + 3] -= mv[3] * sj; } }
#pragma unroll
                for (int jj = 0; jj < 15; ++jj) {
#pragma unroll
                    for (int q4 = 0; q4 < 4; ++q4) { if (q4 * 4 + 3 <= jj) continue; const f32x4 mv = *(const LAS f32x4*)(Mm + (I * 16 + jj) * 68 + I * 16 + q4 * 4);
#pragma unroll
                        for (int e = 0; e < 4; ++e) if (q4 * 4 + e > jj) r[q4 * 4 + e] -= mv[e] * r[jj]; } }
#pragma unroll
                for (int ii = 0; ii < 16; ++ii) solL[(I * 16 + ii) * 256 + col] = r[ii];
                if (!isw) { *(u32x4*)(gi + 16384 + cc * 64 + I * 16) = pack8(r); *(u32x4*)(gi + 16384 + cc * 64 + I * 16 + 8) = pack8(r + 8); }
                else {
#pragma unroll
                    for (int ii = 0; ii < 16; ++ii) gi[24576 + (I * 16 + ii) * 128 + cc] = f2bf(r[ii]); } }
        } else { const int t2 = tid - 256; const float glast = gc[63];
#pragma unroll
            for (int it = 0; it < 4; ++it) { const int idx = t2 + it * 256, i = idx >> 4, c8 = (idx & 15) * 8; float v[8]; unpack8(*(const LAS u32x4*)(qs + i * 136 + c8), v); const float e = gc[128 + i];
#pragma unroll
                for (int k = 0; k < 8; ++k) v[k] *= e;
                *(u32x4*)(gi + i * 128 + c8) = pack8(v); }
#pragma unroll
            for (int it = 0; it < 4; ++it) { const int idx = t2 + it * 256, d = idx >> 3, i8 = (idx & 7) * 8; float v[8];
#pragma unroll
                for (int k = 0; k < 8; ++k) v[k] = bf2f(ks[(i8 + k) * 136 + d]) * __expf(glast - gc[i8 + k]);
                *(u32x4*)(gi + 8192 + d * 64 + i8) = pack8(v); }
            if (t2 == 0) glb[item] = __expf(glast);
        }
        __syncthreads();
    }
}

__device__ __forceinline__ void hgrn_prep(const Params& p, int l, LAS unsigned char* lds) {
    unsigned char* ws = p.ws; asm volatile("" : "+s"(ws));
    bf16_t* hbuf = (bf16_t*)(ws + R_HBUF); float* eh = (float*)(ws + W_EH);
    LAS bf16_t* qt = (LAS bf16_t*)lds;
    LAS bf16_t* kt = qt + 64 * 72;
    LAS float* tot = (LAS float*)(lds + 2 * 64 * 72 * 2);
    int tid = threadIdx.x; asm volatile("" : "+v"(tid)); const int lane = tid & 63, wid = tid >> 6, fr = lane & 15, fq = lane >> 4;
    for (int item = blockIdx.x; item < 2080; item += gridDim.x) {
        const int h = item & 3; bf16_t* hi = hbuf + (size_t)item * HITEM;
        const int d = tid & 63, seg = tid >> 6;
        float lb = 0.f; if (l == 1) lb = sigmoidf_(p.in[24][256 + h * 64 + d] - p.in[24][h * 64 + d]);
        float qc[8], kf[8], bc[8], vv[8]; float run = 0.f;
#pragma unroll
        for (int i = 0; i < 8; ++i) { const int t = seg * 8 + i; const float cq = bf2f(hi[t * 64 + d]), cf = bf2f(hi[4096 + t * 64 + d]); vv[i] = bf2f(hi[8192 + t * 64 + d]);
            qc[i] = siluf_(cq); const float f = lb + (1.0f - lb) * sigmoidf_(cf); kf[i] = 1.0f - f; run += __logf(f); bc[i] = run; }
        tot[seg * 64 + d] = run;
        asm volatile("s_waitcnt vmcnt(0)" ::: "memory");
        __syncthreads();
        float pre = 0.f, ref = 0.f, all = 0.f;
#pragma unroll
        for (int s = 0; s < 8; ++s) { const float tv = tot[s * 64 + d]; if (s < seg) pre += tv; if (s < 4) ref += tv; all += tv; }
        { float qh8[8], kh8[8];
#pragma unroll
          for (int i = 0; i < 8; ++i) { const int t = seg * 8 + i; const float bct = pre + bc[i];
              qt[t * 72 + d] = f2bf(qc[i] * __expf(bct - ref)); kt[t * 72 + d] = f2bf(kf[i] * __expf(ref - bct));
              qh8[i] = qc[i] * __expf(bct); kh8[i] = kf[i] * __expf(all - bct); }
#pragma unroll
          for (int i = 0; i < 8; ++i) hi[(seg * 8 + i) * 64 + d] = f2bf(qh8[i]);
          *(u32x4*)(hi + 4096 + d * 64 + seg * 8) = pack8(kh8);
          *(u32x4*)(hi + 8192 + d * 64 + seg * 8) = pack8(vv);
          if (seg == 0) eh[(size_t)item * 64 + d] = __expf(all); }
        __syncthreads();
        { const int ti = wid >> 1;
#pragma unroll
          for (int tjj = 0; tjj < 2; ++tjj) { const int tj = (wid & 1) * 2 + tjj; f32x4 a = (f32x4){0.f, 0.f, 0.f, 0.f};
              if (tj <= ti) {
#pragma unroll
                  for (int kk = 0; kk < 2; ++kk) a = mfma16(*(const LAS bf16x8*)(qt + (ti * 16 + fr) * 72 + kk * 32 + fq * 8), *(const LAS bf16x8*)(kt + (tj * 16 + fr) * 72 + kk * 32 + fq * 8), a); }
#pragma unroll
              for (int jj = 0; jj < 4; ++jj) { const int i = ti * 16 + fq * 4 + jj, j = tj * 16 + fr; hi[12288 + i * 64 + j] = f2bf(j <= i ? a[jj] : 0.f); } } }
        __syncthreads();
    }
}

__device__ __forceinline__ void rg_prep(const Params& p, int l, LAS unsigned char* lds) {
    unsigned char* ws = p.ws; asm volatile("" : "+s"(ws));
    const bf16_t* bx = (const bf16_t*)(ws + R_BX); bf16_t* hloc = (bf16_t*)(ws + R_HLOC); bf16_t* pcum = (bf16_t*)(ws + R_PCUM); float* sumA = (float*)(ws + W_SUMA); float* sumH = (float*)(ws + W_SUMH);
    LAS bf16_t* xs = (LAS bf16_t*)lds;
    LAS bf16_t* wT = (LAS bf16_t*)(lds + 64 * 264 * 2);
    int tid = threadIdx.x; asm volatile("" : "+v"(tid)); const int lane = tid & 63, wid = tid >> 6, fr = lane & 15, fq = lane >> 4;
    const float* cw = p.in[17] + (size_t)l * 4 * 256; const float* cb = p.in[18] + l * 256;
    for (int idx = tid; idx < 32768; idx += 512) { const int g = idx >> 14, nb = (idx >> 12) & 3, i = (idx >> 6) & 63, j = idx & 63; const float v = (g ? p.in[21] : p.in[19])[(size_t)l * 16384 + nb * 4096 + i * 64 + j];
        wT[((g * 4 + nb) * 64 + j) * 72 + i] = f2bf(v); }
    for (int chunk = blockIdx.x; chunk < NCHUNK; chunk += gridDim.x) {
        const bool samp = chunk >= 512; const int b = samp ? chunk - 512 : chunk >> 6, n = samp ? 0 : (chunk & 63);
        __syncthreads();
        { const int row = tid >> 3, cgp = tid & 7;
#pragma unroll
          for (int q8 = 0; q8 < 4; ++q8) { const int c = cgp * 32 + q8 * 8; float a8[8];
              { const f32x4 b0 = *(const f32x4*)(cb + c), b1 = *(const f32x4*)(cb + c + 4); a8[0] = b0[0]; a8[1] = b0[1]; a8[2] = b0[2]; a8[3] = b0[3]; a8[4] = b1[0]; a8[5] = b1[1]; a8[6] = b1[2]; a8[7] = b1[3]; }
#pragma unroll
              for (int j = 0; j < 4; ++j) { const int rr = row - 3 + j; float x8[8] = {0.f, 0.f, 0.f, 0.f, 0.f, 0.f, 0.f, 0.f};
                  if (rr >= 0 || n > 0) unpack8(*(const u32x4*)(bx + ((size_t)chunk * 64 + rr) * 256 + c), x8);
                  else if (samp) { const float* st = p.in[6] + ((size_t)(l * 8 + b) * 3 + (3 + rr)) * 256 + c; const f32x4 s0 = *(const f32x4*)st, s1 = *(const f32x4*)(st + 4); x8[0] = s0[0]; x8[1] = s0[1]; x8[2] = s0[2]; x8[3] = s0[3]; x8[4] = s1[0]; x8[5] = s1[1]; x8[6] = s1[2]; x8[7] = s1[3]; }
                  const f32x4 w0 = *(const f32x4*)(cw + j * 256 + c), w1 = *(const f32x4*)(cw + j * 256 + c + 4);
                  a8[0] += w0[0] * x8[0]; a8[1] += w0[1] * x8[1]; a8[2] += w0[2] * x8[2]; a8[3] += w0[3] * x8[3]; a8[4] += w1[0] * x8[4]; a8[5] += w1[1] * x8[5]; a8[6] += w1[2] * x8[6]; a8[7] += w1[3] * x8[7]; }
              *(LAS u32x4*)(xs + row * 264 + c) = pack8(a8); } }
        if (samp || n == 63) { float* o = p.out + (samp ? OUT_SBC : OUT_PBC) + (size_t)(l * 8 + b) * 3 * 256;
            for (int i = tid; i < 768; i += 512) { const int j = i >> 8, c = i & 255; o[j * 256 + c] = bf2f(bx[((size_t)chunk * 64 + 61 + j) * 256 + c]); } }
        __syncthreads();
#pragma unroll 1
        for (int pp = 0; pp < 2; ++pp) { const int pair = wid * 2 + pp, nb = pair >> 2, tj = pair & 3, ch = nb * 64 + tj * 16 + fr;
            const float br = p.in[20][l * 256 + ch], bi = p.in[22][l * 256 + ch], sp = softplusf_(-p.in[23][l * 256 + ch]);
            float Ac = 1.0f, Hc = 0.0f;
#pragma unroll 1
            for (int ti = 0; ti < 4; ++ti) { f32x4 ar = (f32x4){0.f, 0.f, 0.f, 0.f}, aig = ar;
#pragma unroll
                for (int kk = 0; kk < 2; ++kk) { const bf16x8 a = *(const LAS bf16x8*)(xs + (ti * 16 + fr) * 264 + nb * 64 + kk * 32 + fq * 8);
                    ar = mfma16(a, *(const LAS bf16x8*)(wT + ((0 * 4 + nb) * 64 + tj * 16 + fr) * 72 + kk * 32 + fq * 8), ar);
                    aig = mfma16(a, *(const LAS bf16x8*)(wT + ((1 * 4 + nb) * 64 + tj * 16 + fr) * 72 + kk * 32 + fq * 8), aig); }
                float Aj[4], Hj[4]; float Ar = 1.0f, Hr = 0.0f;
#pragma unroll
                for (int jj = 0; jj < 4; ++jj) { const int tok = ti * 16 + fq * 4 + jj; const float r = sigmoidf_(ar[jj] + br), ig = sigmoidf_(aig[jj] + bi); const float la = -8.0f * r * sp; const float a = __expf(la);
                    const float mult = sqrtf(fmaxf(1.0f - __expf(2.0f * la), 0.0f)); const float uu = mult * ig * bf2f(xs[tok * 264 + ch]);
                    Hr = a * Hr + uu; Ar = a * Ar; Aj[jj] = Ar; Hj[jj] = Hr; }
                float Ap = Ac, Hp = Hc;
#pragma unroll
                for (int qd = 0; qd < 4; ++qd) { const float Aq = __shfl(Ar, qd * 16 + fr), Hq = __shfl(Hr, qd * 16 + fr);
                    if (qd < fq) { Hp = Aq * Hp + Hq; Ap = Aq * Ap; }
                    Hc = Aq * Hc + Hq; Ac = Aq * Ac; }
#pragma unroll
                for (int jj = 0; jj < 4; ++jj) { const size_t o = ((size_t)chunk * 64 + ti * 16 + fq * 4 + jj) * 256 + ch; hloc[o] = f2bf(Hj[jj] + Aj[jj] * Hp); pcum[o] = f2bf(Aj[jj] * Ap); } }
            if (fq == 0) { sumA[(size_t)chunk * 256 + ch] = Ac; sumH[(size_t)chunk * 256 + ch] = Hc; } }
    }
    __syncthreads();
}

__device__ __forceinline__ void gdn_scan(const Params& p, int l, int seq, int h, int slice, LAS unsigned char* lds) {
    unsigned char* ws = p.ws; asm volatile("" : "+s"(ws)); bf16_t* gbuf = (bf16_t*)(ws + R_GBUF); const float* glb = (const float*)(ws + W_GL); bf16_t* obuf = (bf16_t*)(ws + W_XB);
    LAS bf16_t* StL = (LAS bf16_t*)lds;
    LAS bf16_t* VtL = StL + 32 * 136;
    int tid = threadIdx.x; asm volatile("" : "+v"(tid)); const int lane = tid & 63, w = tid >> 6, fr = lane & 15, fq = lane >> 4;
    const bool samp = seq >= 8; const int b = seq & 7; const int nsteps = samp ? 1 : 64, chunk0 = samp ? 512 + b : b * 64;
    f32x4 S[2];
#pragma unroll
    for (int nt = 0; nt < 2; ++nt) { S[nt] = (f32x4){0.f, 0.f, 0.f, 0.f};
        if (samp) { const float* s0 = p.in[5] + ((size_t)((l * 8 + b) * 4 + h)) * 16384;
#pragma unroll
            for (int jj = 0; jj < 4; ++jj) S[nt][jj] = s0[(w * 16 + fq * 4 + jj) * 128 + slice * 32 + nt * 16 + fr]; } }
    for (int step = 0; step < nsteps; ++step) {
        const int item = (chunk0 + step) * 4 + h; bf16_t* gi = gbuf + (size_t)item * GITEM;
#pragma unroll
        for (int nt = 0; nt < 2; ++nt) { u32x2 wv; wv.x = cvt_pk_bf16(S[nt][0], S[nt][1]); wv.y = cvt_pk_bf16(S[nt][2], S[nt][3]); *(LAS u32x2*)(StL + (nt * 16 + fr) * 136 + w * 16 + fq * 4) = wv; }
        __syncthreads();
        const int mt = w & 3; f32x4 acc[2] = {(f32x4){0.f, 0.f, 0.f, 0.f}, (f32x4){0.f, 0.f, 0.f, 0.f}};
        { const bf16_t* Ab = gi + (w < 4 ? 24576 : 0) + (mt * 16 + fr) * 128 + fq * 8;
#pragma unroll
          for (int kk = 0; kk < 4; ++kk) { const bf16x8 a = *(const bf16x8*)(Ab + kk * 32);
#pragma unroll
              for (int nt = 0; nt < 2; ++nt) acc[nt] = mfma16(a, *(const LAS bf16x8*)(StL + (nt * 16 + fr) * 136 + kk * 32 + fq * 8), acc[nt]); } }
        if (w < 4) {
#pragma unroll
            for (int nt = 0; nt < 2; ++nt) { const u32x2 uw = *(const u32x2*)(gi + 16384 + (slice * 32 + nt * 16 + fr) * 64 + mt * 16 + fq * 4);
                u32x2 vw; vw.x = cvt_pk_bf16(lo_bf(uw.x) - acc[nt][0], hi_bf(uw.x) - acc[nt][1]); vw.y = cvt_pk_bf16(lo_bf(uw.y) - acc[nt][2], hi_bf(uw.y) - acc[nt][3]);
                *(LAS u32x2*)(VtL + (nt * 16 + fr) * 72 + mt * 16 + fq * 4) = vw; } }
        __syncthreads();
        bf16x8 vB[2][2];
#pragma unroll
        for (int nt = 0; nt < 2; ++nt)
#pragma unroll
            for (int kk = 0; kk < 2; ++kk) vB[nt][kk] = *(const LAS bf16x8*)(VtL + (nt * 16 + fr) * 72 + kk * 32 + fq * 8);
        if (w >= 4) {
#pragma unroll
            for (int kk = 0; kk < 2; ++kk) { const bf16x8 a = *(const bf16x8*)(gi + 32768 + (mt * 16 + fr) * 64 + kk * 32 + fq * 8);
#pragma unroll
                for (int nt = 0; nt < 2; ++nt) acc[nt] = mfma16(a, vB[nt][kk], acc[nt]); }
#pragma unroll
            for (int nt = 0; nt < 2; ++nt) { u32x2 ow; ow.x = cvt_pk_bf16(acc[nt][0], acc[nt][1]); ow.y = cvt_pk_bf16(acc[nt][2], acc[nt][3]);
                *(u32x2*)(obuf + (size_t)item * 8192 + (slice * 32 + nt * 16 + fr) * 64 + mt * 16 + fq * 4) = ow; } }
        { const float gl = glb[item];
#pragma unroll
          for (int nt = 0; nt < 2; ++nt) S[nt] *= gl;
#pragma unroll
          for (int kk = 0; kk < 2; ++kk) { const bf16x8 a = *(const bf16x8*)(gi + 8192 + (w * 16 + fr) * 64 + kk * 32 + fq * 8);
#pragma unroll
              for (int nt = 0; nt < 2; ++nt) S[nt] = mfma16(a, vB[nt][kk], S[nt]); } }
    }
    float* so = p.out + (samp ? OUT_SAS : OUT_PAS) + ((size_t)((l * 8 + b) * 4 + h)) * 16384;
#pragma unroll
    for (int nt = 0; nt < 2; ++nt)
#pragma unroll
        for (int jj = 0; jj < 4; ++jj) so[(w * 16 + fq * 4 + jj) * 128 + slice * 32 + nt * 16 + fr] = S[nt][jj];
    __syncthreads();
}
__device__ __forceinline__ void hgrn_scan(const Params& p, int l, int seq, int h, int slice, LAS unsigned char* lds) {
    unsigned char* ws = p.ws; asm volatile("" : "+s"(ws)); bf16_t* hbuf = (bf16_t*)(ws + R_HBUF); const float* eh = (const float*)(ws + W_EH);
    LAS bf16_t* StL = (LAS bf16_t*)lds;
    int tid = threadIdx.x; asm volatile("" : "+v"(tid)); const int lane = tid & 63, w = tid >> 6, fr = lane & 15, fq = lane >> 4;
    const bool samp = seq >= 8; const int b = seq & 7; const int nsteps = samp ? 1 : 64, chunk0 = samp ? 512 + b : b * 64;
    const int wd = w & 3;
    f32x4 S = (f32x4){0.f, 0.f, 0.f, 0.f};
    if (samp) { const float* s0 = p.in[8] + ((size_t)((l * 8 + b) * 4 + h)) * 4096;
#pragma unroll
        for (int jj = 0; jj < 4; ++jj) S[jj] = s0[(wd * 16 + fq * 4 + jj) * 64 + slice * 16 + fr]; }
    for (int step = 0; step < nsteps; ++step) {
        const int item = (chunk0 + step) * 4 + h; bf16_t* hi = hbuf + (size_t)item * HITEM;
        if (w < 4) { u32x2 wv; wv.x = cvt_pk_bf16(S[0], S[1]); wv.y = cvt_pk_bf16(S[2], S[3]); *(LAS u32x2*)(StL + fr * 72 + w * 16 + fq * 4) = wv; }
        __syncthreads();
        bf16x8 vB[2];
#pragma unroll
        for (int kk = 0; kk < 2; ++kk) vB[kk] = *(const bf16x8*)(hi + 8192 + (slice * 16 + fr) * 64 + kk * 32 + fq * 8);
        f32x4 o = (f32x4){0.f, 0.f, 0.f, 0.f};
        if (w >= 4) { const int mt = w - 4;
#pragma unroll
            for (int kk = 0; kk < 2; ++kk) o = mfma16(*(const bf16x8*)(hi + (mt * 16 + fr) * 64 + kk * 32 + fq * 8), *(const LAS bf16x8*)(StL + fr * 72 + kk * 32 + fq * 8), o);
#pragma unroll
            for (int kk = 0; kk < 2; ++kk) o = mfma16(*(const bf16x8*)(hi + 12288 + (mt * 16 + fr) * 64 + kk * 32 + fq * 8), vB[kk], o);
        } else { const f32x4 ev = *(const f32x4*)(eh + (size_t)item * 64 + w * 16 + fq * 4); S = S * ev;
#pragma unroll
            for (int kk = 0; kk < 2; ++kk) S = mfma16(*(const bf16x8*)(hi + 4096 + (w * 16 + fr) * 64 + kk * 32 + fq * 8), vB[kk], S); }
        asm volatile("s_waitcnt vmcnt(0)" ::: "memory");
        __syncthreads();
        if (w >= 4) { const int mt = w - 4; u32x2 ow; ow.x = cvt_pk_bf16(o[0], o[1]); ow.y = cvt_pk_bf16(o[2], o[3]); *(u32x2*)(hi + 8192 + (slice * 16 + fr) * 64 + mt * 16 + fq * 4) = ow; }
    }
    if (w < 4) { float* so = p.out + (samp ? OUT_SCS : OUT_PCS) + ((size_t)((l * 8 + b) * 4 + h)) * 4096;
#pragma unroll
        for (int jj = 0; jj < 4; ++jj) so[(w * 16 + fq * 4 + jj) * 64 + slice * 16 + fr] = S[jj]; }
    __syncthreads();
}
__device__ __forceinline__ void scan_phase(const Params& p, int l, LAS unsigned char* lds) {
    for (int x = blockIdx.x; x < 256; x += gridDim.x) {
        const int y = x & 127, xcd = y & 7, r = y >> 3, chain = xcd * 4 + (r >> 2), slice = r & 3, b = chain >> 2, h = chain & 3;
        if (x < 128) {
#pragma unroll 1
            for (int sq = 0; sq < 2; ++sq) gdn_scan(p, l, sq * 8 + b, h, slice, lds); }
        else {
#pragma unroll 1
            for (int sq = 0; sq < 2; ++sq) hgrn_scan(p, l, sq * 8 + b, h, slice, lds); }
    }
}

__device__ __forceinline__ void apply_phase(const Params& p, int l, LAS unsigned char* lds) {
    unsigned char* ws = p.ws; asm volatile("" : "+s"(ws));
    const bf16_t* gbuf = (const bf16_t*)(ws + R_GBUF); const bf16_t* hbuf = (const bf16_t*)(ws + R_HBUF); bf16_t* zbuf = (bf16_t*)(ws + R_ZBUF);
    const bf16_t* hloc = (const bf16_t*)(ws + R_HLOC); const bf16_t* pcum = (const bf16_t*)(ws + R_PCUM); const float* sumA = (const float*)(ws + W_SUMA); const float* sumH = (const float*)(ws + W_SUMH);
    LAS bf16_t* ot = (LAS bf16_t*)lds;
    int tid = threadIdx.x; asm volatile("" : "+v"(tid));
    for (int it = blockIdx.x; it < NCHUNK * 9; it += gridDim.x) {
        const int chunk = it / 9, sub = it % 9; const bool samp = chunk >= 512; const int b = samp ? chunk - 512 : chunk >> 6, n = samp ? 0 : (chunk & 63);
        if (sub < 4) { const int h = sub; const bf16_t* oT = (const bf16_t*)(ws + W_XB) + (size_t)(chunk * 4 + h) * 8192;
            __syncthreads();
#pragma unroll
            for (int i = 0; i < 2; ++i) { const int pc = tid + i * 512, dv = pc >> 3, t8 = (pc & 7) * 8; *(LAS u32x4*)(ot + dv * 72 + t8) = *(const u32x4*)(oT + dv * 64 + t8); }
            __syncthreads();
            const int tok = tid >> 3, cgp = tid & 7; float v[16]; float ss = 0.f;
#pragma unroll
            for (int i = 0; i < 16; ++i) { v[i] = bf2f(ot[(cgp * 16 + i) * 72 + tok]); ss += v[i] * v[i]; }
            ss += __shfl_xor(ss, 1); ss += __shfl_xor(ss, 2); ss += __shfl_xor(ss, 4);
            const float rn = rsqrtf(ss * (1.0f / 128.0f) + EPS);
            bf16_t* zp = zbuf + ((size_t)chunk * 64 + tok) * 1024 + h * 128 + cgp * 16; const float* an = p.in[16] + l * 128 + cgp * 16;
            float z[16]; unpack8(*(const u32x4*)zp, z); unpack8(*(const u32x4*)(zp + 8), z + 8);
#pragma unroll
            for (int i = 0; i < 16; ++i) v[i] = v[i] * rn * an[i] * siluf_(z[i]);
            *(u32x4*)zp = pack8(v); *(u32x4*)(zp + 8) = pack8(v + 8);
        } else if (sub < 8) { const int h = sub - 4; const bf16_t* oT = hbuf + (size_t)(chunk * 4 + h) * HITEM + 8192;
            __syncthreads();
            { const int dv = tid >> 3, t8 = (tid & 7) * 8; *(LAS u32x4*)(ot + dv * 72 + t8) = *(const u32x4*)(oT + dv * 64 + t8); }
            __syncthreads();
            const int tok = tid >> 3, cgp = tid & 7; float v[8]; float ss = 0.f;
#pragma unroll
            for (int i = 0; i < 8; ++i) { v[i] = bf2f(ot[(cgp * 8 + i) * 72 + tok]); ss += v[i] * v[i]; }
            ss += __shfl_xor(ss, 1); ss += __shfl_xor(ss, 2); ss += __shfl_xor(ss, 4);
            const float rn = rsqrtf(ss * (1.0f / 64.0f) + EPS);
            bf16_t* zp = zbuf + ((size_t)chunk * 64 + tok) * 1024 + 768 + h * 64 + cgp * 8; const float* cn = p.in[25] + l * 64 + cgp * 8;
            float z[8]; unpack8(*(const u32x4*)zp, z);
#pragma unroll
            for (int i = 0; i < 8; ++i) v[i] = v[i] * rn * cn[i] * siluf_(z[i]);
            *(u32x4*)zp = pack8(v);
        } else { const int ch = tid & 255, half = tid >> 8;
            float hin = samp ? p.in[7][(size_t)(l * 8 + b) * 256 + ch] : 0.f;
            for (int m = 0; m < n; ++m) { const size_t o = (size_t)(chunk - n + m) * 256 + ch; hin = sumA[o] * hin + sumH[o]; }
            for (int t = half * 32; t < half * 32 + 32; ++t) { const size_t row = (size_t)chunk * 64 + t; const float hv = bf2f(hloc[row * 256 + ch]) + bf2f(pcum[row * 256 + ch]) * hin;
                bf16_t* zp = zbuf + row * 1024 + 512 + ch; *zp = f2bf(hv * gelu_tanh(bf2f(*zp)));
                if (t == 63 && (samp || n == 63)) p.out[(samp ? OUT_SBH : OUT_PBH) + (size_t)(l * 8 + b) * 256 + ch] = hv; }
        }
    }
    __syncthreads();
}

__device__ __forceinline__ void attn_phase(const Params& p, int l, LAS unsigned char* lds) {
    unsigned char* ws = p.ws; asm volatile("" : "+s"(ws));
    const bf16_t* qbuf = (const bf16_t*)(ws + R_QBUF); bf16_t* oatt = (bf16_t*)(ws + R_OATT);
    int tid = threadIdx.x; asm volatile("" : "+v"(tid)); const int lane = tid & 63, w = tid >> 6, fr = lane & 15, fq = lane >> 4;
    for (int item = blockIdx.x; item < 1056; item += gridDim.x) {
        int row0, seq, h, nw;
        if (item < 1024) { const int tile = item >> 2; h = item & 3; row0 = tile * 128; seq = row0 >> 12; nw = 8; }
        else { const int i2 = item - 1024; seq = 8 + (i2 >> 2); h = i2 & 3; row0 = T_P + (i2 >> 2) * 64; nw = 4; }
        const bf16_t* Kp = (const bf16_t*)(ws + W_KB) + (size_t)(l * 16 + seq) * 256 * 1024 + h * 256;
        const bf16_t* Vp = (const bf16_t*)(ws + W_VT) + (size_t)((l * 16 + seq) * 4 + h) * 65536;
        const bool active = w < nw;
        const int qrow = row0 + (active ? w : 0) * 16 + fr;
        bf16x8 qB[8];
#pragma unroll
        for (int kk = 0; kk < 8; ++kk) qB[kk] = *(const bf16x8*)(qbuf + (size_t)qrow * 1024 + h * 256 + kk * 32 + fq * 8);
        f32x4 sacc[16];
#pragma unroll
        for (int i = 0; i < 16; ++i) sacc[i] = (f32x4){0.f, 0.f, 0.f, 0.f};
        bf16x8 pk[8]; float inv = 0.f;
        u32x4 st[4];
#pragma unroll
        for (int i = 0; i < 4; ++i) { const int idx = tid + i * 512, r = idx >> 5, c8 = (idx & 31) * 8; st[i] = *(const u32x4*)(Kp + (size_t)r * 1024 + c8); }
        __syncthreads();
        auto round = [&](auto R8c) __attribute__((always_inline)) {
            constexpr int r8 = decltype(R8c)::value;
            LAS bf16_t* buf = (LAS bf16_t*)(lds + (r8 & 1) * 33792);
#pragma unroll
            for (int i = 0; i < 4; ++i) { const int idx = tid + i * 512, r = idx >> 5, c8 = (idx & 31) * 8; *(LAS u32x4*)(buf + r * 264 + c8) = st[i]; }
            __syncthreads();
            if constexpr (r8 < 7) { constexpr int nr = r8 + 1;
#pragma unroll
                for (int i = 0; i < 4; ++i) { const int idx = tid + i * 512, r = idx >> 5, c8 = (idx & 31) * 8;
                    st[i] = nr < 4 ? *(const u32x4*)(Kp + (size_t)(nr * 64 + r) * 1024 + c8) : *(const u32x4*)(Vp + (size_t)((nr - 4) * 64 + r) * 256 + c8); } }
            if (active) {
                if constexpr (r8 < 4) {
#pragma unroll
                    for (int mt = 0; mt < 4; ++mt)
#pragma unroll
                        for (int kk = 0; kk < 8; ++kk) sacc[r8 * 4 + mt] = mfma16(*(const LAS bf16x8*)(buf + (mt * 16 + fr) * 264 + kk * 32 + fq * 8), qB[kk], sacc[r8 * 4 + mt]);
                    if constexpr (r8 == 3) { float mx = -3.0e38f;
#pragma unroll
                        for (int i = 0; i < 16; ++i) mx = fmaxf(mx, fmaxf(fmaxf(sacc[i][0], sacc[i][1]), fmaxf(sacc[i][2], sacc[i][3])));
                        mx = fmaxf(mx, __shfl_xor(mx, 16)); mx = fmaxf(mx, __shfl_xor(mx, 32));
                        float sm = 0.f;
#pragma unroll
                        for (int i = 0; i < 16; ++i) {
#pragma unroll
                            for (int jj = 0; jj < 4; ++jj) { const float e = __expf(sacc[i][jj] - mx); sacc[i][jj] = e; sm += e; } }
                        sm += __shfl_xor(sm, 16); sm += __shfl_xor(sm, 32); inv = 1.0f / sm;
#pragma unroll
                        for (int s = 0; s < 8; ++s) { u32x4 wv; wv.x = cvt_pk_bf16(sacc[2 * s][0], sacc[2 * s][1]); wv.y = cvt_pk_bf16(sacc[2 * s][2], sacc[2 * s][3]); wv.z = cvt_pk_bf16(sacc[2 * s + 1][0], sacc[2 * s + 1][1]); wv.w = cvt_pk_bf16(sacc[2 * s + 1][2], sacc[2 * s + 1][3]);
                            pk[s] = __builtin_bit_cast(bf16x8, wv); } }
                } else { constexpr int dt = r8 - 4;
#pragma unroll
                    for (int mt = 0; mt < 4; ++mt) { f32x4 o = (f32x4){0.f, 0.f, 0.f, 0.f};
#pragma unroll
                        for (int s = 0; s < 8; ++s) { const u32x2 lo = *(const LAS u32x2*)(buf + (mt * 16 + fr) * 264 + 32 * s + 4 * fq), hi2 = *(const LAS u32x2*)(buf + (mt * 16 + fr) * 264 + 32 * s + 16 + 4 * fq);
                            u32x4 av; av.x = lo.x; av.y = lo.y; av.z = hi2.x; av.w = hi2.y; o = mfma16(__builtin_bit_cast(bf16x8, av), pk[s], o); }
                        u32x2 ow; ow.x = cvt_pk_bf16(o[0] * inv, o[1] * inv); ow.y = cvt_pk_bf16(o[2] * inv, o[3] * inv);
                        *(u32x2*)(oatt + (size_t)qrow * 1024 + h * 256 + dt * 64 + mt * 16 + fq * 4) = ow; } }
            }
        };
        round(std::integral_constant<int, 0>{}); round(std::integral_constant<int, 1>{}); round(std::integral_constant<int, 2>{}); round(std::integral_constant<int, 3>{});
        round(std::integral_constant<int, 4>{}); round(std::integral_constant<int, 5>{}); round(std::integral_constant<int, 6>{}); round(std::integral_constant<int, 7>{});
    }
    __syncthreads();
}

__device__ __forceinline__ void final_norm(const Params& p) {
    const float* ssq = (const float*)(p.ws + W_SSQ) + 6ull * T_ALL; const float* g = p.in[38]; float* y = p.out + OUT_Y;
    int tidl = threadIdx.x; asm volatile("" : "+v"(tidl)); const int lane = tidl & 63, gw = blockIdx.x * 8 + (tidl >> 6), nw = gridDim.x * 8;
    for (int r = gw; r < T_ALL; r += nw) { const float rs = rsqrtf(ssq[r] * (1.0f / 1024.0f) + EPS);
#pragma unroll
        for (int i = 0; i < 4; ++i) { const int c = i * 256 + lane * 4; f32x4 x = *(const f32x4*)(y + (size_t)r * 1024 + c); const f32x4 gg = *(const f32x4*)(g + c); x = x * rs * gg; *(f32x4*)(y + (size_t)r * 1024 + c) = x; } }
}

__global__ void __launch_bounds__(512, 2) hybrid_fwd(Params p) {
    extern __shared__ __attribute__((aligned(16))) unsigned char smem[];
    LAS unsigned char* lds = (LAS unsigned char*)smem;
    cg::grid_group grid = cg::this_grid();
    unsigned char* ws = p.ws; asm volatile("" : "+s"(ws));
    float* ssq = (float*)(ws + W_SSQ);
    bf16_t* xb = (bf16_t*)(ws + W_XB) + XB_PRE * 1024;
    float* xf = p.out + OUT_Y;

    phase0(p, lds);
    grid.sync();
    { EpiKV E{p.out, ssq + 7ull * T_ALL}; pg8::gemm_phase<EpiKV, 0>(lds, (const bf16_t*)(ws + W_MEMB), (const bf16_t*)(ws + W_BKV), 1024, 8, 16, E); }
    grid.sync();
#pragma unroll 1
    for (int l_ = 0; l_ < 2; ++l_) {
        int l = l_; asm volatile("" : "+s"(l));
        { EpiProj E{ws, ssq + (size_t)(3 * l) * T_ALL}; pg8::gemm_phase<EpiProj, 0>(lds, xb, (const bf16_t*)(ws + W_BIN) + (size_t)l * NINP * 1024, 1024, 130, 15, E); }
        if (l == 0) kv_prompt_convert(p, lds);
        grid.sync();
        if (STOP_AFTER <= 1) return;
        gdn_prep(p, l, lds); hgrn_prep(p, l, lds); rg_prep(p, l, lds);
        grid.sync();
        if (STOP_AFTER <= 2) return;
        scan_phase(p, l, lds);
        grid.sync();
        if (STOP_AFTER <= 3) return;
        apply_phase(p, l, lds);
        grid.sync();
        if (STOP_AFTER <= 4) return;
        { EpiRes E{xf, xb, ssq + (size_t)(3 * l + 1) * T_ALL}; pg8::gemm_phase<EpiRes, 0>(lds, (const bf16_t*)(ws + R_ZBUF), (const bf16_t*)(ws + W_BOUT) + (size_t)l * 1024 * 1024, 1024, 130, 4, E); }
        grid.sync();
        { EpiQ E{(bf16_t*)(ws + R_QBUF), ssq + (size_t)(3 * l + 1) * T_ALL}; pg8::gemm_phase<EpiQ, 0>(lds, xb, (const bf16_t*)(ws + W_BQ) + (size_t)l * 1024 * 1024, 1024, 130, 4, E); }
        grid.sync();
        if (STOP_AFTER <= 5) return;
        attn_phase(p, l, lds);
        grid.sync();
        if (STOP_AFTER <= 6) return;
        { EpiRes E{xf, xb, ssq + (size_t)(3 * l + 2) * T_ALL}; pg8::gemm_phase<EpiRes, 0>(lds, (const bf16_t*)(ws + R_OATT), (const bf16_t*)(ws + W_BO) + (size_t)l * 1024 * 1024, 1024, 130, 4, E); }
        grid.sync();
        { EpiUp E{(bf16_t*)(ws + R_ACT), ssq + (size_t)(3 * l + 2) * T_ALL, p.in[35] + (size_t)l * 3 * DFF2, p.in[36] + (size_t)l * DFF2, p.in[9] + (size_t)l * 8 * 2 * DFF2, p.out + OUT_PFC + (size_t)l * 8 * 2 * DFF2, p.out + OUT_SFC + (size_t)l * 8 * 2 * DFF2};
          if (STOP_AFTER <= 7) return;
          pg8::gemm_phase<EpiUp, 1>(lds, xb - 2 * 1024, (const bf16_t*)(ws + W_BUP) + (size_t)l * DFF2 * 1024, 1024, 133, 22, E); }
        grid.sync();
        if (STOP_AFTER <= 8) return;
        { EpiRes E{xf, xb, ssq + (size_t)(3 * l + 3) * T_ALL}; pg8::gemm_phase<EpiRes, 0>(lds, (const bf16_t*)(ws + R_ACT), (const bf16_t*)(ws + W_BDN) + (size_t)l * 1024 * DFF, DFF, 130, 4, E); }
        grid.sync();
    }
    final_norm(p);
}

extern "C" void kernel_launch(void* const* d_in, const int* in_sizes, int n_in, void* d_out, int out_size, void* d_ws, size_t ws_size, hipStream_t stream) {
    static int grid = 0;
    if (grid == 0) {
        if (n_in != 39 || (size_t)out_size != OUT_TOTAL || ws_size < WS_NEED) { fprintf(stderr, "kernel_launch: unexpected shapes (n_in %d out %d ws %zu need %zu)\n", n_in, out_size, ws_size, (size_t)WS_NEED); grid = -1; return; }
        int dev = 0, cus = 0, per_cu = 0;
        hipGetDevice(&dev); hipDeviceGetAttribute(&cus, hipDeviceAttributeMultiprocessorCount, dev);
        hipFuncSetAttribute((const void*)hybrid_fwd, hipFuncAttributeMaxDynamicSharedMemorySize, LDS_BYTES);
        hipOccupancyMaxActiveBlocksPerMultiprocessor(&per_cu, (const void*)hybrid_fwd, 512, LDS_BYTES);
        if (per_cu < 1) per_cu = 1;
        (void)hipGetLastError();
        grid = cus * 1;
        if (grid > 256) grid = 256;
    }
    if (grid < 0) return;
    Params p{};
    for (int i = 0; i < 39; ++i) p.in[i] = (const float*)d_in[i];
    p.out = (float*)d_out; p.ws = (unsigned char*)d_ws;
    void* args[] = {&p};
    hipError_t e = hipLaunchCooperativeKernel((const void*)hybrid_fwd, dim3(grid), dim3(512), args, LDS_BYTES, stream);
    if (e != hipSuccess) fprintf(stderr, "cooperative launch failed: %s (grid %d)\n", hipGetErrorString(e), grid);
}
```

```cpp
#include <hip/hip_runtime.h>
#include <hip/hip_cooperative_groups.h>
#include <cstdio>
#include <type_traits>
namespace cg = cooperative_groups;

#define LAS __attribute__((address_space(3)))
typedef unsigned short bf16_t;
typedef short bf16x8 __attribute__((ext_vector_type(8)));
typedef short bf16x4 __attribute__((ext_vector_type(4)));
typedef float f32x4 __attribute__((ext_vector_type(4)));
typedef unsigned u32x4 __attribute__((ext_vector_type(4)));
typedef unsigned u32x2 __attribute__((ext_vector_type(2)));

constexpr int T_ALL = 33280, T_P = 32768, NCHUNK = 520, DM = 1024, NINP = 3840, DFF = 2816, DFF2 = 5632;
constexpr float EPS = 1e-6f;
constexpr size_t OUT_Y = 0;
constexpr size_t OUT_PMK = OUT_Y + (size_t)T_ALL * 1024;
constexpr size_t OUT_PMV = OUT_PMK + 2ull * 8 * 256 * 1024;
constexpr size_t SZ_AC = 2ull * 8 * 3 * 1536, SZ_AS = 2ull * 8 * 4 * 128 * 128, SZ_BC = 2ull * 8 * 3 * 256, SZ_BH = 2ull * 8 * 256, SZ_CS = 2ull * 8 * 4 * 64 * 64, SZ_FC = 2ull * 8 * 2 * 5632;
constexpr size_t OUT_PAC = OUT_PMV + 2ull * 8 * 256 * 1024;
constexpr size_t OUT_PAS = OUT_PAC + SZ_AC;
constexpr size_t OUT_PBC = OUT_PAS + SZ_AS;
constexpr size_t OUT_PBH = OUT_PBC + SZ_BC;
constexpr size_t OUT_PCS = OUT_PBH + SZ_BH;
constexpr size_t OUT_PFC = OUT_PCS + SZ_CS;
constexpr size_t OUT_SAC = OUT_PFC + SZ_FC;
constexpr size_t OUT_SAS = OUT_SAC + SZ_AC;
constexpr size_t OUT_SBC = OUT_SAS + SZ_AS;
constexpr size_t OUT_SBH = OUT_SBC + SZ_BC;
constexpr size_t OUT_SCS = OUT_SBH + SZ_BH;
constexpr size_t OUT_SFC = OUT_SCS + SZ_CS;
constexpr size_t OUT_TOTAL = OUT_SFC + SZ_FC;

constexpr size_t AL(size_t x) { return (x + 255) & ~(size_t)255; }
constexpr size_t W_BIN = 0;
constexpr size_t W_BOUT = W_BIN + 2ull * NINP * 1024 * 2;
constexpr size_t W_BQ = W_BOUT + 2ull * 1024 * 1024 * 2;
constexpr size_t W_BO = W_BQ + 2ull * 1024 * 1024 * 2;
constexpr size_t W_BKV = W_BO + 2ull * 1024 * 1024 * 2;
constexpr size_t W_BUP = W_BKV + 4096ull * 1024 * 2;
constexpr size_t W_BDN = W_BUP + 2ull * DFF2 * 1024 * 2;
constexpr size_t W_MEMB = W_BDN + 2ull * 1024 * DFF * 2;
constexpr size_t W_KB = W_MEMB + 2048ull * 1024 * 2;
constexpr size_t W_VT = W_KB + 2ull * 16 * 256 * 1024 * 2;
constexpr size_t XB_PRE = 2, XB_ROWS = (size_t)T_ALL + 2 + 318;
constexpr size_t W_XB = W_VT + 2ull * 16 * 256 * 1024 * 2;
constexpr size_t W_SSQ = W_XB + XB_ROWS * 1024 * 2;
constexpr size_t W_GL = W_SSQ + 8ull * T_ALL * 4;
constexpr size_t W_EH = AL(W_GL + 2080 * 4);
constexpr size_t W_SUMA = W_EH + 2080ull * 64 * 4;
constexpr size_t W_SUMH = W_SUMA + 520ull * 256 * 4;
constexpr size_t W_BAR = AL(W_SUMH + 520ull * 256 * 4);
constexpr size_t XCD_BAR_BYTES = 3456 * 4;
constexpr size_t W_R = AL(W_BAR + XCD_BAR_BYTES);
constexpr size_t GITEM = 36864;
constexpr size_t HITEM = 16384;
constexpr size_t R_GBUF = W_R;
constexpr size_t R_HBUF = R_GBUF + 2080ull * GITEM * 2;
constexpr size_t R_ZBUF = R_HBUF + 2080ull * HITEM * 2;
constexpr size_t R_BX = R_ZBUF + (size_t)T_ALL * 1024 * 2;
constexpr size_t R_HLOC = R_BX + (size_t)T_ALL * 256 * 2;
constexpr size_t R_PCUM = R_HLOC + (size_t)T_ALL * 256 * 2;
constexpr size_t R_HALO = R_PCUM + (size_t)T_ALL * 256 * 2;
constexpr size_t R_GATES = AL(R_HALO + 520ull * 3 * 1536 * 2);
constexpr size_t R_END1 = R_GATES + (size_t)T_ALL * 8 * 4;
constexpr size_t R_QBUF = W_R;
constexpr size_t R_OATT = R_QBUF + (size_t)T_ALL * 1024 * 2;
constexpr size_t R_ACT = W_R;
constexpr size_t R_END3 = R_ACT + ((size_t)T_ALL + 256) * DFF * 2;
constexpr size_t WS_NEED = (R_END1 > R_END3 ? R_END1 : R_END3);
static_assert(WS_NEED <= 512ull * 1024 * 1024, "workspace map exceeds 512 MiB");

constexpr int LDS_BYTES = 147456;
#ifndef TIMING
#define TIMING 0
#endif
#define TSCAN(k) do { if (TIMING == 2 && blockIdx.x == 0 && threadIdx.x == 0) { unsigned long long* tmr_ = (unsigned long long*)(p.ws + W_SSQ + (7ull * T_ALL + 4096) * 4); const unsigned long long t_ = __builtin_amdgcn_s_memrealtime(); tmr_[k] += t_ - tmr_[29]; tmr_[29] = t_; } } while (0)
#define TMARK(k) do { if (TIMING && blockIdx.x == 0 && threadIdx.x == 0) { unsigned long long* tmr_ = (unsigned long long*)(p.ws + W_SSQ + (7ull * T_ALL + 4096) * 4); const unsigned long long t_ = __builtin_amdgcn_s_memrealtime(); tmr_[k] += t_ - tmr_[31]; tmr_[31] = t_; } } while (0)
#ifndef STOP_AFTER
#define STOP_AFTER 99
#endif

struct Params {
    const float* in[39];
    float* out;
    unsigned char* ws;
};

__device__ __forceinline__ float bf2f(bf16_t b) { return __uint_as_float(((unsigned)b) << 16); }
typedef float f32x2_t __attribute__((ext_vector_type(2)));
typedef __bf16 bf16x2_t __attribute__((ext_vector_type(2)));
__device__ __forceinline__ unsigned cvt_pk_bf16(float lo, float hi) { const f32x2_t v = {lo, hi}; const bf16x2_t r = __builtin_convertvector(v, bf16x2_t); return __builtin_bit_cast(unsigned, r); }
__device__ __forceinline__ bf16_t f2bf(float f) { return (bf16_t)(cvt_pk_bf16(f, 0.f) & 0xffffu); }
__device__ __forceinline__ float lo_bf(unsigned w) { return __uint_as_float(w << 16); }
__device__ __forceinline__ float hi_bf(unsigned w) { return __uint_as_float(w & 0xffff0000u); }
__device__ __forceinline__ float sigmoidf_(float x) { return __builtin_amdgcn_rcpf(1.0f + __expf(-x)); }
__device__ __forceinline__ float siluf_(float x) { return x * __builtin_amdgcn_rcpf(1.0f + __expf(-x)); }
__device__ __forceinline__ float softplusf_(float x) { return x > 20.f ? x : log1pf(__expf(x)); }
__device__ __forceinline__ float gelu_tanh(float x) { const float u = 0.7978845608028654f * (x + 0.044715f * x * x * x); return 0.5f * x * (1.0f + tanhf(u)); }
__device__ __forceinline__ float ssqv(const float* ssq, int row) { return (float)__float_as_uint(ssq[row]) * (1.0f / 4096.0f); }
__device__ __forceinline__ unsigned ssq_fix(float s) { return (unsigned)(s * 4096.0f + 0.5f); }
__device__ __forceinline__ f32x4 mfma16(bf16x8 a, bf16x8 b, f32x4 c) { return __builtin_amdgcn_mfma_f32_16x16x32_bf16(a, b, c, 0, 0, 0); }
__device__ __forceinline__ void unpack8(u32x4 w, float* f) { f[0] = lo_bf(w.x); f[1] = hi_bf(w.x); f[2] = lo_bf(w.y); f[3] = hi_bf(w.y); f[4] = lo_bf(w.z); f[5] = hi_bf(w.z); f[6] = lo_bf(w.w); f[7] = hi_bf(w.w); }
__device__ __forceinline__ u32x4 pack8(const float* f) { u32x4 w; w.x = cvt_pk_bf16(f[0], f[1]); w.y = cvt_pk_bf16(f[2], f[3]); w.z = cvt_pk_bf16(f[4], f[5]); w.w = cvt_pk_bf16(f[6], f[7]); return w; }

namespace pg8 {
constexpr int BM = 256, BK = 64, HALF = 128, HTB = HALF * BK * 2, STAGE_BYTES = 8 * HTB, NXCD = 8, WGM = 8;
__device__ __forceinline__ int lds_byte(int r, int c) { const int st = (r >> 4) * 2 + (c >> 5), rr = r & 15, cc = c & 31, ob = rr * 64 + cc * 2; return st * 1024 + (ob ^ (((ob >> 9) & 1) << 5)); }
__device__ __forceinline__ void stage_rc(int b, int& R, int& C) { const int st = b / 1024, sb = b % 1024, swz = sb ^ (((sb >> 9) & 1) << 5); R = (st >> 1) * 16 + swz / 64; C = (st & 1) * 32 + (swz % 64) / 2; }
__device__ __forceinline__ int perm32(int rho) { const int n = rho >> 4, i = rho & 15; return 8 * (i >> 2) + 4 * n + (i & 3); }
struct Unit { int pm, pn; };
struct Order {
    int nM, nN, nwg, G, c;
    __device__ void init(int nM_, int nN_, int G_, int c_) { nM = nM_; nN = nN_; nwg = nM * nN; G = G_; c = c_; }
    __device__ bool next(int i, Unit& u) const {
        const long L = (long)i * G + c; if (L >= nwg) return false;
        int wgid = (int)L; { const int q = nwg / NXCD, r = nwg % NXCD, xcd = wgid % NXCD, off = wgid / NXCD; wgid = (xcd < r ? xcd * (q + 1) : r * (q + 1) + (xcd - r) * q) + off; }
        const int nig = WGM * nN, gid = wgid / nig, fm = gid * WGM, gsz = (nM - fm) < WGM ? (nM - fm) : WGM;
        u.pm = fm + ((wgid % nig) % gsz); u.pn = (wgid % nig) / gsz; return true;
    }
};
template <class Epi, int AMODE>
__device__ __forceinline__ void gemm_phase(LAS unsigned char* lds, const bf16_t* A, const bf16_t* Bt, int K, int nM, int nN, const Epi& E) {
    int tid = threadIdx.x; asm volatile("" : "+v"(tid)); const int wid = __builtin_amdgcn_readfirstlane(tid >> 6), lane = tid & 63, wr = wid >> 2, wc = wid & 3, fr = lane & 15, fq = lane >> 4;
    const int nt = K / BK;
    unsigned voffA[2], voffB[2];
#pragma unroll
    for (int i = 0; i < 2; ++i) { int R, C; stage_rc(tid * 16 + i * 8192, R, C); const int Rb = Epi::PERM ? ((R & ~31) + perm32(R & 31)) : R;
        const int Ra = AMODE ? ((R >> 6) * 126 + (R & 63)) : R;
        voffA[i] = (unsigned)(Ra * K + C) * 2u; voffB[i] = (unsigned)(Rb * K + C) * 2u; }
    const size_t kstep = (size_t)(BK * 2);
    const size_t hstepB = (size_t)HALF * K * 2, tstepB = 2 * hstepB;
    const size_t hstepA = AMODE ? (size_t)64 * K * 2 : hstepB, tstepA = AMODE ? (size_t)252 * K * 2 : tstepB;
    const unsigned ldsw = (unsigned)wid * 1024u;
    const int aoff = lds_byte(wr * 64 + fr, fq * 8), boff = lds_byte(wc * 32 + fr, fq * 8);
#define PG8_SA(b, h) (((b) * 2 + (h)) * HTB)
#define PG8_SB(b, h) ((4 + (b) * 2 + (h)) * HTB)
#define PG8_STAGE(bufoff, gbase, voff) do { _Pragma("unroll") for (int _i = 0; _i < 2; ++_i) \
        __builtin_amdgcn_global_load_lds((const unsigned*)((const char*)(gbase) + (voff)[_i]), (LAS unsigned*)(lds + (bufoff) + ldsw + _i * 8192), 16, 0, 0); } while (0)
#define PG8_LDA(dst, b, h) do { _Pragma("unroll") for (int m = 0; m < 4; ++m) _Pragma("unroll") for (int k = 0; k < 2; ++k) dst[m][k] = *(const LAS bf16x8*)(lds + PG8_SA(b, h) + aoff + m * 2048 + k * 1024); } while (0)
#define PG8_LDB(dst, b, h) do { _Pragma("unroll") for (int n = 0; n < 2; ++n) _Pragma("unroll") for (int k = 0; k < 2; ++k) dst[n][k] = *(const LAS bf16x8*)(lds + PG8_SB(b, h) + boff + n * 2048 + k * 1024); } while (0)
#define PG8_MMA(ai, bj, At, Bt_) do { __builtin_amdgcn_s_setprio(1); _Pragma("unroll") for (int m = 0; m < 4; ++m) _Pragma("unroll") for (int n = 0; n < 2; ++n) _Pragma("unroll") for (int k = 0; k < 2; ++k) \
        acc[ai][bj][m][n] = __builtin_amdgcn_mfma_f32_16x16x32_bf16(Bt_[n][k], At[m][k], acc[ai][bj][m][n], 0, 0, 0); __builtin_amdgcn_s_setprio(0); } while (0)
#define PG8_WAIT_V(n) asm volatile("s_waitcnt vmcnt(" #n ")" ::: "memory")
#define PG8_WAIT_L(n) asm volatile("s_waitcnt lgkmcnt(" #n ")" ::: "memory")
#define PG8_BAR __builtin_amdgcn_s_barrier()
#define PG8_SCHED __builtin_amdgcn_sched_barrier(0)
    int bid_ = blockIdx.x; asm volatile("" : "+s"(bid_));
    Order S; S.init(nM, nN, gridDim.x, bid_);
    Unit cur, nxt; int ui = 0;
    if (!S.next(0, cur)) return;
    f32x4 acc[2][2][4][2];
    if constexpr (Epi::PRELOAD) E.preload(acc, cur, wr, wc);
    else {
#pragma unroll
    for (int a = 0; a < 2; ++a)
#pragma unroll
        for (int b = 0; b < 2; ++b)
#pragma unroll
            for (int m = 0; m < 4; ++m)
#pragma unroll
                for (int n = 0; n < 2; ++n) acc[a][b][m][n] = (f32x4){0.f, 0.f, 0.f, 0.f}; }
    bf16x8 At[4][2], B0[2][2], B1[2][2];
    const char* cA = (const char*)A + (size_t)cur.pm * tstepA; const char* cB = (const char*)Bt + (size_t)cur.pn * tstepB;
    PG8_STAGE(PG8_SB(0, 0), cB, voffB); PG8_STAGE(PG8_SA(0, 0), cA, voffA); PG8_STAGE(PG8_SB(0, 1), cB + hstepB, voffB); PG8_STAGE(PG8_SA(0, 1), cA + hstepA, voffA);
    if (wr == 1) PG8_BAR;
    PG8_WAIT_V(4); PG8_BAR;
    PG8_STAGE(PG8_SB(1, 0), cB + kstep, voffB); PG8_STAGE(PG8_SA(1, 0), cA + kstep, voffA); PG8_STAGE(PG8_SB(1, 1), cB + hstepB + kstep, voffB);
    PG8_WAIT_V(6); PG8_BAR;
    for (;;) {
        const bool has_next = S.next(ui + 1, nxt);
        const char* nA = has_next ? (const char*)A + (size_t)nxt.pm * tstepA : cA; const char* nB = has_next ? (const char*)Bt + (size_t)nxt.pn * tstepB : cB;
        for (int t = 0; t < nt; t += 2) {
            const bool last = (t == nt - 2);
            const char* a1 = cA + (size_t)(t + 1) * kstep;
            const char* a2 = last ? nA : cA + (size_t)(t + 2) * kstep; const char* b2 = last ? nB : cB + (size_t)(t + 2) * kstep;
            const char* a3 = a2 + kstep; const char* b3 = b2 + kstep;
            PG8_LDB(B0, 0, 0); PG8_SCHED; PG8_LDA(At, 0, 0); PG8_STAGE(PG8_SA(1, 1), a1 + hstepA, voffA);
            PG8_WAIT_L(8); PG8_BAR; PG8_WAIT_L(0); PG8_MMA(0, 0, At, B0); PG8_BAR; PG8_SCHED;
            PG8_LDB(B1, 0, 1); PG8_STAGE(PG8_SB(0, 0), b2, voffB);
            PG8_BAR; PG8_WAIT_L(0); PG8_MMA(0, 1, At, B1); PG8_BAR;
            PG8_LDA(At, 0, 1); PG8_STAGE(PG8_SA(0, 0), a2, voffA);
            PG8_BAR; PG8_WAIT_L(0); PG8_MMA(1, 0, At, B0); PG8_BAR; PG8_SCHED;
            PG8_STAGE(PG8_SB(0, 1), b2 + hstepB, voffB);
            PG8_WAIT_V(6); PG8_BAR; PG8_MMA(1, 1, At, B1); PG8_BAR;
            PG8_LDB(B0, 1, 0); PG8_SCHED; PG8_LDA(At, 1, 0); PG8_STAGE(PG8_SA(0, 1), a2 + hstepA, voffA);
            PG8_WAIT_L(8); PG8_BAR; PG8_WAIT_L(0); PG8_MMA(0, 0, At, B0); PG8_BAR; PG8_SCHED;
            PG8_LDB(B1, 1, 1); PG8_STAGE(PG8_SB(1, 0), b3, voffB);
            PG8_BAR; PG8_WAIT_L(0); PG8_MMA(0, 1, At, B1); PG8_BAR;
            PG8_LDA(At, 1, 1); PG8_STAGE(PG8_SA(1, 0), a3, voffA);
            PG8_BAR; PG8_WAIT_L(0); PG8_MMA(1, 0, At, B0); PG8_BAR; PG8_SCHED;
            PG8_STAGE(PG8_SB(1, 1), b3 + hstepB, voffB);
            PG8_WAIT_V(6); PG8_BAR; PG8_MMA(1, 1, At, B1); PG8_BAR;
        }
        E(acc, cur, wr, wc, fr, fq);
        if (!has_next) break;
        if constexpr (Epi::PRELOAD) E.preload(acc, nxt, wr, wc);
        else {
#pragma unroll
        for (int a = 0; a < 2; ++a)
#pragma unroll
            for (int b = 0; b < 2; ++b)
#pragma unroll
                for (int m = 0; m < 4; ++m)
#pragma unroll
                    for (int n = 0; n < 2; ++n) acc[a][b][m][n] = (f32x4){0.f, 0.f, 0.f, 0.f}; }
        cur = nxt; cA = nA; cB = nB; ++ui;
    }
    PG8_WAIT_V(0);
    if (wr == 0) PG8_BAR;
    PG8_BAR;
#undef PG8_SA
#undef PG8_SB
#undef PG8_STAGE
#undef PG8_LDA
#undef PG8_LDB
#undef PG8_MMA
#undef PG8_WAIT_V
#undef PG8_WAIT_L
#undef PG8_BAR
#undef PG8_SCHED
}
}
using pg8::Unit;
typedef f32x4 AccT[2][2][4][2];

struct EpiKV {
    static constexpr bool PERM = false, PRELOAD = false;
    float* out; const float* ssq;
    __device__ __forceinline__ void operator()(const AccT& acc, const Unit& u, int wr, int wc, int fr, int fq) const {
        { int ln_ = (int)__builtin_amdgcn_mbcnt_hi(~0u, __builtin_amdgcn_mbcnt_lo(~0u, 0u)); asm volatile("" : "+v"(ln_)); fr = ln_ & 15; fq = ln_ >> 4; }
        const int which = u.pn >> 2;
        float* base = out + ((which & 1) ? OUT_PMV : OUT_PMK) + (size_t)(which >> 1) * 2048 * 1024 + (u.pn & 3) * 256 + wc * 32 + 4 * fq;
#pragma unroll
        for (int ai = 0; ai < 2; ++ai)
#pragma unroll
            for (int m = 0; m < 4; ++m) { const int row = u.pm * 256 + ai * 128 + wr * 64 + m * 16 + fr; const float rs = rsqrtf(ssqv(ssq, row) * (1.0f / 1024.0f) + EPS);
                float* rowp = base + (size_t)row * 1024;
#pragma unroll
                for (int bj = 0; bj < 2; ++bj)
#pragma unroll
                    for (int n = 0; n < 2; ++n) *(f32x4*)(rowp + bj * 128 + n * 16) = acc[ai][bj][m][n] * rs; }
    }
};
struct EpiRes {
    static constexpr bool PERM = false, PRELOAD = true;
    float* xf; bf16_t* xb; float* ssq;
    __device__ __forceinline__ void preload(AccT& acc, const Unit& u, int wr, int wc) const {
        int ln_ = (int)__builtin_amdgcn_mbcnt_hi(~0u, __builtin_amdgcn_mbcnt_lo(~0u, 0u)); asm volatile("" : "+v"(ln_)); const int fr = ln_ & 15, fq = ln_ >> 4;
        const int col0 = u.pn * 256 + wc * 32 + 4 * fq;
#pragma unroll
        for (int ai = 0; ai < 2; ++ai)
#pragma unroll
            for (int m = 0; m < 4; ++m) { const int row = u.pm * 256 + ai * 128 + wr * 64 + m * 16 + fr; const bf16_t* rowb = xb + (size_t)row * 1024 + col0;
#pragma unroll
                for (int bj = 0; bj < 2; ++bj)
#pragma unroll
                    for (int n = 0; n < 2; ++n) { const u32x2 o = *(const u32x2*)(rowb + bj * 128 + n * 16); acc[ai][bj][m][n] = (f32x4){lo_bf(o.x), hi_bf(o.x), lo_bf(o.y), hi_bf(o.y)}; } }
    }
    __device__ __forceinline__ void operator()(const AccT& acc, const Unit& u, int wr, int wc, int fr, int fq) const {
        { int ln_ = (int)__builtin_amdgcn_mbcnt_hi(~0u, __builtin_amdgcn_mbcnt_lo(~0u, 0u)); asm volatile("" : "+v"(ln_)); fr = ln_ & 15; fq = ln_ >> 4; }
        const int col0 = u.pn * 256 + wc * 32 + 4 * fq;
#pragma unroll
        for (int ai = 0; ai < 2; ++ai)
#pragma unroll
            for (int m = 0; m < 4; ++m) { const int row = u.pm * 256 + ai * 128 + wr * 64 + m * 16 + fr; bf16_t* rowb = xb + (size_t)row * 1024 + col0;
                float s = 0.f;
#pragma unroll
                for (int bj = 0; bj < 2; ++bj)
#pragma unroll
                    for (int n = 0; n < 2; ++n) { const f32x4 x = acc[ai][bj][m][n];
                        u32x2 w; w.x = cvt_pk_bf16(x[0], x[1]); w.y = cvt_pk_bf16(x[2], x[3]); *(u32x2*)(rowb + bj * 128 + n * 16) = w;
                        if (xf) *(f32x4*)(xf + (size_t)row * 1024 + col0 + bj * 128 + n * 16) = x;
                        s += (x[0] * x[0] + x[1] * x[1]) + (x[2] * x[2] + x[3] * x[3]); }
                s += __shfl_xor(s, 16); s += __shfl_xor(s, 32);
                if (fq == 0) atomicAdd((unsigned*)(ssq + row), ssq_fix(s)); }
    }
};
struct EpiQ {
    static constexpr bool PERM = true, PRELOAD = false;
    bf16_t* q; const float* ssq;
    __device__ __forceinline__ void operator()(const AccT& acc, const Unit& u, int wr, int wc, int fr, int fq) const {
        { int ln_ = (int)__builtin_amdgcn_mbcnt_hi(~0u, __builtin_amdgcn_mbcnt_lo(~0u, 0u)); asm volatile("" : "+v"(ln_)); fr = ln_ & 15; fq = ln_ >> 4; }
        const int col0 = u.pn * 256 + wc * 32 + 8 * fq;
#pragma unroll
        for (int ai = 0; ai < 2; ++ai)
#pragma unroll
            for (int m = 0; m < 4; ++m) { const int row = u.pm * 256 + ai * 128 + wr * 64 + m * 16 + fr; const float rs = rsqrtf(ssqv(ssq, row) * (1.0f / 1024.0f) + EPS);
                bf16_t* rowp = q + (size_t)row * 1024 + col0;
#pragma unroll
                for (int bj = 0; bj < 2; ++bj) { const f32x4 v0 = acc[ai][bj][m][0] * rs, v1 = acc[ai][bj][m][1] * rs; u32x4 w; w.x = cvt_pk_bf16(v0[0], v0[1]); w.y = cvt_pk_bf16(v0[2], v0[3]); w.z = cvt_pk_bf16(v1[0], v1[1]); w.w = cvt_pk_bf16(v1[2], v1[3]);
                    *(u32x4*)(rowp + bj * 128) = w; } }
    }
};
struct EpiProj {
    static constexpr bool PERM = true, PRELOAD = false;
    unsigned char* ws; const float* ssq;
    __device__ __forceinline__ void operator()(const AccT& acc, const Unit& u, int wr, int wc, int fr, int fq) const {
        { int ln_ = (int)__builtin_amdgcn_mbcnt_hi(~0u, __builtin_amdgcn_mbcnt_lo(~0u, 0u)); asm volatile("" : "+v"(ln_)); fr = ln_ & 15; fq = ln_ >> 4; }
        bf16_t* gbuf = (bf16_t*)(ws + R_GBUF); bf16_t* hbuf = (bf16_t*)(ws + R_HBUF); bf16_t* zbuf = (bf16_t*)(ws + R_ZBUF); bf16_t* bx = (bf16_t*)(ws + R_BX); bf16_t* halo = (bf16_t*)(ws + R_HALO); float* gates = (float*)(ws + R_GATES);
        const int pn = u.pn;
#pragma unroll
        for (int ai = 0; ai < 2; ++ai)
#pragma unroll
            for (int m = 0; m < 4; ++m) { const int row = u.pm * 256 + ai * 128 + wr * 64 + m * 16 + fr; const float rs = rsqrtf(ssqv(ssq, row) * (1.0f / 1024.0f) + EPS);
                const int chunk = row >> 6, t = row & 63;
#pragma unroll
                for (int bj = 0; bj < 2; ++bj) { const f32x4 v0 = acc[ai][bj][m][0] * rs, v1 = acc[ai][bj][m][1] * rs;
                    const int cc = bj * 128 + wc * 32 + 8 * fq;
                    if (pn == 14) { if (cc == 0) { *(f32x4*)(gates + (size_t)row * 8) = v0; *(f32x4*)(gates + (size_t)row * 8 + 4) = v1; } continue; }
                    u32x4 w; w.x = cvt_pk_bf16(v0[0], v0[1]); w.y = cvt_pk_bf16(v0[2], v0[3]); w.z = cvt_pk_bf16(v1[0], v1[1]); w.w = cvt_pk_bf16(v1[2], v1[3]);
                    if (pn < 6) { const int which = pn >> 1, head = (pn & 1) * 2 + bj, d = wc * 32 + 8 * fq;
                        *(u32x4*)(gbuf + (size_t)(chunk * 4 + head) * GITEM + which * 8192 + t * 128 + d) = w;
                        if (t >= 61) *(u32x4*)(halo + (size_t)(chunk * 3 + (t - 61)) * 1536 + which * 512 + head * 128 + d) = w; }
                    else if (pn < 8) *(u32x4*)(zbuf + (size_t)row * 1024 + (pn - 6) * 256 + cc) = w;
                    else if (pn == 8) *(u32x4*)(bx + (size_t)row * 256 + cc) = w;
                    else if (pn == 9) *(u32x4*)(zbuf + (size_t)row * 1024 + 512 + cc) = w;
                    else if (pn < 13) { const int which = pn - 10, head = cc >> 6, d = cc & 63;
                        *(u32x4*)(hbuf + (size_t)(chunk * 4 + head) * HITEM + which * 4096 + t * 64 + d) = w; }
                    else *(u32x4*)(zbuf + (size_t)row * 1024 + 768 + cc) = w; } }
    }
};
struct EpiUp {
    static constexpr bool PERM = true, PRELOAD = false;
    bf16_t* act; const float* ssq; const float* convw; const float* convb; const float* state; float* outp; float* outs;
    __device__ __forceinline__ void operator()(const AccT& acc, const Unit& u, int wr, int wc, int fr, int fq) const {
        { int ln_ = (int)__builtin_amdgcn_mbcnt_hi(~0u, __builtin_amdgcn_mbcnt_lo(~0u, 0u)); asm volatile("" : "+v"(ln_)); fr = ln_ & 15; fq = ln_ >> 4; }
        const int lane = fq * 16 + fr;
        const int grow0 = u.pm * 252 + wr * 126 - 2;
        const int cbase = u.pn * 128 + wc * 32 + 8 * fq;
        (void)lane;
        float rsv[8];
#pragma unroll
        for (int g = 0; g < 8; ++g) { int grow = grow0 + g * 16 + fr; grow = grow < 0 ? 0 : (grow >= T_ALL ? T_ALL - 1 : grow); rsv[g] = rsqrtf(ssqv(ssq, grow) * (1.0f / 1024.0f) + EPS); }
#pragma unroll
        for (int n = 0; n < 2; ++n) {
            const int c = cbase + 4 * n;
            f32x4 wg[3], wv[3];
#pragma unroll
            for (int j = 0; j < 3; ++j) { wg[j] = *(const f32x4*)(convw + j * DFF2 + c); wv[j] = *(const f32x4*)(convw + j * DFF2 + DFF + c); }
            const f32x4 bg = *(const f32x4*)(convb + c), bv = *(const f32x4*)(convb + DFF + c);
            f32x4 pg_g = (f32x4){0.f, 0.f, 0.f, 0.f}, pg_v = pg_g;
#pragma unroll
            for (int g = 0; g < 8; ++g) {
                const int ai = g >> 2, m = g & 3;
                const f32x4 cg_ = acc[ai][0][m][n] * rsv[g], cv_ = acc[ai][1][m][n] * rsv[g];
                f32x4 p1g, p2g, p1v, p2v;
#pragma unroll
                for (int j = 0; j < 4; ++j) {
#define ROR1(x) __builtin_bit_cast(float, __builtin_amdgcn_update_dpp(0, __builtin_bit_cast(int, (float)(x)), 0x121, 0xf, 0xf, false))
#define ROR2(x) __builtin_bit_cast(float, __builtin_amdgcn_update_dpp(0, __builtin_bit_cast(int, (float)(x)), 0x122, 0xf, 0xf, false))
                    const float a1 = ROR1(cg_[j]), b1 = ROR1(pg_g[j]), a2 = ROR2(cg_[j]), b2 = ROR2(pg_g[j]);
                    p1g[j] = fr >= 1 ? a1 : b1; p2g[j] = fr >= 2 ? a2 : b2;
                    const float c1 = ROR1(cv_[j]), d1 = ROR1(pg_v[j]), c2 = ROR2(cv_[j]), d2 = ROR2(pg_v[j]);
                    p1v[j] = fr >= 1 ? c1 : d1; p2v[j] = fr >= 2 ? c2 : d2;
                }
                const int rho = g * 16 + fr, grow = grow0 + rho;
                if (rho >= 2 && grow < T_ALL) {
                    const bool samp = grow >= T_P; const int s = samp ? ((grow - T_P) & 63) : (grow & 4095); const int b = samp ? ((grow - T_P) >> 6) : (grow >> 12); const int L = samp ? 64 : 4096;
                    if (s < 2) {
                        f32x4 s0g = (f32x4){0.f, 0.f, 0.f, 0.f}, s1g = s0g, s0v = s0g, s1v = s0g;
                        if (samp) { const float* st = state + (size_t)b * 2 * DFF2; s0g = *(const f32x4*)(st + c); s1g = *(const f32x4*)(st + DFF2 + c); s0v = *(const f32x4*)(st + DFF + c); s1v = *(const f32x4*)(st + DFF2 + DFF + c); }
                        if (s == 0) { p1g = s1g; p2g = s0g; p1v = s1v; p2v = s0v; } else { p2g = s1g; p2v = s1v; }
                    }
                    const f32x4 yg = wg[0] * p2g + wg[1] * p1g + wg[2] * cg_ + bg;
                    const f32x4 yv = wv[0] * p2v + wv[1] * p1v + wv[2] * cv_ + bv;
                    u32x2 w; w.x = cvt_pk_bf16(siluf_(yg[0]) * yv[0], siluf_(yg[1]) * yv[1]); w.y = cvt_pk_bf16(siluf_(yg[2]) * yv[2], siluf_(yg[3]) * yv[3]);
                    *(u32x2*)(act + (size_t)grow * DFF + c) = w;
                    if (s >= L - 2) { float* o = (samp ? outs : outp) + ((size_t)b * 2 + (s - (L - 2))) * DFF2; *(f32x4*)(o + c) = cg_; *(f32x4*)(o + DFF + c) = cv_; }
                }
                pg_g = cg_; pg_v = cv_;
            }
        }
    }
};

template <int MODE>
__device__ __forceinline__ void small_gemm(const bf16_t* A, const bf16_t* Bt, int K, bf16_t* outb, float* xf, float* ssq_acc, const float* ssq_rs) {
    int tid = threadIdx.x; asm volatile("" : "+v"(tid)); const int lane = tid & 63, w = tid >> 6, fr = lane & 15, fq = lane >> 4;
    for (int t = blockIdx.x; t < 256; t += gridDim.x) {
        const int tm = t >> 5, tn = t & 31; const int row0 = T_P + tm * 64 + (w >> 1) * 16, col0 = tn * 32 + (w & 1) * 16;
        const bf16_t* ap = A + (size_t)(row0 + fr) * K + fq * 8; const bf16_t* bp = Bt + (size_t)(col0 + fr) * K + fq * 8;
        f32x4 acc = (f32x4){0.f, 0.f, 0.f, 0.f};
#pragma unroll 8
        for (int k = 0; k < K; k += 32) acc = mfma16(*(const bf16x8*)(ap + k), *(const bf16x8*)(bp + k), acc);
#pragma unroll
        for (int jj = 0; jj < 4; ++jj) { const int row = row0 + fq * 4 + jj, col = col0 + fr; const size_t o = (size_t)row * 1024 + col;
            if (MODE == 0) { const float x = bf2f(outb[o]) + acc[jj]; outb[o] = f2bf(x); if (xf) xf[o] = x;
                float sq = x * x; sq += __shfl_xor(sq, 1); sq += __shfl_xor(sq, 2); sq += __shfl_xor(sq, 4); sq += __shfl_xor(sq, 8);
                if (fr == 0) atomicAdd((unsigned*)(ssq_acc + row), ssq_fix(sq)); }
            else { const float rs = rsqrtf(ssqv(ssq_rs, row) * (1.0f / 1024.0f) + EPS); outb[o] = f2bf(acc[jj] * rs); } }
    }
}

__device__ __forceinline__ int src_col8(int mode, int j0) {
    if (mode == 1) { if (j0 < 2048) return j0; if (j0 < 3584) return j0 + 8; if (j0 < 3592) return 2048; return -1; }
    if (mode == 2) { const int pn = j0 >> 8, w = j0 & 255; return w < 128 ? pn * 128 + w : DFF + pn * 128 + (w - 128); }
    return j0;
}
__device__ __noinline__ void transpose_job(const float* W, int ldw, int Kdim, int Nout, int mode, const float* gain, float scale, bf16_t* Bt, LAS unsigned char* lds, int rot) {
    LAS bf16_t* tile = (LAS bf16_t*)lds;
    int tid = threadIdx.x; asm volatile("" : "+v"(tid)); const int ntn = Nout >> 6, ntiles = ntn * (Kdim >> 6);
    for (int t = (int)((blockIdx.x + gridDim.x - (rot % gridDim.x)) % gridDim.x); t < ntiles; t += gridDim.x) {
        const int kt = t / ntn, ntl = t % ntn, k0 = kt * 64, n0 = ntl * 64;
        { const int kk = tid >> 3, ng = tid & 7; const int s = src_col8(mode, n0 + ng * 8);
          f32x4 a = (f32x4){0.f, 0.f, 0.f, 0.f}, b = a;
          if (s >= 0) { const float* p = W + (size_t)(k0 + kk) * ldw + s; a = *(const f32x4*)p; b = *(const f32x4*)(p + 4); }
          const float g = (gain ? gain[k0 + kk] : 1.0f) * scale;
          const float v[8] = {a[0] * g, a[1] * g, a[2] * g, a[3] * g, b[0] * g, b[1] * g, b[2] * g, b[3] * g};
#pragma unroll
          for (int i = 0; i < 8; ++i) tile[(ng * 8 + i) * 72 + kk] = f2bf(v[i]); }
        __syncthreads();
        { const int nl = tid >> 3, kg = tid & 7; const u32x4 w = *(const LAS u32x4*)(tile + nl * 72 + kg * 8); *(u32x4*)(Bt + (size_t)(n0 + nl) * Kdim + k0 + kg * 8) = w; }
        __syncthreads();
    }
}
__device__ __forceinline__ void rows_to_bf16(const float* src, int nrows, bf16_t* dst, float* copy, float* ssq) {
    int tidl = threadIdx.x; asm volatile("" : "+v"(tidl)); const int lane = tidl & 63, gw = blockIdx.x * 8 + (tidl >> 6), nw = gridDim.x * 8;
    for (int r = gw; r < nrows; r += nw) {
        float s = 0.f;
#pragma unroll
        for (int i = 0; i < 4; ++i) { const int c = i * 256 + lane * 4; const f32x4 x = *(const f32x4*)(src + (size_t)r * 1024 + c);
            if (copy) *(f32x4*)(copy + (size_t)r * 1024 + c) = x;
            u32x2 w; w.x = cvt_pk_bf16(x[0], x[1]); w.y = cvt_pk_bf16(x[2], x[3]); *(u32x2*)(dst + (size_t)r * 1024 + c) = w;
            s += (x[0] * x[0] + x[1] * x[1]) + (x[2] * x[2] + x[3] * x[3]); }
#pragma unroll
        for (int o = 32; o >= 1; o >>= 1) s += __shfl_xor(s, o);
        if (lane == 0) ssq[r] = __uint_as_float(ssq_fix(s));
    }
}
__device__ __forceinline__ void convert_flat(const float* src, bf16_t* dst, size_t n8) {
    int tidl = threadIdx.x; asm volatile("" : "+v"(tidl)); for (size_t i = (size_t)blockIdx.x * 512 + tidl; i < n8; i += (size_t)gridDim.x * 512) { const f32x4 a = *(const f32x4*)(src + i * 8), b = *(const f32x4*)(src + i * 8 + 4);
        u32x4 w; w.x = cvt_pk_bf16(a[0], a[1]); w.y = cvt_pk_bf16(a[2], a[3]); w.z = cvt_pk_bf16(b[0], b[1]); w.w = cvt_pk_bf16(b[2], b[3]); *(u32x4*)(dst + i * 8) = w; }
}

__device__ __forceinline__ void phase0(const Params& p, LAS unsigned char* lds) {
    unsigned char* ws = p.ws;
    int rot = 0;
    for (int l = 0; l < 2; ++l) {
        transpose_job(p.in[12] + (size_t)l * 1024 * 3592, 3592, 1024, NINP, 1, p.in[11] + l * 1024, 1.0f, (bf16_t*)(ws + W_BIN) + (size_t)l * NINP * 1024, lds, rot); rot += 60 * 16;
        transpose_job(p.in[26] + (size_t)l * 1024 * 1024, 1024, 1024, 1024, 0, nullptr, 1.0f, (bf16_t*)(ws + W_BOUT) + (size_t)l * 1024 * 1024, lds, rot); rot += 256;
        transpose_job(p.in[29] + (size_t)l * 1024 * 1024, 1024, 1024, 1024, 0, p.in[27] + l * 1024, 0.0625f, (bf16_t*)(ws + W_BQ) + (size_t)l * 1024 * 1024, lds, rot); rot += 256;
        transpose_job(p.in[32] + (size_t)l * 1024 * 1024, 1024, 1024, 1024, 0, nullptr, 1.0f, (bf16_t*)(ws + W_BO) + (size_t)l * 1024 * 1024, lds, rot); rot += 256;
        transpose_job(p.in[30] + (size_t)l * 1024 * 1024, 1024, 1024, 1024, 0, p.in[28] + l * 1024, 1.0f, (bf16_t*)(ws + W_BKV) + (size_t)(l * 2048) * 1024, lds, rot); rot += 256;
        transpose_job(p.in[31] + (size_t)l * 1024 * 1024, 1024, 1024, 1024, 0, p.in[28] + l * 1024, 1.0f, (bf16_t*)(ws + W_BKV) + (size_t)(l * 2048 + 1024) * 1024, lds, rot); rot += 256;
        transpose_job(p.in[34] + (size_t)l * 1024 * DFF2, DFF2, 1024, DFF2, 2, p.in[33] + l * 1024, 1.0f, (bf16_t*)(ws + W_BUP) + (size_t)l * DFF2 * 1024, lds, rot); rot += 88 * 16;
        transpose_job(p.in[37] + (size_t)l * DFF * 1024, 1024, DFF, 1024, 0, nullptr, 1.0f, (bf16_t*)(ws + W_BDN) + (size_t)l * 1024 * DFF, lds, rot); rot += 16 * 44;
        for (int b = 0; b < 8; ++b) for (int h = 0; h < 4; ++h) {
            transpose_job(p.in[3] + ((size_t)(l * 8 + b) * 256) * 1024 + h * 256, 1024, 256, 256, 0, nullptr, 1.0f, (bf16_t*)(ws + W_VT) + ((size_t)((l * 16 + 8 + b) * 4 + h)) * 65536, lds, rot); rot += 16; }
        convert_flat(p.in[2] + (size_t)l * 8 * 256 * 1024, (bf16_t*)(ws + W_KB) + (size_t)(l * 16 + 8) * 256 * 1024, 8ull * 256 * 1024 / 8);
    }
    float* ssq = (float*)(ws + W_SSQ);
    bf16_t* xb = (bf16_t*)(ws + W_XB) + XB_PRE * 1024;
    rows_to_bf16(p.in[0], T_P, xb, nullptr, ssq);
    rows_to_bf16(p.in[1], 512, xb + (size_t)T_P * 1024, nullptr, ssq + T_P);
    rows_to_bf16(p.in[10], 2048, (bf16_t*)(ws + W_MEMB), nullptr, ssq + 7ull * T_ALL);
    int tidz = threadIdx.x; asm volatile("" : "+v"(tidz)); for (size_t i = (size_t)blockIdx.x * 512 + tidz; i < 6ull * T_ALL; i += (size_t)gridDim.x * 512) ssq[T_ALL + i] = 0.f;
}
__device__ __forceinline__ void kv_prompt_convert(const Params& p, LAS unsigned char* lds) {
    unsigned char* ws = p.ws; int rot = 0;
    for (int l = 0; l < 2; ++l) {
        convert_flat(p.out + OUT_PMK + (size_t)l * 2048 * 1024, (bf16_t*)(ws + W_KB) + (size_t)(l * 16) * 256 * 1024, 2048ull * 1024 / 8);
        for (int b = 0; b < 8; ++b) for (int h = 0; h < 4; ++h) {
            transpose_job(p.out + OUT_PMV + ((size_t)(l * 8 + b) * 256) * 1024 + h * 256, 1024, 256, 256, 0, nullptr, 1.0f, (bf16_t*)(ws + W_VT) + ((size_t)((l * 16 + b) * 4 + h)) * 65536, lds, rot); rot += 16; }
    }
}

__device__ __forceinline__ void gdn_prep(const Params& p, int l, LAS unsigned char* lds) {
    unsigned char* ws = p.ws;
    bf16_t* gbuf = (bf16_t*)(ws + R_GBUF); const bf16_t* halo = (const bf16_t*)(ws + R_HALO); const float* gates = (const float*)(ws + R_GATES); float* glb = (float*)(ws + W_GL);
    LAS bf16_t* qs = (LAS bf16_t*)lds;
    LAS bf16_t* ks = qs + 64 * 136; LAS bf16_t* vs = ks + 64 * 136;
    LAS float* Mm = (LAS float*)(lds + 52224);
    LAS float* gc = (LAS float*)(lds + 69632);
    LAS bf16_t* raw = (LAS bf16_t*)(lds + 70400);
    LAS bf16_t* Mb = (LAS bf16_t*)(lds + 70400);
    LAS bf16_t* TinvB = (LAS bf16_t*)(lds + 79616);
    LAS bf16_t* RT = (LAS bf16_t*)(lds + 84736);
    LAS bf16_t* solT = (LAS bf16_t*)(lds + 101120);
    int tid = threadIdx.x; asm volatile("" : "+v"(tid)); const int lane = tid & 63, wid = tid >> 6, fr = lane & 15, fq = lane >> 4;
    const float* convw = p.in[13] + (size_t)l * 4 * 1536;
    LAS float* cwL = (LAS float*)(lds + 137984);
    { const int hh = blockIdx.x & 3; for (int i = tid; i < 1536; i += 512) { const int j = i / 384, c = i % 384; cwL[i] = convw[j * 1536 + (c >> 7) * 512 + hh * 128 + (c & 127)]; } }
    __syncthreads();
    for (int item = blockIdx.x; item < 2080; item += gridDim.x) {
        const int chunk = item >> 2, h = item & 3; const bool samp = chunk >= 512; const int b = samp ? chunk - 512 : chunk >> 6, n = samp ? 0 : (chunk & 63);
        bf16_t* gi = gbuf + (size_t)item * GITEM;
        { u32x4 wv[6];
#pragma unroll
          for (int i = 0; i < 6; ++i) { const int pc = tid + i * 512, r = pc / 48, cp = pc % 48, which = cp >> 4, c8 = (cp & 15) * 8; wv[i] = *(const u32x4*)(gi + which * 8192 + r * 128 + c8); }
#pragma unroll
          for (int i = 0; i < 6; ++i) { const int pc = tid + i * 512, r = pc / 48, cp = pc % 48, which = cp >> 4, c8 = (cp & 15) * 8; *(LAS u32x4*)(raw + (r + 3) * 392 + which * 128 + c8) = wv[i]; }
          if (tid < 144) { const int r = tid / 48, cp = tid % 48, which = cp >> 4, c8 = (cp & 15) * 8; u32x4 w = (u32x4){0u, 0u, 0u, 0u};
            if (n > 0) w = *(const u32x4*)(halo + (size_t)((chunk - 1) * 3 + r) * 1536 + which * 512 + h * 128 + c8);
            else if (samp) { const float* st = p.in[4] + ((size_t)(l * 8 + b) * 3 + r) * 1536 + which * 512 + h * 128 + c8; const f32x4 a = *(const f32x4*)st, bb = *(const f32x4*)(st + 4);
                w.x = cvt_pk_bf16(a[0], a[1]); w.y = cvt_pk_bf16(a[2], a[3]); w.z = cvt_pk_bf16(bb[0], bb[1]); w.w = cvt_pk_bf16(bb[2], bb[3]); }
            *(LAS u32x4*)(raw + r * 392 + which * 128 + c8) = w; } }
        __syncthreads();
        if (samp || n == 63) { float* o = p.out + (samp ? OUT_SAC : OUT_PAC) + (size_t)(l * 8 + b) * 3 * 1536;
            for (int i = tid; i < 3 * 384; i += 512) { const int j = i / 384, c = i % 384, which = c >> 7, d = c & 127; o[j * 1536 + which * 512 + h * 128 + d] = bf2f(raw[(64 + j) * 392 + c]); } }
        { const int row = tid >> 3, cgp = tid & 7;
#pragma unroll 1
          for (int which = 0; which < 3; ++which) { float y[16]; float ss = 0.f;
#pragma unroll
              for (int hf = 0; hf < 2; ++hf) { const int c = cgp * 16 + hf * 8; float a8[8] = {0.f, 0.f, 0.f, 0.f, 0.f, 0.f, 0.f, 0.f};
#pragma unroll
                  for (int j = 0; j < 4; ++j) { float x8[8]; unpack8(*(const LAS u32x4*)(raw + (row + j) * 392 + which * 128 + c), x8); LAS const float* wp = cwL + j * 384 + which * 128 + c; const f32x4 w0 = *(LAS const f32x4*)wp, w1 = *(LAS const f32x4*)(wp + 4);
                      a8[0] += w0[0] * x8[0]; a8[1] += w0[1] * x8[1]; a8[2] += w0[2] * x8[2]; a8[3] += w0[3] * x8[3]; a8[4] += w1[0] * x8[4]; a8[5] += w1[1] * x8[5]; a8[6] += w1[2] * x8[6]; a8[7] += w1[3] * x8[7]; }
#pragma unroll
                  for (int i = 0; i < 8; ++i) { const float v = siluf_(a8[i]); y[hf * 8 + i] = v; ss += v * v; } }
              float sc = 1.0f;
              if (which < 2) { ss += __shfl_xor(ss, 1); ss += __shfl_xor(ss, 2); ss += __shfl_xor(ss, 4); sc = rsqrtf(ss + 1e-6f) * (which == 0 ? 0.08838834764831845f : 1.0f); }
#pragma unroll
              for (int i = 0; i < 16; ++i) y[i] *= sc;
              LAS bf16_t* dst = (which == 0 ? qs : (which == 1 ? ks : vs)) + row * 136 + cgp * 16;
              *(LAS u32x4*)dst = pack8(y); *(LAS u32x4*)(dst + 8) = pack8(y + 8); } }
        if (wid == 0) { const size_t rowg = (size_t)chunk * 64 + lane; const float ab = gates[rowg * 8 + h], aa = gates[rowg * 8 + 4 + h];
            const float beta = sigmoidf_(ab); float g = -__expf(p.in[14][l * 4 + h]) * softplusf_(aa + p.in[15][l * 4 + h]);
#pragma unroll
            for (int o = 1; o < 64; o <<= 1) { const float v = __shfl_up(g, o); if (lane >= o) g += v; }
            gc[lane] = g; gc[64 + lane] = beta; gc[128 + lane] = __expf(g); }
        __syncthreads();
        { const int ti = wid >> 1;
#pragma unroll
          for (int tjj = 0; tjj < 2; ++tjj) { const int tj = (wid & 1) * 2 + tjj;
              f32x4 akk = (f32x4){0.f, 0.f, 0.f, 0.f}, aqk = akk;
              if (tj <= ti) {
#pragma unroll
                  for (int kk = 0; kk < 4; ++kk) { const bf16x8 ak = *(const LAS bf16x8*)(ks + (ti * 16 + fr) * 136 + kk * 32 + fq * 8), aq = *(const LAS bf16x8*)(qs + (ti * 16 + fr) * 136 + kk * 32 + fq * 8), bk = *(const LAS bf16x8*)(ks + (tj * 16 + fr) * 136 + kk * 32 + fq * 8);
                      akk = mfma16(ak, bk, akk); aqk = mfma16(aq, bk, aqk); } }
              f32x4 mrow;
#pragma unroll
              for (int jj = 0; jj < 4; ++jj) { const int i = ti * 16 + fq * 4 + jj, j = tj * 16 + fr; float mval = 0.f, qv = 0.f;
                  if (j <= i) { const float dec = __expf(gc[i] - gc[j]); qv = aqk[jj] * dec; if (j < i) mval = gc[64 + i] * akk[jj] * dec; }
                  mrow[jj] = mval; Mb[i * 72 + j] = (tj < ti) ? f2bf(mval) : (bf16_t)0;
                  RT[i * 64 + j] = f2bf(qv); }
              if (tj <= ti) *(LAS f32x4*)(Mm + (tj * 16 + fr) * 68 + ti * 16 + fq * 4) = mrow; } }
        __syncthreads();
        if (tid < 64) { int tl_ = tid; asm volatile("" : "+v"(tl_)); const int I = tl_ >> 4, c = tl_ & 15; float x[16];
#pragma unroll
            for (int i = 0; i < 16; ++i) x[i] = (i == c) ? 1.0f : 0.0f;
#pragma unroll
            for (int j = 0; j < 15; ++j) {
#pragma unroll
                for (int q4 = 0; q4 < 4; ++q4) { if (q4 * 4 + 3 <= j) continue; const f32x4 mv = *(const LAS f32x4*)(Mm + (I * 16 + j) * 68 + I * 16 + q4 * 4);
#pragma unroll
                    for (int e = 0; e < 4; ++e) if (q4 * 4 + e > j) x[q4 * 4 + e] -= mv[e] * x[j]; } }
#pragma unroll
            for (int i = 0; i < 16; ++i) { TinvB[(I * 16 + i) * 40 + c] = f2bf(x[i]); TinvB[(I * 16 + i) * 40 + 16 + c] = 0; }
        } else if (tid < 256) { const u32x4 z4 = (u32x4){0u, 0u, 0u, 0u};
            for (int i = tid - 64; i < 3328; i += 192) { if (i < 512) *(u32x4*)(gi + 32768 + i * 8) = *(const LAS u32x4*)(lds + 84736 + i * 16);
                *(LAS u32x4*)(lds + 84736 + i * 16) = z4; }
        } else { const int t2 = tid - 256; const float glast = gc[63];
#pragma unroll
            for (int it = 0; it < 4; ++it) { const int idx = t2 + it * 256, i = idx >> 4, c8 = (idx & 15) * 8; float v[8]; unpack8(*(const LAS u32x4*)(qs + i * 136 + c8), v); const float e = gc[128 + i];
#pragma unroll
                for (int k = 0; k < 8; ++k) v[k] *= e;
                *(u32x4*)(gi + i * 128 + c8) = pack8(v); }
#pragma unroll
            for (int it = 0; it < 4; ++it) { const int idx = t2 + it * 256, d = idx >> 3, i8 = (idx & 7) * 8; float v[8];
#pragma unroll
                for (int k = 0; k < 8; ++k) v[k] = bf2f(ks[(i8 + k) * 136 + d]) * __expf(glast - gc[i8 + k]);
                *(u32x4*)(gi + 8192 + d * 64 + i8) = pack8(v); }
            if (t2 == 0) glb[item] = __expf(glast);
        }
        __syncthreads();
        { int tl2_ = tid; asm volatile("" : "+v"(tl2_)); const int fr = tl2_ & 15, fq = (tl2_ >> 4) & 3, wid = tl2_ >> 6;
#pragma unroll 1
          for (int I = 0; I < 4; ++I) {
              f32x4 racc[2] = {(f32x4){0.f, 0.f, 0.f, 0.f}, (f32x4){0.f, 0.f, 0.f, 0.f}};
              for (int ks2 = 0; ks2 * 32 < I * 16; ++ks2) {
                  const bf16x8 a = *(const LAS bf16x8*)(Mb + (I * 16 + fr) * 72 + ks2 * 32 + fq * 8);
                  const bf16x8 b0 = *(const LAS bf16x8*)(solT + ((wid * 2 + 0) * 16 + fr) * 72 + ks2 * 32 + fq * 8);
                  const bf16x8 b1 = *(const LAS bf16x8*)(solT + ((wid * 2 + 1) * 16 + fr) * 72 + ks2 * 32 + fq * 8);
                  racc[0] = mfma16(a, b0, racc[0]); racc[1] = mfma16(a, b1, racc[1]); }
#pragma unroll
              for (int n2 = 0; n2 < 2; ++n2) { const int col = (wid * 2 + n2) * 16 + fr; float rv[4];
#pragma unroll
                  for (int jj = 0; jj < 4; ++jj) { const int i = I * 16 + fq * 4 + jj; float v = (col < 128 ? bf2f(vs[i * 136 + col]) : bf2f(ks[i * 136 + col - 128]) * gc[128 + i]) * gc[64 + i]; rv[jj] = v - racc[n2][jj]; }
                  u32x2 wv; wv.x = cvt_pk_bf16(rv[0], rv[1]); wv.y = cvt_pk_bf16(rv[2], rv[3]); *(LAS u32x2*)(RT + col * 32 + fq * 4) = wv; }
              __syncthreads();
              { const bf16x8 a = *(const LAS bf16x8*)(TinvB + (I * 16 + fr) * 40 + fq * 8);
                const bf16x8 b0 = *(const LAS bf16x8*)(RT + ((wid * 2 + 0) * 16 + fr) * 32 + fq * 8), b1 = *(const LAS bf16x8*)(RT + ((wid * 2 + 1) * 16 + fr) * 32 + fq * 8);
                f32x4 sv2[2]; sv2[0] = (f32x4){0.f, 0.f, 0.f, 0.f}; sv2[1] = sv2[0];
                sv2[0] = mfma16(a, b0, sv2[0]); sv2[1] = mfma16(a, b1, sv2[1]);
#pragma unroll
                for (int n2 = 0; n2 < 2; ++n2) { const int col = (wid * 2 + n2) * 16 + fr;
                    float s4[4] = {sv2[n2][0] + 0.f, sv2[n2][1] + 0.f, sv2[n2][2] + 0.f, sv2[n2][3] + 0.f};
                    u32x2 wv; wv.x = cvt_pk_bf16(s4[0], s4[1]); wv.y = cvt_pk_bf16(s4[2], s4[3]);
                    *(LAS u32x2*)(solT + col * 72 + I * 16 + fq * 4) = wv;
                    if (col < 128) *(u32x2*)(gi + 16384 + col * 64 + I * 16 + fq * 4) = wv;
                    else {
#pragma unroll
                        for (int jj = 0; jj < 4; ++jj) gi[24576 + (I * 16 + fq * 4 + jj) * 128 + (col - 128)] = f2bf(s4[jj]); } } }
              __syncthreads(); } }
    }
}

__device__ __forceinline__ void hgrn_prep(const Params& p, int l, LAS unsigned char* lds) {
    unsigned char* ws = p.ws;
    bf16_t* hbuf = (bf16_t*)(ws + R_HBUF); float* eh = (float*)(ws + W_EH);
    LAS bf16_t* qt = (LAS bf16_t*)lds;
    LAS bf16_t* kt = qt + 64 * 72;
    LAS float* tot = (LAS float*)(lds + 2 * 64 * 72 * 2);
    LAS bf16_t* sq = (LAS bf16_t*)(lds + 20480);
    LAS bf16_t* sf = sq + 64 * 72; LAS bf16_t* si = sf + 64 * 72;
    int tid = threadIdx.x; asm volatile("" : "+v"(tid)); const int lane = tid & 63, wid = tid >> 6, fr = lane & 15, fq = lane >> 4;
    for (int item = (blockIdx.x + 64) % gridDim.x; item < 2080; item += gridDim.x) {
        const int h = item & 3; bf16_t* hi = hbuf + (size_t)item * HITEM;
        { const int t_ = tid >> 3, d8 = (tid & 7) * 8; const u32x4 va = *(const u32x4*)(hi + t_ * 64 + d8), vb = *(const u32x4*)(hi + 4096 + t_ * 64 + d8), vc = *(const u32x4*)(hi + 8192 + t_ * 64 + d8);
          *(LAS u32x4*)(sq + t_ * 72 + d8) = va; *(LAS u32x4*)(sf + t_ * 72 + d8) = vb; *(LAS u32x4*)(si + t_ * 72 + d8) = vc; }
        __syncthreads();
        const int d = tid & 63, seg = tid >> 6;
        float lb = 0.f; if (l == 1) lb = sigmoidf_(p.in[24][256 + h * 64 + d] - p.in[24][h * 64 + d]);
        float qc[8], kf[8], bc[8], vv[8]; float run = 0.f;
#pragma unroll
        for (int i = 0; i < 8; ++i) { const int t = seg * 8 + i; const float cq = bf2f(sq[t * 72 + d]), cf = bf2f(sf[t * 72 + d]); vv[i] = bf2f(si[t * 72 + d]);
            qc[i] = siluf_(cq); const float f = lb + (1.0f - lb) * sigmoidf_(cf); kf[i] = 1.0f - f; run += __logf(f); bc[i] = run; }
        tot[seg * 64 + d] = run;
        asm volatile("s_waitcnt vmcnt(0)" ::: "memory");
        __syncthreads();
        float pre = 0.f, ref = 0.f, all = 0.f;
#pragma unroll
        for (int s = 0; s < 8; ++s) { const float tv = tot[s * 64 + d]; if (s < seg) pre += tv; if (s < 4) ref += tv; all += tv; }
        { float qh8[8], kh8[8];
#pragma unroll
          for (int i = 0; i < 8; ++i) { const int t = seg * 8 + i; const float bct = pre + bc[i];
              qt[t * 72 + d] = f2bf(qc[i] * __expf(bct - ref)); kt[t * 72 + d] = f2bf(kf[i] * __expf(ref - bct));
              qh8[i] = qc[i] * __expf(bct); kh8[i] = kf[i] * __expf(all - bct); }
#pragma unroll
          for (int i = 0; i < 8; ++i) sq[(seg * 8 + i) * 72 + d] = f2bf(qh8[i]);
          *(u32x4*)(hi + 4096 + d * 64 + seg * 8) = pack8(kh8);
          *(u32x4*)(hi + 8192 + d * 64 + seg * 8) = pack8(vv);
          if (seg == 0) eh[(size_t)item * 64 + d] = __expf(all); }
        __syncthreads();
        { const int t_ = tid >> 3, d8 = (tid & 7) * 8; *(u32x4*)(hi + t_ * 64 + d8) = *(const LAS u32x4*)(sq + t_ * 72 + d8); }
        { const int ti = wid >> 1;
#pragma unroll
          for (int tjj = 0; tjj < 2; ++tjj) { const int tj = (wid & 1) * 2 + tjj; f32x4 a = (f32x4){0.f, 0.f, 0.f, 0.f};
              if (tj <= ti) {
#pragma unroll
                  for (int kk = 0; kk < 2; ++kk) a = mfma16(*(const LAS bf16x8*)(qt + (ti * 16 + fr) * 72 + kk * 32 + fq * 8), *(const LAS bf16x8*)(kt + (tj * 16 + fr) * 72 + kk * 32 + fq * 8), a); }
#pragma unroll
              for (int jj = 0; jj < 4; ++jj) { const int i = ti * 16 + fq * 4 + jj, j = tj * 16 + fr; sf[i * 72 + j] = f2bf(j <= i ? a[jj] : 0.f); } } }
        __syncthreads();
        { const int t_ = tid >> 3, d8 = (tid & 7) * 8; *(u32x4*)(hi + 12288 + t_ * 64 + d8) = *(const LAS u32x4*)(sf + t_ * 72 + d8); }
    }
    __syncthreads();
}

__device__ __forceinline__ void rg_prep(const Params& p, int l, LAS unsigned char* lds) {
    unsigned char* ws = p.ws;
    const bf16_t* bx = (const bf16_t*)(ws + R_BX); bf16_t* hloc = (bf16_t*)(ws + R_HLOC); bf16_t* pcum = (bf16_t*)(ws + R_PCUM); float* sumA = (float*)(ws + W_SUMA); float* sumH = (float*)(ws + W_SUMH);
    LAS bf16_t* xs = (LAS bf16_t*)lds;
    LAS bf16_t* wT = (LAS bf16_t*)(lds + 64 * 264 * 2);

    int tid = threadIdx.x; asm volatile("" : "+v"(tid)); const int lane = tid & 63, wid = tid >> 6, fr = lane & 15, fq = lane >> 4;
    const float* cw = p.in[17] + (size_t)l * 4 * 256; const float* cb = p.in[18] + l * 256;
    for (int idx = tid; idx < 32768; idx += 512) { const int g = idx >> 14, nb = (idx >> 12) & 3, i = (idx >> 6) & 63, j = idx & 63; const float v = (g ? p.in[21] : p.in[19])[(size_t)l * 16384 + nb * 4096 + i * 64 + j];
        wT[((g * 4 + nb) * 64 + j) * 72 + i] = f2bf(v); }
    for (int chunk_ = (blockIdx.x + 128) % gridDim.x; chunk_ < NCHUNK; chunk_ += gridDim.x) {
        const int chunk = chunk_; const bool samp = chunk >= 512; const int b = samp ? chunk - 512 : chunk >> 6, n = samp ? 0 : (chunk & 63);
        __syncthreads();
        { const int row = tid >> 3, cgp = tid & 7;
#pragma unroll
          for (int q8 = 0; q8 < 4; ++q8) { const int c = cgp * 32 + q8 * 8; float a8[8];
              { const f32x4 b0 = *(const f32x4*)(cb + c), b1 = *(const f32x4*)(cb + c + 4); a8[0] = b0[0]; a8[1] = b0[1]; a8[2] = b0[2]; a8[3] = b0[3]; a8[4] = b1[0]; a8[5] = b1[1]; a8[6] = b1[2]; a8[7] = b1[3]; }
#pragma unroll
              for (int j = 0; j < 4; ++j) { const int rr = row - 3 + j; float x8[8] = {0.f, 0.f, 0.f, 0.f, 0.f, 0.f, 0.f, 0.f};
                  if (rr >= 0 || n > 0) unpack8(*(const u32x4*)(bx + ((size_t)chunk * 64 + rr) * 256 + c), x8);
                  else if (samp) { const float* st = p.in[6] + ((size_t)(l * 8 + b) * 3 + (3 + rr)) * 256 + c; const f32x4 s0 = *(const f32x4*)st, s1 = *(const f32x4*)(st + 4); x8[0] = s0[0]; x8[1] = s0[1]; x8[2] = s0[2]; x8[3] = s0[3]; x8[4] = s1[0]; x8[5] = s1[1]; x8[6] = s1[2]; x8[7] = s1[3]; }
                  const f32x4 w0 = *(const f32x4*)(cw + j * 256 + c), w1 = *(const f32x4*)(cw + j * 256 + c + 4);
                  a8[0] += w0[0] * x8[0]; a8[1] += w0[1] * x8[1]; a8[2] += w0[2] * x8[2]; a8[3] += w0[3] * x8[3]; a8[4] += w1[0] * x8[4]; a8[5] += w1[1] * x8[5]; a8[6] += w1[2] * x8[6]; a8[7] += w1[3] * x8[7]; }
              *(LAS u32x4*)(xs + row * 264 + c) = pack8(a8); } }
        if (samp || n == 63) { float* o = p.out + (samp ? OUT_SBC : OUT_PBC) + (size_t)(l * 8 + b) * 3 * 256;
            for (int i = tid; i < 768; i += 512) { const int j = i >> 8, c = i & 255; o[j * 256 + c] = bf2f(bx[((size_t)chunk * 64 + 61 + j) * 256 + c]); } }
        __syncthreads();
#pragma unroll 1
        for (int pp = 0; pp < 2; ++pp) { const int pair = wid * 2 + pp, nb = pair >> 2, tj = pair & 3, ch = nb * 64 + tj * 16 + fr;
            LAS bf16_t* hbL = (LAS bf16_t*)(lds + 107520) + wid * 2048; LAS bf16_t* pbL = hbL + 1024;
            const float br = p.in[20][l * 256 + ch], bi = p.in[22][l * 256 + ch], sp = softplusf_(-p.in[23][l * 256 + ch]);
            float Ac = 1.0f, Hc = 0.0f;
#pragma unroll 1
            for (int ti = 0; ti < 4; ++ti) { f32x4 ar = (f32x4){0.f, 0.f, 0.f, 0.f}, aig = ar;
#pragma unroll
                for (int kk = 0; kk < 2; ++kk) { const bf16x8 a = *(const LAS bf16x8*)(xs + (ti * 16 + fr) * 264 + nb * 64 + kk * 32 + fq * 8);
                    ar = mfma16(a, *(const LAS bf16x8*)(wT + ((0 * 4 + nb) * 64 + tj * 16 + fr) * 72 + kk * 32 + fq * 8), ar);
                    aig = mfma16(a, *(const LAS bf16x8*)(wT + ((1 * 4 + nb) * 64 + tj * 16 + fr) * 72 + kk * 32 + fq * 8), aig); }
                float Aj[4], Hj[4]; float Ar = 1.0f, Hr = 0.0f;
#pragma unroll
                for (int jj = 0; jj < 4; ++jj) { const int tok = ti * 16 + fq * 4 + jj; const float r = sigmoidf_(ar[jj] + br), ig = sigmoidf_(aig[jj] + bi); const float la = -8.0f * r * sp; const float a = __expf(la);
                    const float mult = sqrtf(fmaxf(1.0f - __expf(2.0f * la), 0.0f)); const float uu = mult * ig * bf2f(xs[tok * 264 + ch]);
                    Hr = a * Hr + uu; Ar = a * Ar; Aj[jj] = Ar; Hj[jj] = Hr; }
                float Ap = Ac, Hp = Hc;
#pragma unroll
                for (int qd = 0; qd < 4; ++qd) { const float Aq = __shfl(Ar, qd * 16 + fr), Hq = __shfl(Hr, qd * 16 + fr);
                    if (qd < fq) { Hp = Aq * Hp + Hq; Ap = Aq * Ap; }
                    Hc = Aq * Hc + Hq; Ac = Aq * Ac; }
#pragma unroll
                for (int jj = 0; jj < 4; ++jj) { const int tl = ti * 16 + fq * 4 + jj; hbL[tl * 16 + fr] = f2bf(Hj[jj] + Aj[jj] * Hp); pbL[tl * 16 + fr] = f2bf(Aj[jj] * Ap); } }
#pragma unroll
            for (int r2 = 0; r2 < 2; ++r2) { const int idx = lane + r2 * 64, tok = idx >> 1, hf = idx & 1; const size_t o = ((size_t)chunk * 64 + tok) * 256 + nb * 64 + tj * 16 + hf * 8;
                *(u32x4*)(hloc + o) = *(const LAS u32x4*)(hbL + tok * 16 + hf * 8); *(u32x4*)(pcum + o) = *(const LAS u32x4*)(pbL + tok * 16 + hf * 8); }
            if (fq == 0) { sumA[(size_t)chunk * 256 + ch] = Ac; sumH[(size_t)chunk * 256 + ch] = Hc; } }
    }
    __syncthreads();
}

__device__ __forceinline__ void rg_apply_chunk(const Params& p, int l, int chunk) {
    unsigned char* ws = p.ws; bf16_t* zbuf = (bf16_t*)(ws + R_ZBUF);
    const bf16_t* hloc = (const bf16_t*)(ws + R_HLOC); const bf16_t* pcum = (const bf16_t*)(ws + R_PCUM); const float* sumA = (const float*)(ws + W_SUMA); const float* sumH = (const float*)(ws + W_SUMH);
    int tid = threadIdx.x; asm volatile("" : "+v"(tid));
    const bool samp = chunk >= 512; const int b = samp ? chunk - 512 : chunk >> 6, n = samp ? 0 : (chunk & 63);
    { const int ch = tid & 255, half = tid >> 8;
            float hin = samp ? p.in[7][(size_t)(l * 8 + b) * 256 + ch] : 0.f;
            for (int m = 0; m < n; ++m) { const size_t o = (size_t)(chunk - n + m) * 256 + ch; hin = sumA[o] * hin + sumH[o]; }
#pragma unroll 1
            for (int t0 = half * 32; t0 < half * 32 + 32; t0 += 8) { float hl[8], pc8[8], zg[8];
#pragma unroll
                for (int i = 0; i < 8; ++i) { const size_t row = (size_t)chunk * 64 + t0 + i; hl[i] = bf2f(hloc[row * 256 + ch]); pc8[i] = bf2f(pcum[row * 256 + ch]); zg[i] = bf2f(zbuf[row * 1024 + 512 + ch]); }
#pragma unroll
                for (int i = 0; i < 8; ++i) { const size_t row = (size_t)chunk * 64 + t0 + i; const float hv = hl[i] + pc8[i] * hin; zbuf[row * 1024 + 512 + ch] = f2bf(hv * gelu_tanh(zg[i]));
                    if (t0 + i == 63 && (samp || n == 63)) p.out[(samp ? OUT_SBH : OUT_PBH) + (size_t)(l * 8 + b) * 256 + ch] = hv; } }
    }
}

constexpr size_t OBUF_H_OFF = 2080ull * 8192;
static_assert((OBUF_H_OFF + 2080ull * 4096) * 2 <= (size_t)T_ALL * 1024 * 4, "o buffers must fit in the y region");
__device__ __forceinline__ void gdn_scan(const Params& p, int l, int seq, int h, int slice, LAS unsigned char* lds) {
    unsigned char* ws = p.ws; const bf16_t* gbuf = (const bf16_t*)(ws + R_GBUF); const float* glb = (const float*)(ws + W_GL); bf16_t* obuf = (bf16_t*)(p.out + OUT_Y);
    LAS bf16_t* StL = (LAS bf16_t*)lds;
    LAS bf16_t* VtL = StL + 32 * 136;
    int tid = threadIdx.x; asm volatile("" : "+v"(tid)); const int lane = tid & 63, w = tid >> 6, fr = lane & 15, fq = lane >> 4, mt = w & 3;
    const bool samp = seq >= 8; const int b = seq & 7; const int nsteps = samp ? 1 : 64, chunk0 = samp ? 512 + b : b * 64;
    f32x4 S[2];
#pragma unroll
    for (int nt = 0; nt < 2; ++nt) { S[nt] = (f32x4){0.f, 0.f, 0.f, 0.f};
        if (samp) { const float* s0 = p.in[5] + ((size_t)((l * 8 + b) * 4 + h)) * 16384;
#pragma unroll
            for (int jj = 0; jj < 4; ++jj) S[nt][jj] = s0[(w * 16 + fq * 4 + jj) * 128 + slice * 32 + nt * 16 + fr]; } }
#define GDN_LOAD(A_, KD_, QK_, UU_, GL_, item_) do { const bf16_t* gi_ = gbuf + (size_t)(item_) * GITEM; const bf16_t* Ab_ = gi_ + (w < 4 ? 24576 : 0) + (mt * 16 + fr) * 128 + fq * 8; \
        _Pragma("unroll") for (int kk = 0; kk < 4; ++kk) A_[kk] = *(const bf16x8*)(Ab_ + kk * 32); \
        _Pragma("unroll") for (int kk = 0; kk < 2; ++kk) KD_[kk] = *(const bf16x8*)(gi_ + 8192 + (w * 16 + fr) * 64 + kk * 32 + fq * 8); \
        if (w >= 4) { _Pragma("unroll") for (int kk = 0; kk < 2; ++kk) QK_[kk] = *(const bf16x8*)(gi_ + 32768 + (mt * 16 + fr) * 64 + kk * 32 + fq * 8); } \
        else { _Pragma("unroll") for (int nt = 0; nt < 2; ++nt) UU_[nt] = *(const u32x2*)(gi_ + 16384 + (slice * 32 + nt * 16 + fr) * 64 + mt * 16 + fq * 4); } \
        GL_ = glb[item_]; } while (0)
    bf16x8 ca[4], ckd[2], cqk[2] = {}; u32x2 cuu[2] = {}; float cgl;
    bf16x8 ma[4], mkd[2], mqk[2] = {}; u32x2 muu[2] = {}; float mgl;
    GDN_LOAD(ca, ckd, cqk, cuu, cgl, chunk0 * 4 + h);
    { const int it1 = (nsteps > 1) ? (chunk0 + 1) * 4 + h : chunk0 * 4 + h; GDN_LOAD(ma, mkd, mqk, muu, mgl, it1); }
    for (int step = 0; step < nsteps; ++step) {
        const int item = (chunk0 + step) * 4 + h;
        bf16x8 na[4], nkd[2], nqk[2] = {}; u32x2 nuu[2] = {}; float ngl;
        { const int nit = (step + 2 < nsteps) ? item + 8 : item; GDN_LOAD(na, nkd, nqk, nuu, ngl, nit); }
#pragma unroll
        for (int nt = 0; nt < 2; ++nt) { u32x2 wv; wv.x = cvt_pk_bf16(S[nt][0], S[nt][1]); wv.y = cvt_pk_bf16(S[nt][2], S[nt][3]); *(LAS u32x2*)(StL + (nt * 16 + fr) * 136 + w * 16 + fq * 4) = wv; }
        __syncthreads();
        f32x4 acc[2] = {(f32x4){0.f, 0.f, 0.f, 0.f}, (f32x4){0.f, 0.f, 0.f, 0.f}};
#pragma unroll
        for (int kk = 0; kk < 4; ++kk)
#pragma unroll
            for (int nt = 0; nt < 2; ++nt) acc[nt] = mfma16(ca[kk], *(const LAS bf16x8*)(StL + (nt * 16 + fr) * 136 + kk * 32 + fq * 8), acc[nt]);
        if (w < 4) {
#pragma unroll
            for (int nt = 0; nt < 2; ++nt) { const u32x2 uw = cuu[nt];
                u32x2 vw; vw.x = cvt_pk_bf16(lo_bf(uw.x) - acc[nt][0], hi_bf(uw.x) - acc[nt][1]); vw.y = cvt_pk_bf16(lo_bf(uw.y) - acc[nt][2], hi_bf(uw.y) - acc[nt][3]);
                *(LAS u32x2*)(VtL + (nt * 16 + fr) * 72 + mt * 16 + fq * 4) = vw; } }
        __syncthreads();
        bf16x8 vB[2][2];
#pragma unroll
        for (int nt = 0; nt < 2; ++nt)
#pragma unroll
            for (int kk = 0; kk < 2; ++kk) vB[nt][kk] = *(const LAS bf16x8*)(VtL + (nt * 16 + fr) * 72 + kk * 32 + fq * 8);
        if (w >= 4) {
#pragma unroll
            for (int kk = 0; kk < 2; ++kk)
#pragma unroll
                for (int nt = 0; nt < 2; ++nt) acc[nt] = mfma16(cqk[kk], vB[nt][kk], acc[nt]);
#pragma unroll
            for (int nt = 0; nt < 2; ++nt) { u32x2 ow; ow.x = cvt_pk_bf16(acc[nt][0], acc[nt][1]); ow.y = cvt_pk_bf16(acc[nt][2], acc[nt][3]);
                *(u32x2*)(obuf + (size_t)item * 8192 + (slice * 32 + nt * 16 + fr) * 64 + mt * 16 + fq * 4) = ow; } }
#pragma unroll
        for (int nt = 0; nt < 2; ++nt) S[nt] *= cgl;
#pragma unroll
        for (int kk = 0; kk < 2; ++kk)
#pragma unroll
            for (int nt = 0; nt < 2; ++nt) S[nt] = mfma16(ckd[kk], vB[nt][kk], S[nt]);
#pragma unroll
        for (int kk = 0; kk < 4; ++kk) { ca[kk] = ma[kk]; ma[kk] = na[kk]; }
#pragma unroll
        for (int kk = 0; kk < 2; ++kk) { ckd[kk] = mkd[kk]; cqk[kk] = mqk[kk]; cuu[kk] = muu[kk]; mkd[kk] = nkd[kk]; mqk[kk] = nqk[kk]; muu[kk] = nuu[kk]; }
        cgl = mgl; mgl = ngl;
    }
    float* so = p.out + (samp ? OUT_SAS : OUT_PAS) + ((size_t)((l * 8 + b) * 4 + h)) * 16384;
#pragma unroll
    for (int nt = 0; nt < 2; ++nt)
#pragma unroll
        for (int jj = 0; jj < 4; ++jj) so[(w * 16 + fq * 4 + jj) * 128 + slice * 32 + nt * 16 + fr] = S[nt][jj];
    __syncthreads();
}
__device__ __forceinline__ void hgrn_scan(const Params& p, int l, int seq, int h, int slice, LAS unsigned char* lds) {
    unsigned char* ws = p.ws; const bf16_t* hbuf = (const bf16_t*)(ws + R_HBUF); const float* eh = (const float*)(ws + W_EH); bf16_t* obuf = (bf16_t*)(p.out + OUT_Y) + OBUF_H_OFF;
    int tid = threadIdx.x; asm volatile("" : "+v"(tid)); const int lane = tid & 63, w = tid >> 6, fr = lane & 15, fq = lane >> 4, wd = w & 3;
    const bool samp = seq >= 8; const int b = seq & 7; const int nsteps = samp ? 1 : 64, chunk0 = samp ? 512 + b : b * 64;
    f32x4 S = (f32x4){0.f, 0.f, 0.f, 0.f};
    if (samp) { const float* s0 = p.in[8] + ((size_t)((l * 8 + b) * 4 + h)) * 4096;
#pragma unroll
        for (int jj = 0; jj < 4; ++jj) S[jj] = s0[(wd * 16 + fq * 4 + jj) * 64 + slice * 16 + fr]; }
#define HG_LOAD(QA_, AT_, KH_, VB_, EV_, item_) do { const bf16_t* hi_ = hbuf + (size_t)(item_) * HITEM; \
        _Pragma("unroll") for (int kk = 0; kk < 2; ++kk) VB_[kk] = *(const bf16x8*)(hi_ + 8192 + (slice * 16 + fr) * 64 + kk * 32 + fq * 8); \
        if (w >= 4) { _Pragma("unroll") for (int kk = 0; kk < 2; ++kk) { QA_[kk] = *(const bf16x8*)(hi_ + (wd * 16 + fr) * 64 + kk * 32 + fq * 8); AT_[kk] = *(const bf16x8*)(hi_ + 12288 + (wd * 16 + fr) * 64 + kk * 32 + fq * 8); } } \
        else { _Pragma("unroll") for (int kk = 0; kk < 2; ++kk) KH_[kk] = *(const bf16x8*)(hi_ + 4096 + (wd * 16 + fr) * 64 + kk * 32 + fq * 8); \
            EV_ = *(const f32x4*)(eh + (size_t)(item_) * 64 + wd * 16 + fq * 4); } } while (0)
    bf16x8 cqa[2] = {}, cat[2] = {}, ckh[2] = {}, cvb[2]; f32x4 cev = (f32x4){0.f, 0.f, 0.f, 0.f};
    bf16x8 mqa[2] = {}, mat[2] = {}, mkh[2] = {}, mvb[2]; f32x4 mev = (f32x4){0.f, 0.f, 0.f, 0.f};
    HG_LOAD(cqa, cat, ckh, cvb, cev, chunk0 * 4 + h);
    { const int it1 = (nsteps > 1) ? (chunk0 + 1) * 4 + h : chunk0 * 4 + h; HG_LOAD(mqa, mat, mkh, mvb, mev, it1); }
    for (int step = 0; step < nsteps; ++step) {
        const int item = (chunk0 + step) * 4 + h;
        bf16x8 nqa[2] = {}, nat[2] = {}, nkh[2] = {}, nvb[2]; f32x4 nev = (f32x4){0.f, 0.f, 0.f, 0.f};
        { const int nit = (step + 2 < nsteps) ? item + 8 : item; HG_LOAD(nqa, nat, nkh, nvb, nev, nit); }
        LAS bf16_t* StL = (LAS bf16_t*)lds + (step & 1) * (16 * 72);
        if (w < 4) { u32x2 wv; wv.x = cvt_pk_bf16(S[0], S[1]); wv.y = cvt_pk_bf16(S[2], S[3]); *(LAS u32x2*)(StL + fr * 72 + w * 16 + fq * 4) = wv; }
        __syncthreads();
        if (w >= 4) { f32x4 o = (f32x4){0.f, 0.f, 0.f, 0.f};
#pragma unroll
            for (int kk = 0; kk < 2; ++kk) o = mfma16(cqa[kk], *(const LAS bf16x8*)(StL + fr * 72 + kk * 32 + fq * 8), o);
#pragma unroll
            for (int kk = 0; kk < 2; ++kk) o = mfma16(cat[kk], cvb[kk], o);
            u32x2 ow; ow.x = cvt_pk_bf16(o[0], o[1]); ow.y = cvt_pk_bf16(o[2], o[3]); *(u32x2*)(obuf + (size_t)item * 4096 + (slice * 16 + fr) * 64 + wd * 16 + fq * 4) = ow;
        } else { S = S * cev;
#pragma unroll
            for (int kk = 0; kk < 2; ++kk) S = mfma16(ckh[kk], cvb[kk], S); }
#pragma unroll
        for (int kk = 0; kk < 2; ++kk) { cqa[kk] = mqa[kk]; cat[kk] = mat[kk]; ckh[kk] = mkh[kk]; cvb[kk] = mvb[kk]; mqa[kk] = nqa[kk]; mat[kk] = nat[kk]; mkh[kk] = nkh[kk]; mvb[kk] = nvb[kk]; }
        cev = mev; mev = nev;
    }
    if (w < 4) { float* so = p.out + (samp ? OUT_SCS : OUT_PCS) + ((size_t)((l * 8 + b) * 4 + h)) * 4096;
#pragma unroll
        for (int jj = 0; jj < 4; ++jj) so[(w * 16 + fq * 4 + jj) * 64 + slice * 16 + fr] = S[jj]; }
    __syncthreads();
}
__device__ __forceinline__ void scan_phase(const Params& p, int l, LAS unsigned char* lds) {
    for (int x = blockIdx.x; x < 256; x += gridDim.x) {
        const int y = x & 127, xcd = y & 7, r = y >> 3, chain = xcd * 4 + (r >> 2), slice = r & 3, b = chain >> 2, h = chain & 3;
        if (x < 128) {
#pragma unroll 1
            for (int sq = 0; sq < 2; ++sq) gdn_scan(p, l, sq * 8 + b, h, slice, lds); }
        else {
#pragma unroll 1
            for (int sq = 0; sq < 2; ++sq) hgrn_scan(p, l, sq * 8 + b, h, slice, lds);
#pragma unroll 1
            for (int chunk = x - 128; chunk < NCHUNK; chunk += 128) rg_apply_chunk(p, l, chunk); }
    }
}

__device__ __forceinline__ void apply_phase(const Params& p, int l, LAS unsigned char* lds) {
    unsigned char* ws = p.ws;
    const bf16_t* gbuf = (const bf16_t*)(ws + R_GBUF); const bf16_t* hbuf = (const bf16_t*)(ws + R_HBUF); bf16_t* zbuf = (bf16_t*)(ws + R_ZBUF);
    const bf16_t* hloc = (const bf16_t*)(ws + R_HLOC); const bf16_t* pcum = (const bf16_t*)(ws + R_PCUM); const float* sumA = (const float*)(ws + W_SUMA); const float* sumH = (const float*)(ws + W_SUMH);
    LAS bf16_t* ot = (LAS bf16_t*)lds;
    int tid = threadIdx.x; asm volatile("" : "+v"(tid));
    for (int it = blockIdx.x; it < NCHUNK * 8; it += gridDim.x) {
        const int chunk = it >> 3, sub = it & 7; const bool samp = chunk >= 512; const int b = samp ? chunk - 512 : chunk >> 6, n = samp ? 0 : (chunk & 63);
        if (sub < 4) { const int h = sub; const bf16_t* oT = (const bf16_t*)(p.out + OUT_Y) + (size_t)(chunk * 4 + h) * 8192;
            __syncthreads();
#pragma unroll
            for (int i = 0; i < 2; ++i) { const int pc = tid + i * 512, dv = pc >> 3, t8 = (pc & 7) * 8; *(LAS u32x4*)(ot + dv * 72 + t8) = *(const u32x4*)(oT + dv * 64 + t8); }
            __syncthreads();
            const int tok = tid >> 3, cgp = tid & 7; float v[16]; float ss = 0.f;
#pragma unroll
            for (int i = 0; i < 16; ++i) { v[i] = bf2f(ot[(cgp * 16 + i) * 72 + tok]); ss += v[i] * v[i]; }
            ss += __shfl_xor(ss, 1); ss += __shfl_xor(ss, 2); ss += __shfl_xor(ss, 4);
            const float rn = rsqrtf(ss * (1.0f / 128.0f) + EPS);
            bf16_t* zp = zbuf + ((size_t)chunk * 64 + tok) * 1024 + h * 128 + cgp * 16; const float* an = p.in[16] + l * 128 + cgp * 16;
            float z[16]; unpack8(*(const u32x4*)zp, z); unpack8(*(const u32x4*)(zp + 8), z + 8);
#pragma unroll
            for (int i = 0; i < 16; ++i) v[i] = v[i] * rn * an[i] * siluf_(z[i]);
            *(u32x4*)zp = pack8(v); *(u32x4*)(zp + 8) = pack8(v + 8);
        } else if (sub < 8) { const int h = sub - 4; const bf16_t* oT = (const bf16_t*)(p.out + OUT_Y) + OBUF_H_OFF + (size_t)(chunk * 4 + h) * 4096;
            __syncthreads();
            { const int dv = tid >> 3, t8 = (tid & 7) * 8; *(LAS u32x4*)(ot + dv * 72 + t8) = *(const u32x4*)(oT + dv * 64 + t8); }
            __syncthreads();
            const int tok = tid >> 3, cgp = tid & 7; float v[8]; float ss = 0.f;
#pragma unroll
            for (int i = 0; i < 8; ++i) { v[i] = bf2f(ot[(cgp * 8 + i) * 72 + tok]); ss += v[i] * v[i]; }
            ss += __shfl_xor(ss, 1); ss += __shfl_xor(ss, 2); ss += __shfl_xor(ss, 4);
            const float rn = rsqrtf(ss * (1.0f / 64.0f) + EPS);
            bf16_t* zp = zbuf + ((size_t)chunk * 64 + tok) * 1024 + 768 + h * 64 + cgp * 8; const float* cn = p.in[25] + l * 64 + cgp * 8;
            float z[8]; unpack8(*(const u32x4*)zp, z);
#pragma unroll
            for (int i = 0; i < 8; ++i) v[i] = v[i] * rn * cn[i] * siluf_(z[i]);
            *(u32x4*)zp = pack8(v);
        }
    }
    __syncthreads();
}

__device__ __forceinline__ void attn_phase(const Params& p, int l, LAS unsigned char* lds) {
    unsigned char* ws = p.ws;
    const bf16_t* qbuf = (const bf16_t*)(ws + R_QBUF); bf16_t* oatt = (bf16_t*)(ws + R_OATT);
    int tid = threadIdx.x; asm volatile("" : "+v"(tid)); const int lane = tid & 63, w = tid >> 6, fr = lane & 15, fq = lane >> 4;
    for (int item = blockIdx.x; item < 1056; item += gridDim.x) {
        int row0, seq, h, nw;
        if (item < 1024) { const int tile = item >> 2; h = item & 3; row0 = tile * 128; seq = row0 >> 12; nw = 8; }
        else { const int i2 = item - 1024; seq = 8 + (i2 >> 2); h = i2 & 3; row0 = T_P + (i2 >> 2) * 64; nw = 4; }
        const bf16_t* Kp = (const bf16_t*)(ws + W_KB) + (size_t)(l * 16 + seq) * 256 * 1024 + h * 256;
        const bf16_t* Vp = (const bf16_t*)(ws + W_VT) + (size_t)((l * 16 + seq) * 4 + h) * 65536;
        const bool active = w < nw;
        const int qrow = row0 + (active ? w : 0) * 16 + fr;
        bf16x8 qB[8];
#pragma unroll
        for (int kk = 0; kk < 8; ++kk) qB[kk] = *(const bf16x8*)(qbuf + (size_t)qrow * 1024 + h * 256 + kk * 32 + fq * 8);
        f32x4 sacc[16];
#pragma unroll
        for (int i = 0; i < 16; ++i) sacc[i] = (f32x4){0.f, 0.f, 0.f, 0.f};
        bf16x8 pk[8]; float inv = 0.f;
        u32x4 stA[4], stB[4];
#pragma unroll
        for (int i = 0; i < 4; ++i) { const int idx = tid + i * 512, r = idx >> 5, c8 = (idx & 31) * 8; stA[i] = *(const u32x4*)(Kp + (size_t)r * 1024 + c8); stB[i] = *(const u32x4*)(Kp + (size_t)(64 + r) * 1024 + c8); }
        __syncthreads();
        auto round = [&](auto R8c) __attribute__((always_inline)) {
            constexpr int r8 = decltype(R8c)::value;
            LAS bf16_t* buf = (LAS bf16_t*)(lds + (r8 & 1) * 33792);
#pragma unroll
            for (int i = 0; i < 4; ++i) { const int idx = tid + i * 512, r = idx >> 5, c8 = (idx & 31) * 8; *(LAS u32x4*)(buf + r * 264 + c8) = (r8 & 1) ? stB[i] : stA[i]; }
            __syncthreads();
            if constexpr (r8 < 6) { constexpr int nr = r8 + 2;
#pragma unroll
                for (int i = 0; i < 4; ++i) { const int idx = tid + i * 512, r = idx >> 5, c8 = (idx & 31) * 8;
                    const u32x4 v = nr < 4 ? *(const u32x4*)(Kp + (size_t)(nr * 64 + r) * 1024 + c8) : *(const u32x4*)(Vp + (size_t)((nr - 4) * 64 + r) * 256 + c8);
                    if (r8 & 1) stB[i] = v; else stA[i] = v; } }
            if (active) {
                if constexpr (r8 < 4) {
#pragma unroll
                    for (int mt = 0; mt < 4; ++mt)
#pragma unroll
                        for (int kk = 0; kk < 8; ++kk) sacc[r8 * 4 + mt] = mfma16(*(const LAS bf16x8*)(buf + (mt * 16 + fr) * 264 + kk * 32 + fq * 8), qB[kk], sacc[r8 * 4 + mt]);
                    if constexpr (r8 == 3) { float mx = -3.0e38f;
#pragma unroll
                        for (int i = 0; i < 16; ++i) mx = fmaxf(mx, fmaxf(fmaxf(sacc[i][0], sacc[i][1]), fmaxf(sacc[i][2], sacc[i][3])));
                        mx = fmaxf(mx, __shfl_xor(mx, 16)); mx = fmaxf(mx, __shfl_xor(mx, 32));
                        float sm = 0.f;
#pragma unroll
                        for (int i = 0; i < 16; ++i) {
#pragma unroll
                            for (int jj = 0; jj < 4; ++jj) { const float e = __expf(sacc[i][jj] - mx); sacc[i][jj] = e; sm += e; } }
                        sm += __shfl_xor(sm, 16); sm += __shfl_xor(sm, 32); inv = 1.0f / sm;
#pragma unroll
                        for (int s = 0; s < 8; ++s) { u32x4 wv; wv.x = cvt_pk_bf16(sacc[2 * s][0], sacc[2 * s][1]); wv.y = cvt_pk_bf16(sacc[2 * s][2], sacc[2 * s][3]); wv.z = cvt_pk_bf16(sacc[2 * s + 1][0], sacc[2 * s + 1][1]); wv.w = cvt_pk_bf16(sacc[2 * s + 1][2], sacc[2 * s + 1][3]);
                            pk[s] = __builtin_bit_cast(bf16x8, wv); } }
                } else { constexpr int dt = r8 - 4;
#pragma unroll
                    for (int mt = 0; mt < 4; ++mt) { f32x4 o = (f32x4){0.f, 0.f, 0.f, 0.f};
#pragma unroll
                        for (int s = 0; s < 8; ++s) { const u32x2 lo = *(const LAS u32x2*)(buf + (mt * 16 + fr) * 264 + 32 * s + 4 * fq), hi2 = *(const LAS u32x2*)(buf + (mt * 16 + fr) * 264 + 32 * s + 16 + 4 * fq);
                            u32x4 av; av.x = lo.x; av.y = lo.y; av.z = hi2.x; av.w = hi2.y; o = mfma16(__builtin_bit_cast(bf16x8, av), pk[s], o); }
                        u32x2 ow; ow.x = cvt_pk_bf16(o[0] * inv, o[1] * inv); ow.y = cvt_pk_bf16(o[2] * inv, o[3] * inv);
                        *(u32x2*)(oatt + (size_t)qrow * 1024 + h * 256 + dt * 64 + mt * 16 + fq * 4) = ow; } }
            }
        };
        round(std::integral_constant<int, 0>{}); round(std::integral_constant<int, 1>{}); round(std::integral_constant<int, 2>{}); round(std::integral_constant<int, 3>{});
        round(std::integral_constant<int, 4>{}); round(std::integral_constant<int, 5>{}); round(std::integral_constant<int, 6>{}); round(std::integral_constant<int, 7>{});
    }
    __syncthreads();
}

__device__ __forceinline__ void final_norm(const Params& p) {
    const float* ssq = (const float*)(p.ws + W_SSQ) + 6ull * T_ALL; const float* g = p.in[38]; float* y = p.out + OUT_Y;
    int tidl = threadIdx.x; asm volatile("" : "+v"(tidl)); const int lane = tidl & 63, gw = blockIdx.x * 8 + (tidl >> 6), nw = gridDim.x * 8;
    for (int r = gw; r < T_ALL; r += nw) { const float rs = rsqrtf(ssqv(ssq, r) * (1.0f / 1024.0f) + EPS);
#pragma unroll
        for (int i = 0; i < 4; ++i) { const int c = i * 256 + lane * 4; f32x4 x = *(const f32x4*)(y + (size_t)r * 1024 + c); const f32x4 gg = *(const f32x4*)(g + c); x = x * rs * gg; *(f32x4*)(y + (size_t)r * 1024 + c) = x; } }
}

#define XB_TMO      128
#define XB_XCNT(j)  (256  + 64 * (j))
#define XB_XSUB(j)  (1280 + 64 * (j))
#define XB_XGEN(j)  (2304 + 64 * (j))
#define XB_TOP      3328
#define XB_TOPGEN   3392
#define XB_SPIN_CAP (1u << 18)
constexpr int XB_LDS_OFF = LDS_BYTES - 16;
__device__ __forceinline__ unsigned xb_ld(unsigned* p)              { return __hip_atomic_load(p, __ATOMIC_RELAXED, __HIP_MEMORY_SCOPE_AGENT); }
__device__ __forceinline__ unsigned xb_add(unsigned* p, unsigned v) { return __hip_atomic_fetch_add(p, v, __ATOMIC_RELAXED, __HIP_MEMORY_SCOPE_AGENT); }
__device__ __forceinline__ unsigned xb_xcc_id() { return (unsigned)__builtin_amdgcn_s_getreg((3 << 11) | 20) & 0xFu; }
#define XB_SPIN(cond, bar) do { unsigned _sp = 0; while (cond) { __builtin_amdgcn_s_sleep(1); \
    if ((++_sp & 255u) == 0u) { if (xb_ld(&(bar)[XB_TMO])) break; if (_sp > XB_SPIN_CAP) { atomicAdd(&(bar)[XB_TMO], 1u); break; } } } } while (0)
__device__ __forceinline__ void xcd_barrier_post(unsigned* bar) { if (threadIdx.x == 0) (void)xb_add(&bar[XB_XCNT(xb_xcc_id())], 1u); }
__device__ __forceinline__ void xcd_barrier_complete(unsigned* bar, unsigned x, unsigned& nloc, unsigned& nx) {
    const unsigned G = gridDim.x * gridDim.y * gridDim.z;
    unsigned sum, cnt, mine, sp = 0u;
    for (;;) {
        sum = 0u; cnt = 0u; mine = 0u;
#pragma unroll
        for (unsigned j = 0; j < 16; ++j) { const unsigned c = xb_ld(&bar[XB_XCNT(j)]); sum += c; cnt += (c > 0u) ? 1u : 0u; mine = (j == x) ? c : mine; }
        if (sum == G) break;
        __builtin_amdgcn_s_sleep(1);
        if ((++sp & 255u) == 0u) { if (xb_ld(&bar[XB_TMO])) break; if (sp > XB_SPIN_CAP) { atomicAdd(&bar[XB_TMO], 1u); break; } }
    }
    nloc = mine > 0u ? mine : 1u; nx = cnt > 0u ? cnt : 1u;
}
__device__ __forceinline__ void xcd_barrier(unsigned char* ws, LAS unsigned char* lds) {
    asm volatile("s_waitcnt vmcnt(0)" ::: "memory");
    __syncthreads();
    if (threadIdx.x == 0) {
        unsigned* bar = (unsigned*)(ws + W_BAR); volatile LAS unsigned* st = (volatile LAS unsigned*)(lds + XB_LDS_OFF); const unsigned x = xb_xcc_id();
        __builtin_amdgcn_s_waitcnt(0);
        unsigned nloc = st[0], nx = st[1];
        if (nloc == 0u) { xcd_barrier_complete(bar, x, nloc, nx); st[0] = nloc; st[1] = nx; }
        const unsigned old = xb_add(&bar[XB_XSUB(x)], 1u);
        const unsigned gen = old / nloc;
        if (old + 1u == (gen + 1u) * nloc) {
            __builtin_amdgcn_fence(__ATOMIC_RELEASE, "agent");
            asm volatile("s_waitcnt vmcnt(0)" ::: "memory");
            const unsigned og = xb_add(&bar[XB_TOP], 1u);
            const unsigned tg = og / nx;
            if (og + 1u == (tg + 1u) * nx) xb_add(&bar[XB_TOPGEN], 1u);
            else XB_SPIN(xb_ld(&bar[XB_TOPGEN]) == tg, bar);
            __builtin_amdgcn_fence(__ATOMIC_ACQUIRE, "agent");
            xb_add(&bar[XB_XGEN(x)], 1u);
            asm volatile("s_waitcnt vmcnt(0)" ::: "memory");
        } else {
            XB_SPIN(xb_ld(&bar[XB_XGEN(x)]) == gen, bar);
            __builtin_amdgcn_fence(__ATOMIC_ACQUIRE, "agent");
            asm volatile("s_waitcnt vmcnt(0)" ::: "memory");
        }
    }
    __syncthreads();
}

__global__ void __launch_bounds__(512, 2) hybrid_fwd(Params p) {
    extern __shared__ __attribute__((aligned(16))) unsigned char smem[];
    LAS unsigned char* lds = (LAS unsigned char*)smem;
    cg::grid_group grid = cg::this_grid();
    unsigned char* ws = p.ws;
    float* ssq = (float*)(ws + W_SSQ);
    bf16_t* xb = (bf16_t*)(ws + W_XB) + XB_PRE * 1024;
    float* xf = p.out + OUT_Y;
    if (threadIdx.x == 0) { volatile LAS unsigned* st_ = (volatile LAS unsigned*)(lds + XB_LDS_OFF); st_[0] = 0u; st_[1] = 0u; }
    __syncthreads();
    xcd_barrier_post((unsigned*)(ws + W_BAR));

    if (TIMING && blockIdx.x == 0 && threadIdx.x == 0) { unsigned long long* tmr_ = (unsigned long long*)(p.ws + W_SSQ + (7ull * T_ALL + 4096) * 4); for (int i = 0; i < 31; ++i) tmr_[i] = 0ull; tmr_[31] = __builtin_amdgcn_s_memrealtime(); tmr_[30] = tmr_[31]; }
    phase0(p, lds);
    if (p.ws == nullptr) grid.sync();
    xcd_barrier(ws, lds); TMARK(0);
    { EpiKV E{p.out, ssq + 7ull * T_ALL}; pg8::gemm_phase<EpiKV, 0>(lds, (const bf16_t*)(ws + W_MEMB), (const bf16_t*)(ws + W_BKV), 1024, 8, 16, E); }
    xcd_barrier(ws, lds); TMARK(1);
#pragma unroll 1
    for (int l_ = 0; l_ < 2; ++l_) {
        int l = l_; asm volatile("" : "+s"(l));
        { EpiProj E{ws, ssq + (size_t)(3 * l) * T_ALL}; pg8::gemm_phase<EpiProj, 0>(lds, xb, (const bf16_t*)(ws + W_BIN) + (size_t)l * NINP * 1024, 1024, 130, 15, E); }
        if (l == 0) kv_prompt_convert(p, lds);
        xcd_barrier(ws, lds); TMARK(2);
        if (STOP_AFTER <= 1) return;
        gdn_prep(p, l, lds); TMARK(3); hgrn_prep(p, l, lds); TMARK(4); rg_prep(p, l, lds);
        xcd_barrier(ws, lds); TMARK(5);
        if (STOP_AFTER <= 2) return;
        scan_phase(p, l, lds);
        xcd_barrier(ws, lds); TMARK(6);
        if (STOP_AFTER <= 3) return;
        apply_phase(p, l, lds);
        xcd_barrier(ws, lds); TMARK(7);
        if (STOP_AFTER <= 4) return;
        { EpiRes E{nullptr, xb, ssq + (size_t)(3 * l + 1) * T_ALL}; pg8::gemm_phase<EpiRes, 0>(lds, (const bf16_t*)(ws + R_ZBUF), (const bf16_t*)(ws + W_BOUT) + (size_t)l * 1024 * 1024, 1024, 128, 4, E);
          small_gemm<0>((const bf16_t*)(ws + R_ZBUF), (const bf16_t*)(ws + W_BOUT) + (size_t)l * 1024 * 1024, 1024, xb, nullptr, ssq + (size_t)(3 * l + 1) * T_ALL, nullptr); }
        xcd_barrier(ws, lds); TMARK(8);
        { EpiQ E{(bf16_t*)(ws + R_QBUF), ssq + (size_t)(3 * l + 1) * T_ALL}; pg8::gemm_phase<EpiQ, 0>(lds, xb, (const bf16_t*)(ws + W_BQ) + (size_t)l * 1024 * 1024, 1024, 128, 4, E);
          small_gemm<1>(xb, (const bf16_t*)(ws + W_BQ) + (size_t)l * 1024 * 1024, 1024, (bf16_t*)(ws + R_QBUF), nullptr, nullptr, ssq + (size_t)(3 * l + 1) * T_ALL); }
        xcd_barrier(ws, lds); TMARK(9);
        if (STOP_AFTER <= 5) return;
        attn_phase(p, l, lds);
        xcd_barrier(ws, lds); TMARK(10);
        if (STOP_AFTER <= 6) return;
        { EpiRes E{nullptr, xb, ssq + (size_t)(3 * l + 2) * T_ALL}; pg8::gemm_phase<EpiRes, 0>(lds, (const bf16_t*)(ws + R_OATT), (const bf16_t*)(ws + W_BO) + (size_t)l * 1024 * 1024, 1024, 128, 4, E);
          small_gemm<0>((const bf16_t*)(ws + R_OATT), (const bf16_t*)(ws + W_BO) + (size_t)l * 1024 * 1024, 1024, xb, nullptr, ssq + (size_t)(3 * l + 2) * T_ALL, nullptr); }
        xcd_barrier(ws, lds); TMARK(11);
        { EpiUp E{(bf16_t*)(ws + R_ACT), ssq + (size_t)(3 * l + 2) * T_ALL, p.in[35] + (size_t)l * 3 * DFF2, p.in[36] + (size_t)l * DFF2, p.in[9] + (size_t)l * 8 * 2 * DFF2, p.out + OUT_PFC + (size_t)l * 8 * 2 * DFF2, p.out + OUT_SFC + (size_t)l * 8 * 2 * DFF2};
          if (STOP_AFTER <= 7) return;
          pg8::gemm_phase<EpiUp, 1>(lds, xb - 2 * 1024, (const bf16_t*)(ws + W_BUP) + (size_t)l * DFF2 * 1024, 1024, 133, 22, E); }
        xcd_barrier(ws, lds); TMARK(12);
        if (STOP_AFTER <= 8) return;
        { EpiRes E{l == 1 ? xf : nullptr, xb, ssq + (size_t)(3 * l + 3) * T_ALL}; pg8::gemm_phase<EpiRes, 0>(lds, (const bf16_t*)(ws + R_ACT), (const bf16_t*)(ws + W_BDN) + (size_t)l * 1024 * DFF, DFF, 128, 4, E);
          small_gemm<0>((const bf16_t*)(ws + R_ACT), (const bf16_t*)(ws + W_BDN) + (size_t)l * 1024 * DFF, DFF, xb, l == 1 ? xf : nullptr, ssq + (size_t)(3 * l + 3) * T_ALL, nullptr); }
        xcd_barrier(ws, lds); TMARK(13);
    }
    final_norm(p);
    if (TIMING) { xcd_barrier(ws, lds); TMARK(14);
        if (blockIdx.x == 0) { const unsigned long long* tmr_ = (const unsigned long long*)(p.ws + W_SSQ + (7ull * T_ALL + 4096) * 4);
#pragma unroll 1
            for (int k = 0; k < 16; ++k) { unsigned long long d = (k < 15) ? tmr_[(TIMING == 2 && k < 4) ? 20 + k : k] : (tmr_[31] - tmr_[30]); unsigned n = (unsigned)(d / 100ull); if (k == 15) n /= 2; if (n < 1) n = 1; if (n > 4000) n = 4000;
                const size_t off_ = k == 0 ? OUT_Y : k == 1 ? OUT_Y + (size_t)T_P * 1024 : k == 2 ? OUT_PMK : k == 3 ? OUT_PMV : k == 4 ? OUT_PAC : k == 5 ? OUT_PAS : k == 6 ? OUT_PBC : k == 7 ? OUT_PBH : k == 8 ? OUT_PCS : k == 9 ? OUT_PFC : k == 10 ? OUT_SAC : k == 11 ? OUT_SAS : k == 12 ? OUT_SBC : k == 13 ? OUT_SBH : k == 14 ? OUT_SCS : OUT_SFC; unsigned* o = (unsigned*)(p.out + off_); for (unsigned i = threadIdx.x; i < 4096; i += 512) o[i] = (i < n) ? 0xAAAAAAAAu : 0u; } } }
}

extern "C" void kernel_launch(void* const* d_in, const int* in_sizes, int n_in, void* d_out, int out_size, void* d_ws, size_t ws_size, hipStream_t stream) {
    static int grid = 0;
    if (grid == 0) {
        if (n_in != 39 || (size_t)out_size != OUT_TOTAL || ws_size < WS_NEED) { fprintf(stderr, "kernel_launch: unexpected shapes (n_in %d out %d ws %zu need %zu)\n", n_in, out_size, ws_size, (size_t)WS_NEED); grid = -1; return; }
        int dev = 0, cus = 0, per_cu = 0;
        hipGetDevice(&dev); hipDeviceGetAttribute(&cus, hipDeviceAttributeMultiprocessorCount, dev);
        hipFuncSetAttribute((const void*)hybrid_fwd, hipFuncAttributeMaxDynamicSharedMemorySize, LDS_BYTES);
        hipOccupancyMaxActiveBlocksPerMultiprocessor(&per_cu, (const void*)hybrid_fwd, 512, LDS_BYTES);
        if (per_cu < 1) per_cu = 1;
        (void)hipGetLastError();
        grid = cus * 1;
        if (grid > 256) grid = 256;
    }
    if (grid < 0) return;
    Params p{};
    for (int i = 0; i < 39; ++i) p.in[i] = (const float*)d_in[i];
    p.out = (float*)d_out; p.ws = (unsigned char*)d_ws;
    (void)hipMemsetAsync((unsigned char*)d_ws + W_BAR, 0, XCD_BAR_BYTES, stream);
    void* args[] = {&p};
    hipError_t e = hipLaunchCooperativeKernel((const void*)hybrid_fwd, dim3(grid), dim3(512), args, LDS_BYTES, stream);
    if (e != hipSuccess) fprintf(stderr, "cooperative launch failed: %s (grid %d)\n", hipGetErrorString(e), grid);
}
```

```cpp
#include <hip/hip_runtime.h>
#include <hip/hip_cooperative_groups.h>
#include <cstdio>
#include <type_traits>
namespace cg = cooperative_groups;

#define LAS __attribute__((address_space(3)))
typedef unsigned short bf16_t;
typedef short bf16x8 __attribute__((ext_vector_type(8)));
typedef short bf16x4 __attribute__((ext_vector_type(4)));
typedef float f32x4 __attribute__((ext_vector_type(4)));
typedef unsigned u32x4 __attribute__((ext_vector_type(4)));
typedef unsigned u32x2 __attribute__((ext_vector_type(2)));

constexpr int T_ALL = 33280, T_P = 32768, NCHUNK = 520, DM = 1024, NINP = 3840, DFF = 2816, DFF2 = 5632;
constexpr float EPS = 1e-6f;
constexpr size_t OUT_Y = 0;
constexpr size_t OUT_PMK = OUT_Y + (size_t)T_ALL * 1024;
constexpr size_t OUT_PMV = OUT_PMK + 2ull * 8 * 256 * 1024;
constexpr size_t SZ_AC = 2ull * 8 * 3 * 1536, SZ_AS = 2ull * 8 * 4 * 128 * 128, SZ_BC = 2ull * 8 * 3 * 256, SZ_BH = 2ull * 8 * 256, SZ_CS = 2ull * 8 * 4 * 64 * 64, SZ_FC = 2ull * 8 * 2 * 5632;
constexpr size_t OUT_PAC = OUT_PMV + 2ull * 8 * 256 * 1024;
constexpr size_t OUT_PAS = OUT_PAC + SZ_AC;
constexpr size_t OUT_PBC = OUT_PAS + SZ_AS;
constexpr size_t OUT_PBH = OUT_PBC + SZ_BC;
constexpr size_t OUT_PCS = OUT_PBH + SZ_BH;
constexpr size_t OUT_PFC = OUT_PCS + SZ_CS;
constexpr size_t OUT_SAC = OUT_PFC + SZ_FC;
constexpr size_t OUT_SAS = OUT_SAC + SZ_AC;
constexpr size_t OUT_SBC = OUT_SAS + SZ_AS;
constexpr size_t OUT_SBH = OUT_SBC + SZ_BC;
constexpr size_t OUT_SCS = OUT_SBH + SZ_BH;
constexpr size_t OUT_SFC = OUT_SCS + SZ_CS;
constexpr size_t OUT_TOTAL = OUT_SFC + SZ_FC;

constexpr size_t AL(size_t x) { return (x + 255) & ~(size_t)255; }
constexpr size_t W_BIN = 0;
constexpr size_t W_BOUT = W_BIN + 2ull * NINP * 1024 * 2;
constexpr size_t W_BQ = W_BOUT + 2ull * 1024 * 1024 * 2;
constexpr size_t W_BO = W_BQ + 2ull * 1024 * 1024 * 2;
constexpr size_t W_BKV = W_BO + 2ull * 1024 * 1024 * 2;
constexpr size_t W_BUP = W_BKV + 4096ull * 1024 * 2;
constexpr size_t W_BDN = W_BUP + 2ull * DFF2 * 1024 * 2;
constexpr size_t W_MEMB = W_BDN + 2ull * 1024 * DFF * 2;
constexpr size_t W_KB = W_MEMB + 2048ull * 1024 * 2;
constexpr size_t W_VT = W_KB + 2ull * 16 * 256 * 1024 * 2;
constexpr size_t XB_PRE = 2, XB_ROWS = (size_t)T_ALL + 2 + 318;
constexpr size_t W_XB = W_VT + 2ull * 16 * 256 * 1024 * 2;
constexpr size_t W_SSQ = W_XB + XB_ROWS * 1024 * 2;
constexpr size_t W_GL = W_SSQ + 8ull * T_ALL * 4;
constexpr size_t W_EH = AL(W_GL + 2080 * 4);
constexpr size_t W_SUMA = W_EH + 2080ull * 64 * 4;
constexpr size_t W_SUMH = W_SUMA + 520ull * 256 * 4;
constexpr size_t W_BAR = AL(W_SUMH + 520ull * 256 * 4);
constexpr size_t XCD_BAR_BYTES = 3456 * 4;
constexpr size_t W_R = AL(W_BAR + XCD_BAR_BYTES);
constexpr size_t GITEM = 36864;
constexpr size_t HITEM = 16384;
constexpr size_t R_GBUF = W_R;
constexpr size_t R_HBUF = R_GBUF + 2080ull * GITEM * 2;
constexpr size_t R_ZBUF = R_HBUF + 2080ull * HITEM * 2;
constexpr size_t R_BX = R_ZBUF + (size_t)T_ALL * 1024 * 2;
constexpr size_t R_HLOC = R_BX + (size_t)T_ALL * 256 * 2;
constexpr size_t R_PCUM = R_HLOC + (size_t)T_ALL * 256 * 2;
constexpr size_t R_HALO = R_PCUM + (size_t)T_ALL * 256 * 2;
constexpr size_t R_GATES = AL(R_HALO + 520ull * 3 * 1536 * 2);
constexpr size_t R_END1 = R_GATES + (size_t)T_ALL * 8 * 4;
constexpr size_t R_QBUF = W_R;
constexpr size_t R_OATT = R_QBUF + (size_t)T_ALL * 1024 * 2;
constexpr size_t R_ACT = W_R;
constexpr size_t R_END3 = R_ACT + ((size_t)T_ALL + 256) * DFF * 2;
constexpr size_t WS_NEED = (R_END1 > R_END3 ? R_END1 : R_END3);
static_assert(WS_NEED <= 512ull * 1024 * 1024, "workspace map exceeds 512 MiB");

constexpr int LDS_BYTES = 147456;
#ifndef TIMING
#define TIMING 0
#endif
#define TSCAN(k) do { if (TIMING == 2 && blockIdx.x == 0 && threadIdx.x == 0) { unsigned long long* tmr_ = (unsigned long long*)(p.ws + W_SSQ + (7ull * T_ALL + 4096) * 4); const unsigned long long t_ = __builtin_amdgcn_s_memrealtime(); tmr_[k] += t_ - tmr_[29]; tmr_[29] = t_; } } while (0)
#define TMARK(k) do { if (TIMING && blockIdx.x == 0 && threadIdx.x == 0) { unsigned long long* tmr_ = (unsigned long long*)(p.ws + W_SSQ + (7ull * T_ALL + 4096) * 4); const unsigned long long t_ = __builtin_amdgcn_s_memrealtime(); tmr_[k] += t_ - tmr_[31]; tmr_[31] = t_; } } while (0)
#ifndef STOP_AFTER
#define STOP_AFTER 99
#endif

struct Params {
    const float* in[39];
    float* out;
    unsigned char* ws;
};

__device__ __forceinline__ float bf2f(bf16_t b) { return __uint_as_float(((unsigned)b) << 16); }
typedef float f32x2_t __attribute__((ext_vector_type(2)));
typedef __bf16 bf16x2_t __attribute__((ext_vector_type(2)));
__device__ __forceinline__ unsigned cvt_pk_bf16(float lo, float hi) { const f32x2_t v = {lo, hi}; const bf16x2_t r = __builtin_convertvector(v, bf16x2_t); return __builtin_bit_cast(unsigned, r); }
__device__ __forceinline__ bf16_t f2bf(float f) { return (bf16_t)(cvt_pk_bf16(f, 0.f) & 0xffffu); }
__device__ __forceinline__ float lo_bf(unsigned w) { return __uint_as_float(w << 16); }
__device__ __forceinline__ float hi_bf(unsigned w) { return __uint_as_float(w & 0xffff0000u); }
__device__ __forceinline__ float sigmoidf_(float x) { return __builtin_amdgcn_rcpf(1.0f + __expf(-x)); }
__device__ __forceinline__ float siluf_(float x) { return x * __builtin_amdgcn_rcpf(1.0f + __expf(-x)); }
__device__ __forceinline__ float softplusf_(float x) { return x > 20.f ? x : log1pf(__expf(x)); }
__device__ __forceinline__ float gelu_tanh(float x) { const float u = 0.7978845608028654f * (x + 0.044715f * x * x * x); return 0.5f * x * (1.0f + tanhf(u)); }
__device__ __forceinline__ float ssqv(const float* ssq, int row) { return (float)__float_as_uint(ssq[row]) * (1.0f / 4096.0f); }
__device__ __forceinline__ unsigned ssq_fix(float s) { return (unsigned)(s * 4096.0f + 0.5f); }
__device__ __forceinline__ f32x4 mfma16(bf16x8 a, bf16x8 b, f32x4 c) { return __builtin_amdgcn_mfma_f32_16x16x32_bf16(a, b, c, 0, 0, 0); }
__device__ __forceinline__ void unpack8(u32x4 w, float* f) { f[0] = lo_bf(w.x); f[1] = hi_bf(w.x); f[2] = lo_bf(w.y); f[3] = hi_bf(w.y); f[4] = lo_bf(w.z); f[5] = hi_bf(w.z); f[6] = lo_bf(w.w); f[7] = hi_bf(w.w); }
__device__ __forceinline__ u32x4 pack8(const float* f) { u32x4 w; w.x = cvt_pk_bf16(f[0], f[1]); w.y = cvt_pk_bf16(f[2], f[3]); w.z = cvt_pk_bf16(f[4], f[5]); w.w = cvt_pk_bf16(f[6], f[7]); return w; }

namespace pg8 {
constexpr int BM = 256, BK = 64, HALF = 128, HTB = HALF * BK * 2, STAGE_BYTES = 8 * HTB, NXCD = 8, WGM = 8;
__device__ __forceinline__ int lds_byte(int r, int c) { const int st = (r >> 4) * 2 + (c >> 5), rr = r & 15, cc = c & 31, ob = rr * 64 + cc * 2; return st * 1024 + (ob ^ (((ob >> 9) & 1) << 5)); }
__device__ __forceinline__ void stage_rc(int b, int& R, int& C) { const int st = b / 1024, sb = b % 1024, swz = sb ^ (((sb >> 9) & 1) << 5); R = (st >> 1) * 16 + swz / 64; C = (st & 1) * 32 + (swz % 64) / 2; }
__device__ __forceinline__ int perm32(int rho) { const int n = rho >> 4, i = rho & 15; return 8 * (i >> 2) + 4 * n + (i & 3); }
struct Unit { int pm, pn; };
struct Order {
    int nM, nN, nwg, G, c;
    __device__ void init(int nM_, int nN_, int G_, int c_) { nM = nM_; nN = nN_; nwg = nM * nN; G = G_; c = c_; }
    __device__ bool next(int i, Unit& u) const {
        const long L = (long)i * G + c; if (L >= nwg) return false;
        int wgid = (int)L; { const int q = nwg / NXCD, r = nwg % NXCD, xcd = wgid % NXCD, off = wgid / NXCD; wgid = (xcd < r ? xcd * (q + 1) : r * (q + 1) + (xcd - r) * q) + off; }
        const int nig = WGM * nN, gid = wgid / nig, fm = gid * WGM, gsz = (nM - fm) < WGM ? (nM - fm) : WGM;
        u.pm = fm + ((wgid % nig) % gsz); u.pn = (wgid % nig) / gsz; return true;
    }
};
template <class Epi, int AMODE>
__device__ __forceinline__ void gemm_phase(LAS unsigned char* lds, const bf16_t* A, const bf16_t* Bt, int K, int nM, int nN, const Epi& E) {
    int tid = threadIdx.x; asm volatile("" : "+v"(tid)); const int wid = __builtin_amdgcn_readfirstlane(tid >> 6), lane = tid & 63, wr = wid >> 2, wc = wid & 3, fr = lane & 15, fq = lane >> 4;
    const int nt = K / BK;
    unsigned voffA[2], voffB[2];
#pragma unroll
    for (int i = 0; i < 2; ++i) { int R, C; stage_rc(tid * 16 + i * 8192, R, C); const int Rb = Epi::PERM ? ((R & ~31) + perm32(R & 31)) : R;
        const int Ra = AMODE ? ((R >> 6) * 126 + (R & 63)) : R;
        voffA[i] = (unsigned)(Ra * K + C) * 2u; voffB[i] = (unsigned)(Rb * K + C) * 2u; }
    const size_t kstep = (size_t)(BK * 2);
    const size_t hstepB = (size_t)HALF * K * 2, tstepB = 2 * hstepB;
    const size_t hstepA = AMODE ? (size_t)64 * K * 2 : hstepB, tstepA = AMODE ? (size_t)252 * K * 2 : tstepB;
    const unsigned ldsw = (unsigned)wid * 1024u;
    const int aoff = lds_byte(wr * 64 + fr, fq * 8), boff = lds_byte(wc * 32 + fr, fq * 8);
#define PG8_SA(b, h) (((b) * 2 + (h)) * HTB)
#define PG8_SB(b, h) ((4 + (b) * 2 + (h)) * HTB)
#define PG8_STAGE(bufoff, gbase, voff) do { _Pragma("unroll") for (int _i = 0; _i < 2; ++_i) \
        __builtin_amdgcn_global_load_lds((const unsigned*)((const char*)(gbase) + (voff)[_i]), (LAS unsigned*)(lds + (bufoff) + ldsw + _i * 8192), 16, 0, 0); } while (0)
#define PG8_LDA(dst, b, h) do { _Pragma("unroll") for (int m = 0; m < 4; ++m) _Pragma("unroll") for (int k = 0; k < 2; ++k) dst[m][k] = *(const LAS bf16x8*)(lds + PG8_SA(b, h) + aoff + m * 2048 + k * 1024); } while (0)
#define PG8_LDB(dst, b, h) do { _Pragma("unroll") for (int n = 0; n < 2; ++n) _Pragma("unroll") for (int k = 0; k < 2; ++k) dst[n][k] = *(const LAS bf16x8*)(lds + PG8_SB(b, h) + boff + n * 2048 + k * 1024); } while (0)
#define PG8_MMA(ai, bj, At, Bt_) do { __builtin_amdgcn_s_setprio(1); _Pragma("unroll") for (int m = 0; m < 4; ++m) _Pragma("unroll") for (int n = 0; n < 2; ++n) _Pragma("unroll") for (int k = 0; k < 2; ++k) \
        acc[ai][bj][m][n] = __builtin_amdgcn_mfma_f32_16x16x32_bf16(Bt_[n][k], At[m][k], acc[ai][bj][m][n], 0, 0, 0); __builtin_amdgcn_s_setprio(0); } while (0)
#define PG8_WAIT_V(n) asm volatile("s_waitcnt vmcnt(" #n ")" ::: "memory")
#define PG8_WAIT_L(n) asm volatile("s_waitcnt lgkmcnt(" #n ")" ::: "memory")
#define PG8_BAR __builtin_amdgcn_s_barrier()
#define PG8_SCHED __builtin_amdgcn_sched_barrier(0)
    int bid_ = blockIdx.x; asm volatile("" : "+s"(bid_));
    Order S; S.init(nM, nN, gridDim.x, bid_);
    Unit cur, nxt; int ui = 0;
    if (!S.next(0, cur)) return;
    f32x4 acc[2][2][4][2];
    if constexpr (Epi::PRELOAD) E.preload(acc, cur, wr, wc);
    else {
#pragma unroll
    for (int a = 0; a < 2; ++a)
#pragma unroll
        for (int b = 0; b < 2; ++b)
#pragma unroll
            for (int m = 0; m < 4; ++m)
#pragma unroll
                for (int n = 0; n < 2; ++n) acc[a][b][m][n] = (f32x4){0.f, 0.f, 0.f, 0.f}; }
    bf16x8 At[4][2], B0[2][2], B1[2][2];
    const char* cA = (const char*)A + (size_t)cur.pm * tstepA; const char* cB = (const char*)Bt + (size_t)cur.pn * tstepB;
    PG8_STAGE(PG8_SB(0, 0), cB, voffB); PG8_STAGE(PG8_SA(0, 0), cA, voffA); PG8_STAGE(PG8_SB(0, 1), cB + hstepB, voffB); PG8_STAGE(PG8_SA(0, 1), cA + hstepA, voffA);
    if (wr == 1) PG8_BAR;
    PG8_WAIT_V(4); PG8_BAR;
    PG8_STAGE(PG8_SB(1, 0), cB + kstep, voffB); PG8_STAGE(PG8_SA(1, 0), cA + kstep, voffA); PG8_STAGE(PG8_SB(1, 1), cB + hstepB + kstep, voffB);
    PG8_WAIT_V(6); PG8_BAR;
    for (;;) {
        const bool has_next = S.next(ui + 1, nxt);
        const char* nA = has_next ? (const char*)A + (size_t)nxt.pm * tstepA : cA; const char* nB = has_next ? (const char*)Bt + (size_t)nxt.pn * tstepB : cB;
        for (int t = 0; t < nt; t += 2) {
            const bool last = (t == nt - 2);
            const char* a1 = cA + (size_t)(t + 1) * kstep;
            const char* a2 = last ? nA : cA + (size_t)(t + 2) * kstep; const char* b2 = last ? nB : cB + (size_t)(t + 2) * kstep;
            const char* a3 = a2 + kstep; const char* b3 = b2 + kstep;
            PG8_LDB(B0, 0, 0); PG8_SCHED; PG8_LDA(At, 0, 0); PG8_STAGE(PG8_SA(1, 1), a1 + hstepA, voffA);
            PG8_WAIT_L(8); PG8_BAR; PG8_WAIT_L(0); PG8_MMA(0, 0, At, B0); PG8_BAR; PG8_SCHED;
            PG8_LDB(B1, 0, 1); PG8_STAGE(PG8_SB(0, 0), b2, voffB);
            PG8_BAR; PG8_WAIT_L(0); PG8_MMA(0, 1, At, B1); PG8_BAR;
            PG8_LDA(At, 0, 1); PG8_STAGE(PG8_SA(0, 0), a2, voffA);
            PG8_BAR; PG8_WAIT_L(0); PG8_MMA(1, 0, At, B0); PG8_BAR; PG8_SCHED;
            PG8_STAGE(PG8_SB(0, 1), b2 + hstepB, voffB);
            PG8_WAIT_V(6); PG8_BAR; PG8_MMA(1, 1, At, B1); PG8_BAR;
            PG8_LDB(B0, 1, 0); PG8_SCHED; PG8_LDA(At, 1, 0); PG8_STAGE(PG8_SA(0, 1), a2 + hstepA, voffA);
            PG8_WAIT_L(8); PG8_BAR; PG8_WAIT_L(0); PG8_MMA(0, 0, At, B0); PG8_BAR; PG8_SCHED;
            PG8_LDB(B1, 1, 1); PG8_STAGE(PG8_SB(1, 0), b3, voffB);
            PG8_BAR; PG8_WAIT_L(0); PG8_MMA(0, 1, At, B1); PG8_BAR;
            PG8_LDA(At, 1, 1); PG8_STAGE(PG8_SA(1, 0), a3, voffA);
            PG8_BAR; PG8_WAIT_L(0); PG8_MMA(1, 0, At, B0); PG8_BAR; PG8_SCHED;
            PG8_STAGE(PG8_SB(1, 1), b3 + hstepB, voffB);
            PG8_WAIT_V(6); PG8_BAR; PG8_MMA(1, 1, At, B1); PG8_BAR;
        }
        E(acc, cur, wr, wc, fr, fq);
        if (!has_next) break;
        if constexpr (Epi::PRELOAD) E.preload(acc, nxt, wr, wc);
        else {
#pragma unroll
        for (int a = 0; a < 2; ++a)
#pragma unroll
            for (int b = 0; b < 2; ++b)
#pragma unroll
                for (int m = 0; m < 4; ++m)
#pragma unroll
                    for (int n = 0; n < 2; ++n) acc[a][b][m][n] = (f32x4){0.f, 0.f, 0.f, 0.f}; }
        cur = nxt; cA = nA; cB = nB; ++ui;
    }
    PG8_WAIT_V(0);
    if (wr == 0) PG8_BAR;
    PG8_BAR;
#undef PG8_SA
#undef PG8_SB
#undef PG8_STAGE
#undef PG8_LDA
#undef PG8_LDB
#undef PG8_MMA
#undef PG8_WAIT_V
#undef PG8_WAIT_L
#undef PG8_BAR
#undef PG8_SCHED
}
}
using pg8::Unit;
typedef f32x4 AccT[2][2][4][2];

struct EpiKV {
    static constexpr bool PERM = false, PRELOAD = false;
    float* out; const float* ssq;
    __device__ __forceinline__ void operator()(const AccT& acc, const Unit& u, int wr, int wc, int fr, int fq) const {
        { int ln_ = (int)__builtin_amdgcn_mbcnt_hi(~0u, __builtin_amdgcn_mbcnt_lo(~0u, 0u)); asm volatile("" : "+v"(ln_)); fr = ln_ & 15; fq = ln_ >> 4; }
        const int which = u.pn >> 2;
        float* base = out + ((which & 1) ? OUT_PMV : OUT_PMK) + (size_t)(which >> 1) * 2048 * 1024 + (u.pn & 3) * 256 + wc * 32 + 4 * fq;
#pragma unroll
        for (int ai = 0; ai < 2; ++ai)
#pragma unroll
            for (int m = 0; m < 4; ++m) { const int row = u.pm * 256 + ai * 128 + wr * 64 + m * 16 + fr; const float rs = rsqrtf(ssqv(ssq, row) * (1.0f / 1024.0f) + EPS);
                float* rowp = base + (size_t)row * 1024;
#pragma unroll
                for (int bj = 0; bj < 2; ++bj)
#pragma unroll
                    for (int n = 0; n < 2; ++n) *(f32x4*)(rowp + bj * 128 + n * 16) = acc[ai][bj][m][n] * rs; }
    }
};
struct EpiRes {
    static constexpr bool PERM = false, PRELOAD = true;
    float* xf; bf16_t* xb; float* ssq;
    __device__ __forceinline__ void preload(AccT& acc, const Unit& u, int wr, int wc) const {
        int ln_ = (int)__builtin_amdgcn_mbcnt_hi(~0u, __builtin_amdgcn_mbcnt_lo(~0u, 0u)); asm volatile("" : "+v"(ln_)); const int fr = ln_ & 15, fq = ln_ >> 4;
        const int col0 = u.pn * 256 + wc * 32 + 4 * fq;
#pragma unroll
        for (int ai = 0; ai < 2; ++ai)
#pragma unroll
            for (int m = 0; m < 4; ++m) { const int row = u.pm * 256 + ai * 128 + wr * 64 + m * 16 + fr; const bf16_t* rowb = xb + (size_t)row * 1024 + col0;
#pragma unroll
                for (int bj = 0; bj < 2; ++bj)
#pragma unroll
                    for (int n = 0; n < 2; ++n) { const u32x2 o = *(const u32x2*)(rowb + bj * 128 + n * 16); acc[ai][bj][m][n] = (f32x4){lo_bf(o.x), hi_bf(o.x), lo_bf(o.y), hi_bf(o.y)}; } }
    }
    __device__ __forceinline__ void operator()(const AccT& acc, const Unit& u, int wr, int wc, int fr, int fq) const {
        { int ln_ = (int)__builtin_amdgcn_mbcnt_hi(~0u, __builtin_amdgcn_mbcnt_lo(~0u, 0u)); asm volatile("" : "+v"(ln_)); fr = ln_ & 15; fq = ln_ >> 4; }
        const int col0 = u.pn * 256 + wc * 32 + 4 * fq;
#pragma unroll
        for (int ai = 0; ai < 2; ++ai)
#pragma unroll
            for (int m = 0; m < 4; ++m) { const int row = u.pm * 256 + ai * 128 + wr * 64 + m * 16 + fr; bf16_t* rowb = xb + (size_t)row * 1024 + col0;
                float s = 0.f;
#pragma unroll
                for (int bj = 0; bj < 2; ++bj)
#pragma unroll
                    for (int n = 0; n < 2; ++n) { const f32x4 x = acc[ai][bj][m][n];
                        u32x2 w; w.x = cvt_pk_bf16(x[0], x[1]); w.y = cvt_pk_bf16(x[2], x[3]); *(u32x2*)(rowb + bj * 128 + n * 16) = w;
                        if (xf) *(f32x4*)(xf + (size_t)row * 1024 + col0 + bj * 128 + n * 16) = x;
                        s += (x[0] * x[0] + x[1] * x[1]) + (x[2] * x[2] + x[3] * x[3]); }
                s += __shfl_xor(s, 16); s += __shfl_xor(s, 32);
                if (fq == 0) atomicAdd((unsigned*)(ssq + row), ssq_fix(s)); }
    }
};
struct EpiQ {
    static constexpr bool PERM = true, PRELOAD = false;
    bf16_t* q; const float* ssq;
    __device__ __forceinline__ void operator()(const AccT& acc, const Unit& u, int wr, int wc, int fr, int fq) const {
        { int ln_ = (int)__builtin_amdgcn_mbcnt_hi(~0u, __builtin_amdgcn_mbcnt_lo(~0u, 0u)); asm volatile("" : "+v"(ln_)); fr = ln_ & 15; fq = ln_ >> 4; }
        const int col0 = u.pn * 256 + wc * 32 + 8 * fq;
#pragma unroll
        for (int ai = 0; ai < 2; ++ai)
#pragma unroll
            for (int m = 0; m < 4; ++m) { const int row = u.pm * 256 + ai * 128 + wr * 64 + m * 16 + fr; const float rs = rsqrtf(ssqv(ssq, row) * (1.0f / 1024.0f) + EPS);
                bf16_t* rowp = q + (size_t)row * 1024 + col0;
#pragma unroll
                for (int bj = 0; bj < 2; ++bj) { const f32x4 v0 = acc[ai][bj][m][0] * rs, v1 = acc[ai][bj][m][1] * rs; u32x4 w; w.x = cvt_pk_bf16(v0[0], v0[1]); w.y = cvt_pk_bf16(v0[2], v0[3]); w.z = cvt_pk_bf16(v1[0], v1[1]); w.w = cvt_pk_bf16(v1[2], v1[3]);
                    *(u32x4*)(rowp + bj * 128) = w; } }
    }
};
struct EpiProj {
    static constexpr bool PERM = true, PRELOAD = false;
    unsigned char* ws; const float* ssq;
    __device__ __forceinline__ void operator()(const AccT& acc, const Unit& u, int wr, int wc, int fr, int fq) const {
        { int ln_ = (int)__builtin_amdgcn_mbcnt_hi(~0u, __builtin_amdgcn_mbcnt_lo(~0u, 0u)); asm volatile("" : "+v"(ln_)); fr = ln_ & 15; fq = ln_ >> 4; }
        bf16_t* gbuf = (bf16_t*)(ws + R_GBUF); bf16_t* hbuf = (bf16_t*)(ws + R_HBUF); bf16_t* zbuf = (bf16_t*)(ws + R_ZBUF); bf16_t* bx = (bf16_t*)(ws + R_BX); bf16_t* halo = (bf16_t*)(ws + R_HALO); float* gates = (float*)(ws + R_GATES);
        const int pn = u.pn;
#pragma unroll
        for (int ai = 0; ai < 2; ++ai)
#pragma unroll
            for (int m = 0; m < 4; ++m) { const int row = u.pm * 256 + ai * 128 + wr * 64 + m * 16 + fr; const float rs = rsqrtf(ssqv(ssq, row) * (1.0f / 1024.0f) + EPS);
                const int chunk = row >> 6, t = row & 63;
#pragma unroll
                for (int bj = 0; bj < 2; ++bj) { const f32x4 v0 = acc[ai][bj][m][0] * rs, v1 = acc[ai][bj][m][1] * rs;
                    const int cc = bj * 128 + wc * 32 + 8 * fq;
                    if (pn == 14) { if (cc == 0) { *(f32x4*)(gates + (size_t)row * 8) = v0; *(f32x4*)(gates + (size_t)row * 8 + 4) = v1; } continue; }
                    u32x4 w; w.x = cvt_pk_bf16(v0[0], v0[1]); w.y = cvt_pk_bf16(v0[2], v0[3]); w.z = cvt_pk_bf16(v1[0], v1[1]); w.w = cvt_pk_bf16(v1[2], v1[3]);
                    if (pn < 6) { const int which = pn >> 1, head = (pn & 1) * 2 + bj, d = wc * 32 + 8 * fq;
                        *(u32x4*)(gbuf + (size_t)(chunk * 4 + head) * GITEM + which * 8192 + t * 128 + d) = w;
                        if (t >= 61) *(u32x4*)(halo + (size_t)(chunk * 3 + (t - 61)) * 1536 + which * 512 + head * 128 + d) = w; }
                    else if (pn < 8) *(u32x4*)(zbuf + (size_t)row * 1024 + (pn - 6) * 256 + cc) = w;
                    else if (pn == 8) *(u32x4*)(bx + (size_t)row * 256 + cc) = w;
                    else if (pn == 9) *(u32x4*)(zbuf + (size_t)row * 1024 + 512 + cc) = w;
                    else if (pn < 13) { const int which = pn - 10, head = cc >> 6, d = cc & 63;
                        *(u32x4*)(hbuf + (size_t)(chunk * 4 + head) * HITEM + which * 4096 + t * 64 + d) = w; }
                    else *(u32x4*)(zbuf + (size_t)row * 1024 + 768 + cc) = w; } }
    }
};
struct EpiUp {
    static constexpr bool PERM = true, PRELOAD = false;
    bf16_t* act; const float* ssq; const float* convw; const float* convb; const float* state; float* outp; float* outs;
    __device__ __forceinline__ void operator()(const AccT& acc, const Unit& u, int wr, int wc, int fr, int fq) const {
        { int ln_ = (int)__builtin_amdgcn_mbcnt_hi(~0u, __builtin_amdgcn_mbcnt_lo(~0u, 0u)); asm volatile("" : "+v"(ln_)); fr = ln_ & 15; fq = ln_ >> 4; }
        const int lane = fq * 16 + fr;
        const int grow0 = u.pm * 252 + wr * 126 - 2;
        const int cbase = u.pn * 128 + wc * 32 + 8 * fq;
        (void)lane;
        float rsv[8];
#pragma unroll
        for (int g = 0; g < 8; ++g) { int grow = grow0 + g * 16 + fr; grow = grow < 0 ? 0 : (grow >= T_ALL ? T_ALL - 1 : grow); rsv[g] = rsqrtf(ssqv(ssq, grow) * (1.0f / 1024.0f) + EPS); }
#pragma unroll
        for (int n = 0; n < 2; ++n) {
            const int c = cbase + 4 * n;
            f32x4 wg[3], wv[3];
#pragma unroll
            for (int j = 0; j < 3; ++j) { wg[j] = *(const f32x4*)(convw + j * DFF2 + c); wv[j] = *(const f32x4*)(convw + j * DFF2 + DFF + c); }
            const f32x4 bg = *(const f32x4*)(convb + c), bv = *(const f32x4*)(convb + DFF + c);
            f32x4 pg_g = (f32x4){0.f, 0.f, 0.f, 0.f}, pg_v = pg_g;
#pragma unroll
            for (int g = 0; g < 8; ++g) {
                const int ai = g >> 2, m = g & 3;
                const f32x4 cg_ = acc[ai][0][m][n] * rsv[g], cv_ = acc[ai][1][m][n] * rsv[g];
                f32x4 p1g, p2g, p1v, p2v;
#pragma unroll
                for (int j = 0; j < 4; ++j) {
#define ROR1(x) __builtin_bit_cast(float, __builtin_amdgcn_update_dpp(0, __builtin_bit_cast(int, (float)(x)), 0x121, 0xf, 0xf, false))
#define ROR2(x) __builtin_bit_cast(float, __builtin_amdgcn_update_dpp(0, __builtin_bit_cast(int, (float)(x)), 0x122, 0xf, 0xf, false))
                    const float a1 = ROR1(cg_[j]), b1 = ROR1(pg_g[j]), a2 = ROR2(cg_[j]), b2 = ROR2(pg_g[j]);
                    p1g[j] = fr >= 1 ? a1 : b1; p2g[j] = fr >= 2 ? a2 : b2;
                    const float c1 = ROR1(cv_[j]), d1 = ROR1(pg_v[j]), c2 = ROR2(cv_[j]), d2 = ROR2(pg_v[j]);
                    p1v[j] = fr >= 1 ? c1 : d1; p2v[j] = fr >= 2 ? c2 : d2;
                }
                const int rho = g * 16 + fr, grow = grow0 + rho;
                if (rho >= 2 && grow < T_ALL) {
                    const bool samp = grow >= T_P; const int s = samp ? ((grow - T_P) & 63) : (grow & 4095); const int b = samp ? ((grow - T_P) >> 6) : (grow >> 12); const int L = samp ? 64 : 4096;
                    if (s < 2) {
                        f32x4 s0g = (f32x4){0.f, 0.f, 0.f, 0.f}, s1g = s0g, s0v = s0g, s1v = s0g;
                        if (samp) { const float* st = state + (size_t)b * 2 * DFF2; s0g = *(const f32x4*)(st + c); s1g = *(const f32x4*)(st + DFF2 + c); s0v = *(const f32x4*)(st + DFF + c); s1v = *(const f32x4*)(st + DFF2 + DFF + c); }
                        if (s == 0) { p1g = s1g; p2g = s0g; p1v = s1v; p2v = s0v; } else { p2g = s1g; p2v = s1v; }
                    }
                    const f32x4 yg = wg[0] * p2g + wg[1] * p1g + wg[2] * cg_ + bg;
                    const f32x4 yv = wv[0] * p2v + wv[1] * p1v + wv[2] * cv_ + bv;
                    u32x2 w; w.x = cvt_pk_bf16(siluf_(yg[0]) * yv[0], siluf_(yg[1]) * yv[1]); w.y = cvt_pk_bf16(siluf_(yg[2]) * yv[2], siluf_(yg[3]) * yv[3]);
                    *(u32x2*)(act + (size_t)grow * DFF + c) = w;
                    if (s >= L - 2) { float* o = (samp ? outs : outp) + ((size_t)b * 2 + (s - (L - 2))) * DFF2; *(f32x4*)(o + c) = cg_; *(f32x4*)(o + DFF + c) = cv_; }
                }
                pg_g = cg_; pg_v = cv_;
            }
        }
    }
};

template <int MODE>
__device__ __forceinline__ void small_gemm(const bf16_t* A, const bf16_t* Bt, int K, bf16_t* outb, float* xf, float* ssq_acc, const float* ssq_rs) {
    int tid = threadIdx.x; asm volatile("" : "+v"(tid)); const int lane = tid & 63, w = tid >> 6, fr = lane & 15, fq = lane >> 4;
    for (int t = blockIdx.x; t < 256; t += gridDim.x) {
        const int tm = t >> 5, tn = t & 31; const int row0 = T_P + tm * 64 + (w >> 1) * 16, col0 = tn * 32 + (w & 1) * 16;
        const bf16_t* ap = A + (size_t)(row0 + fr) * K + fq * 8; const bf16_t* bp = Bt + (size_t)(col0 + fr) * K + fq * 8;
        f32x4 acc = (f32x4){0.f, 0.f, 0.f, 0.f};
#pragma unroll 16
        for (int k = 0; k < K; k += 32) acc = mfma16(*(const bf16x8*)(ap + k), *(const bf16x8*)(bp + k), acc);
#pragma unroll
        for (int jj = 0; jj < 4; ++jj) { const int row = row0 + fq * 4 + jj, col = col0 + fr; const size_t o = (size_t)row * 1024 + col;
            if (MODE == 0) { const float x = bf2f(outb[o]) + acc[jj]; outb[o] = f2bf(x); if (xf) xf[o] = x;
                float sq = x * x; sq += __shfl_xor(sq, 1); sq += __shfl_xor(sq, 2); sq += __shfl_xor(sq, 4); sq += __shfl_xor(sq, 8);
                if (fr == 0) atomicAdd((unsigned*)(ssq_acc + row), ssq_fix(sq)); }
            else { const float rs = rsqrtf(ssqv(ssq_rs, row) * (1.0f / 1024.0f) + EPS); outb[o] = f2bf(acc[jj] * rs); } }
    }
}

__device__ __forceinline__ int src_col8(int mode, int j0) {
    if (mode == 1) { if (j0 < 2048) return j0; if (j0 < 3584) return j0 + 8; if (j0 < 3592) return 2048; return -1; }
    if (mode == 2) { const int pn = j0 >> 8, w = j0 & 255; return w < 128 ? pn * 128 + w : DFF + pn * 128 + (w - 128); }
    return j0;
}
__device__ __noinline__ void transpose_job(const float* W, int ldw, int Kdim, int Nout, int mode, const float* gain, float scale, bf16_t* Bt, LAS unsigned char* lds, int rot) {
    LAS bf16_t* tile = (LAS bf16_t*)lds;
    int tid = threadIdx.x; asm volatile("" : "+v"(tid)); const int ntn = Nout >> 6, ntiles = ntn * (Kdim >> 6);
    for (int t = (int)((blockIdx.x + gridDim.x - (rot % gridDim.x)) % gridDim.x); t < ntiles; t += gridDim.x) {
        const int kt = t / ntn, ntl = t % ntn, k0 = kt * 64, n0 = ntl * 64;
        { const int kk = tid >> 3, ng = tid & 7; const int s = src_col8(mode, n0 + ng * 8);
          f32x4 a = (f32x4){0.f, 0.f, 0.f, 0.f}, b = a;
          if (s >= 0) { const float* p = W + (size_t)(k0 + kk) * ldw + s; a = *(const f32x4*)p; b = *(const f32x4*)(p + 4); }
          const float g = (gain ? gain[k0 + kk] : 1.0f) * scale;
          const float v[8] = {a[0] * g, a[1] * g, a[2] * g, a[3] * g, b[0] * g, b[1] * g, b[2] * g, b[3] * g};
#pragma unroll
          for (int i = 0; i < 8; ++i) tile[(ng * 8 + i) * 72 + kk] = f2bf(v[i]); }
        __syncthreads();
        { const int nl = tid >> 3, kg = tid & 7; const u32x4 w = *(const LAS u32x4*)(tile + nl * 72 + kg * 8); *(u32x4*)(Bt + (size_t)(n0 + nl) * Kdim + k0 + kg * 8) = w; }
        __syncthreads();
    }
}
__device__ __forceinline__ void rows_to_bf16(const float* src, int nrows, bf16_t* dst, float* copy, float* ssq) {
    int tidl = threadIdx.x; asm volatile("" : "+v"(tidl)); const int lane = tidl & 63, gw = blockIdx.x * 8 + (tidl >> 6), nw = gridDim.x * 8;
    for (int r = gw; r < nrows; r += nw) {
        float s = 0.f;
#pragma unroll
        for (int i = 0; i < 4; ++i) { const int c = i * 256 + lane * 4; const f32x4 x = *(const f32x4*)(src + (size_t)r * 1024 + c);
            if (copy) *(f32x4*)(copy + (size_t)r * 1024 + c) = x;
            u32x2 w; w.x = cvt_pk_bf16(x[0], x[1]); w.y = cvt_pk_bf16(x[2], x[3]); *(u32x2*)(dst + (size_t)r * 1024 + c) = w;
            s += (x[0] * x[0] + x[1] * x[1]) + (x[2] * x[2] + x[3] * x[3]); }
#pragma unroll
        for (int o = 32; o >= 1; o >>= 1) s += __shfl_xor(s, o);
        if (lane == 0) ssq[r] = __uint_as_float(ssq_fix(s));
    }
}
__device__ __forceinline__ void convert_flat(const float* src, bf16_t* dst, size_t n8) {
    int tidl = threadIdx.x; asm volatile("" : "+v"(tidl)); for (size_t i = (size_t)blockIdx.x * 512 + tidl; i < n8; i += (size_t)gridDim.x * 512) { const f32x4 a = *(const f32x4*)(src + i * 8), b = *(const f32x4*)(src + i * 8 + 4);
        u32x4 w; w.x = cvt_pk_bf16(a[0], a[1]); w.y = cvt_pk_bf16(a[2], a[3]); w.z = cvt_pk_bf16(b[0], b[1]); w.w = cvt_pk_bf16(b[2], b[3]); *(u32x4*)(dst + i * 8) = w; }
}

__device__ __forceinline__ void phase0(const Params& p, LAS unsigned char* lds) {
    unsigned char* ws = p.ws;
    int rot = 0;
    for (int l = 0; l < 2; ++l) {
        transpose_job(p.in[12] + (size_t)l * 1024 * 3592, 3592, 1024, NINP, 1, p.in[11] + l * 1024, 1.0f, (bf16_t*)(ws + W_BIN) + (size_t)l * NINP * 1024, lds, rot); rot += 60 * 16;
        transpose_job(p.in[26] + (size_t)l * 1024 * 1024, 1024, 1024, 1024, 0, nullptr, 1.0f, (bf16_t*)(ws + W_BOUT) + (size_t)l * 1024 * 1024, lds, rot); rot += 256;
        transpose_job(p.in[29] + (size_t)l * 1024 * 1024, 1024, 1024, 1024, 0, p.in[27] + l * 1024, 0.0625f, (bf16_t*)(ws + W_BQ) + (size_t)l * 1024 * 1024, lds, rot); rot += 256;
        transpose_job(p.in[32] + (size_t)l * 1024 * 1024, 1024, 1024, 1024, 0, nullptr, 1.0f, (bf16_t*)(ws + W_BO) + (size_t)l * 1024 * 1024, lds, rot); rot += 256;
        transpose_job(p.in[30] + (size_t)l * 1024 * 1024, 1024, 1024, 1024, 0, p.in[28] + l * 1024, 1.0f, (bf16_t*)(ws + W_BKV) + (size_t)(l * 2048) * 1024, lds, rot); rot += 256;
        transpose_job(p.in[31] + (size_t)l * 1024 * 1024, 1024, 1024, 1024, 0, p.in[28] + l * 1024, 1.0f, (bf16_t*)(ws + W_BKV) + (size_t)(l * 2048 + 1024) * 1024, lds, rot); rot += 256;
        transpose_job(p.in[34] + (size_t)l * 1024 * DFF2, DFF2, 1024, DFF2, 2, p.in[33] + l * 1024, 1.0f, (bf16_t*)(ws + W_BUP) + (size_t)l * DFF2 * 1024, lds, rot); rot += 88 * 16;
        transpose_job(p.in[37] + (size_t)l * DFF * 1024, 1024, DFF, 1024, 0, nullptr, 1.0f, (bf16_t*)(ws + W_BDN) + (size_t)l * 1024 * DFF, lds, rot); rot += 16 * 44;
        for (int b = 0; b < 8; ++b) for (int h = 0; h < 4; ++h) {
            transpose_job(p.in[3] + ((size_t)(l * 8 + b) * 256) * 1024 + h * 256, 1024, 256, 256, 0, nullptr, 1.0f, (bf16_t*)(ws + W_VT) + ((size_t)((l * 16 + 8 + b) * 4 + h)) * 65536, lds, rot); rot += 16; }
        convert_flat(p.in[2] + (size_t)l * 8 * 256 * 1024, (bf16_t*)(ws + W_KB) + (size_t)(l * 16 + 8) * 256 * 1024, 8ull * 256 * 1024 / 8);
    }
    float* ssq = (float*)(ws + W_SSQ);
    bf16_t* xb = (bf16_t*)(ws + W_XB) + XB_PRE * 1024;
    rows_to_bf16(p.in[0], T_P, xb, nullptr, ssq);
    rows_to_bf16(p.in[1], 512, xb + (size_t)T_P * 1024, nullptr, ssq + T_P);
    rows_to_bf16(p.in[10], 2048, (bf16_t*)(ws + W_MEMB), nullptr, ssq + 7ull * T_ALL);
    int tidz = threadIdx.x; asm volatile("" : "+v"(tidz)); for (size_t i = (size_t)blockIdx.x * 512 + tidz; i < 6ull * T_ALL; i += (size_t)gridDim.x * 512) ssq[T_ALL + i] = 0.f;
}
__device__ __forceinline__ void kv_prompt_convert(const Params& p, LAS unsigned char* lds) {
    unsigned char* ws = p.ws; int rot = 0;
    for (int l = 0; l < 2; ++l) {
        convert_flat(p.out + OUT_PMK + (size_t)l * 2048 * 1024, (bf16_t*)(ws + W_KB) + (size_t)(l * 16) * 256 * 1024, 2048ull * 1024 / 8);
        for (int b = 0; b < 8; ++b) for (int h = 0; h < 4; ++h) {
            transpose_job(p.out + OUT_PMV + ((size_t)(l * 8 + b) * 256) * 1024 + h * 256, 1024, 256, 256, 0, nullptr, 1.0f, (bf16_t*)(ws + W_VT) + ((size_t)((l * 16 + b) * 4 + h)) * 65536, lds, rot); rot += 16; }
    }
}

__device__ __forceinline__ void gdn_prep(const Params& p, int l, LAS unsigned char* lds) {
    unsigned char* ws = p.ws;
    bf16_t* gbuf = (bf16_t*)(ws + R_GBUF); const bf16_t* halo = (const bf16_t*)(ws + R_HALO); const float* gates = (const float*)(ws + R_GATES); float* glb = (float*)(ws + W_GL);
    LAS bf16_t* qs = (LAS bf16_t*)lds;
    LAS bf16_t* ks = qs + 64 * 136; LAS bf16_t* vs = ks + 64 * 136;
    LAS float* Mm = (LAS float*)(lds + 52224);
    LAS float* gc = (LAS float*)(lds + 69632);
    LAS bf16_t* raw = (LAS bf16_t*)(lds + 70400);
    LAS bf16_t* Mb = (LAS bf16_t*)(lds + 70400);
    LAS bf16_t* TinvB = (LAS bf16_t*)(lds + 79616);
    LAS bf16_t* RT = (LAS bf16_t*)(lds + 84736);
    LAS bf16_t* solT = (LAS bf16_t*)(lds + 101120);
    int tid = threadIdx.x; asm volatile("" : "+v"(tid)); const int lane = tid & 63, wid = tid >> 6, fr = lane & 15, fq = lane >> 4;
    const float* convw = p.in[13] + (size_t)l * 4 * 1536;
    LAS float* cwL = (LAS float*)(lds + 137984);
    { const int hh = blockIdx.x & 3; for (int i = tid; i < 1536; i += 512) { const int j = i / 384, c = i % 384; cwL[i] = convw[j * 1536 + (c >> 7) * 512 + hh * 128 + (c & 127)]; } }
    __syncthreads();
    for (int item = blockIdx.x; item < 2080; item += gridDim.x) {
        const int chunk = item >> 2, h = item & 3; const bool samp = chunk >= 512; const int b = samp ? chunk - 512 : chunk >> 6, n = samp ? 0 : (chunk & 63);
        bf16_t* gi = gbuf + (size_t)item * GITEM;
        { u32x4 wv[6];
#pragma unroll
          for (int i = 0; i < 6; ++i) { const int pc = tid + i * 512, r = pc / 48, cp = pc % 48, which = cp >> 4, c8 = (cp & 15) * 8; wv[i] = *(const u32x4*)(gi + which * 8192 + r * 128 + c8); }
#pragma unroll
          for (int i = 0; i < 6; ++i) { const int pc = tid + i * 512, r = pc / 48, cp = pc % 48, which = cp >> 4, c8 = (cp & 15) * 8; *(LAS u32x4*)(raw + (r + 3) * 392 + which * 128 + c8) = wv[i]; }
          if (tid < 144) { const int r = tid / 48, cp = tid % 48, which = cp >> 4, c8 = (cp & 15) * 8; u32x4 w = (u32x4){0u, 0u, 0u, 0u};
            if (n > 0) w = *(const u32x4*)(halo + (size_t)((chunk - 1) * 3 + r) * 1536 + which * 512 + h * 128 + c8);
            else if (samp) { const float* st = p.in[4] + ((size_t)(l * 8 + b) * 3 + r) * 1536 + which * 512 + h * 128 + c8; const f32x4 a = *(const f32x4*)st, bb = *(const f32x4*)(st + 4);
                w.x = cvt_pk_bf16(a[0], a[1]); w.y = cvt_pk_bf16(a[2], a[3]); w.z = cvt_pk_bf16(bb[0], bb[1]); w.w = cvt_pk_bf16(bb[2], bb[3]); }
            *(LAS u32x4*)(raw + r * 392 + which * 128 + c8) = w; } }
        __syncthreads();
        if (samp || n == 63) { float* o = p.out + (samp ? OUT_SAC : OUT_PAC) + (size_t)(l * 8 + b) * 3 * 1536;
            for (int i = tid; i < 3 * 384; i += 512) { const int j = i / 384, c = i % 384, which = c >> 7, d = c & 127; o[j * 1536 + which * 512 + h * 128 + d] = bf2f(raw[(64 + j) * 392 + c]); } }
        { const int row = tid >> 3, cgp = tid & 7;
#pragma unroll 1
          for (int which = 0; which < 3; ++which) { float y[16]; float ss = 0.f;
#pragma unroll
              for (int hf = 0; hf < 2; ++hf) { const int c = cgp * 16 + hf * 8; float a8[8] = {0.f, 0.f, 0.f, 0.f, 0.f, 0.f, 0.f, 0.f};
#pragma unroll
                  for (int j = 0; j < 4; ++j) { float x8[8]; unpack8(*(const LAS u32x4*)(raw + (row + j) * 392 + which * 128 + c), x8); LAS const float* wp = cwL + j * 384 + which * 128 + c; const f32x4 w0 = *(LAS const f32x4*)wp, w1 = *(LAS const f32x4*)(wp + 4);
                      a8[0] += w0[0] * x8[0]; a8[1] += w0[1] * x8[1]; a8[2] += w0[2] * x8[2]; a8[3] += w0[3] * x8[3]; a8[4] += w1[0] * x8[4]; a8[5] += w1[1] * x8[5]; a8[6] += w1[2] * x8[6]; a8[7] += w1[3] * x8[7]; }
#pragma unroll
                  for (int i = 0; i < 8; ++i) { const float v = siluf_(a8[i]); y[hf * 8 + i] = v; ss += v * v; } }
              float sc = 1.0f;
              if (which < 2) { ss += __shfl_xor(ss, 1); ss += __shfl_xor(ss, 2); ss += __shfl_xor(ss, 4); sc = rsqrtf(ss + 1e-6f) * (which == 0 ? 0.08838834764831845f : 1.0f); }
#pragma unroll
              for (int i = 0; i < 16; ++i) y[i] *= sc;
              LAS bf16_t* dst = (which == 0 ? qs : (which == 1 ? ks : vs)) + row * 136 + cgp * 16;
              *(LAS u32x4*)dst = pack8(y); *(LAS u32x4*)(dst + 8) = pack8(y + 8); } }
        if (wid == 0) { const size_t rowg = (size_t)chunk * 64 + lane; const float ab = gates[rowg * 8 + h], aa = gates[rowg * 8 + 4 + h];
            const float beta = sigmoidf_(ab); float g = -__expf(p.in[14][l * 4 + h]) * softplusf_(aa + p.in[15][l * 4 + h]);
#pragma unroll
            for (int o = 1; o < 64; o <<= 1) { const float v = __shfl_up(g, o); if (lane >= o) g += v; }
            gc[lane] = g; gc[64 + lane] = beta; gc[128 + lane] = __expf(g); }
        __syncthreads();
        { const int ti = wid >> 1;
#pragma unroll
          for (int tjj = 0; tjj < 2; ++tjj) { const int tj = (wid & 1) * 2 + tjj;
              f32x4 akk = (f32x4){0.f, 0.f, 0.f, 0.f}, aqk = akk;
              if (tj <= ti) {
#pragma unroll
                  for (int kk = 0; kk < 4; ++kk) { const bf16x8 ak = *(const LAS bf16x8*)(ks + (ti * 16 + fr) * 136 + kk * 32 + fq * 8), aq = *(const LAS bf16x8*)(qs + (ti * 16 + fr) * 136 + kk * 32 + fq * 8), bk = *(const LAS bf16x8*)(ks + (tj * 16 + fr) * 136 + kk * 32 + fq * 8);
                      akk = mfma16(ak, bk, akk); aqk = mfma16(aq, bk, aqk); } }
              f32x4 mrow;
#pragma unroll
              for (int jj = 0; jj < 4; ++jj) { const int i = ti * 16 + fq * 4 + jj, j = tj * 16 + fr; float mval = 0.f, qv = 0.f;
                  if (j <= i) { const float dec = __expf(gc[i] - gc[j]); qv = aqk[jj] * dec; if (j < i) mval = gc[64 + i] * akk[jj] * dec; }
                  mrow[jj] = mval; Mb[i * 72 + j] = (tj < ti) ? f2bf(mval) : (bf16_t)0;
                  gi[32768 + i * 64 + j] = f2bf(qv); }
              if (tj <= ti) *(LAS f32x4*)(Mm + (tj * 16 + fr) * 68 + ti * 16 + fq * 4) = mrow; } }
        __syncthreads();
        if (tid < 64) { int tl_ = tid; asm volatile("" : "+v"(tl_)); const int I = tl_ >> 4, c = tl_ & 15; float x[16];
#pragma unroll
            for (int i = 0; i < 16; ++i) x[i] = (i == c) ? 1.0f : 0.0f;
#pragma unroll
            for (int j = 0; j < 15; ++j) {
#pragma unroll
                for (int q4 = 0; q4 < 4; ++q4) { if (q4 * 4 + 3 <= j) continue; const f32x4 mv = *(const LAS f32x4*)(Mm + (I * 16 + j) * 68 + I * 16 + q4 * 4);
#pragma unroll
                    for (int e = 0; e < 4; ++e) if (q4 * 4 + e > j) x[q4 * 4 + e] -= mv[e] * x[j]; } }
#pragma unroll
            for (int i = 0; i < 16; ++i) { TinvB[(I * 16 + i) * 40 + c] = f2bf(x[i]); TinvB[(I * 16 + i) * 40 + 16 + c] = 0; }
        } else if (tid < 256) { const u32x4 z4 = (u32x4){0u, 0u, 0u, 0u};
            for (int i = tid - 64; i < 3328; i += 192) *(LAS u32x4*)(lds + 84736 + i * 16) = z4;
        } else { const int t2 = tid - 256; const float glast = gc[63];
#pragma unroll
            for (int it = 0; it < 4; ++it) { const int idx = t2 + it * 256, i = idx >> 4, c8 = (idx & 15) * 8; float v[8]; unpack8(*(const LAS u32x4*)(qs + i * 136 + c8), v); const float e = gc[128 + i];
#pragma unroll
                for (int k = 0; k < 8; ++k) v[k] *= e;
                *(u32x4*)(gi + i * 128 + c8) = pack8(v); }
#pragma unroll
            for (int it = 0; it < 4; ++it) { const int idx = t2 + it * 256, d = idx >> 3, i8 = (idx & 7) * 8; float v[8];
#pragma unroll
                for (int k = 0; k < 8; ++k) v[k] = bf2f(ks[(i8 + k) * 136 + d]) * __expf(glast - gc[i8 + k]);
                *(u32x4*)(gi + 8192 + d * 64 + i8) = pack8(v); }
            if (t2 == 0) glb[item] = __expf(glast);
        }
        __syncthreads();
        { int tl2_ = tid; asm volatile("" : "+v"(tl2_)); const int fr = tl2_ & 15, fq = (tl2_ >> 4) & 3, wid = tl2_ >> 6;
#pragma unroll 1
          for (int I = 0; I < 4; ++I) {
              f32x4 racc[2] = {(f32x4){0.f, 0.f, 0.f, 0.f}, (f32x4){0.f, 0.f, 0.f, 0.f}};
              for (int ks2 = 0; ks2 * 32 < I * 16; ++ks2) {
                  const bf16x8 a = *(const LAS bf16x8*)(Mb + (I * 16 + fr) * 72 + ks2 * 32 + fq * 8);
                  const bf16x8 b0 = *(const LAS bf16x8*)(solT + ((wid * 2 + 0) * 16 + fr) * 72 + ks2 * 32 + fq * 8);
                  const bf16x8 b1 = *(const LAS bf16x8*)(solT + ((wid * 2 + 1) * 16 + fr) * 72 + ks2 * 32 + fq * 8);
                  racc[0] = mfma16(a, b0, racc[0]); racc[1] = mfma16(a, b1, racc[1]); }
#pragma unroll
              for (int n2 = 0; n2 < 2; ++n2) { const int col = (wid * 2 + n2) * 16 + fr; float rv[4];
#pragma unroll
                  for (int jj = 0; jj < 4; ++jj) { const int i = I * 16 + fq * 4 + jj; float v = (col < 128 ? bf2f(vs[i * 136 + col]) : bf2f(ks[i * 136 + col - 128]) * gc[128 + i]) * gc[64 + i]; rv[jj] = v - racc[n2][jj]; }
                  u32x2 wv; wv.x = cvt_pk_bf16(rv[0], rv[1]); wv.y = cvt_pk_bf16(rv[2], rv[3]); *(LAS u32x2*)(RT + col * 32 + fq * 4) = wv; }
              __syncthreads();
              { const bf16x8 a = *(const LAS bf16x8*)(TinvB + (I * 16 + fr) * 40 + fq * 8);
                const bf16x8 b0 = *(const LAS bf16x8*)(RT + ((wid * 2 + 0) * 16 + fr) * 32 + fq * 8), b1 = *(const LAS bf16x8*)(RT + ((wid * 2 + 1) * 16 + fr) * 32 + fq * 8);
                f32x4 sv2[2]; sv2[0] = (f32x4){0.f, 0.f, 0.f, 0.f}; sv2[1] = sv2[0];
                sv2[0] = mfma16(a, b0, sv2[0]); sv2[1] = mfma16(a, b1, sv2[1]);
#pragma unroll
                for (int n2 = 0; n2 < 2; ++n2) { const int col = (wid * 2 + n2) * 16 + fr;
                    float s4[4] = {sv2[n2][0] + 0.f, sv2[n2][1] + 0.f, sv2[n2][2] + 0.f, sv2[n2][3] + 0.f};
                    u32x2 wv; wv.x = cvt_pk_bf16(s4[0], s4[1]); wv.y = cvt_pk_bf16(s4[2], s4[3]);
                    *(LAS u32x2*)(solT + col * 72 + I * 16 + fq * 4) = wv;
                    if (col < 128) *(u32x2*)(gi + 16384 + col * 64 + I * 16 + fq * 4) = wv;
                    else {
#pragma unroll
                        for (int jj = 0; jj < 4; ++jj) gi[24576 + (I * 16 + fq * 4 + jj) * 128 + (col - 128)] = f2bf(s4[jj]); } } }
              __syncthreads(); } }
    }
}

__device__ __forceinline__ void hgrn_prep(const Params& p, int l, LAS unsigned char* lds) {
    unsigned char* ws = p.ws;
    bf16_t* hbuf = (bf16_t*)(ws + R_HBUF); float* eh = (float*)(ws + W_EH);
    LAS bf16_t* qt = (LAS bf16_t*)lds;
    LAS bf16_t* kt = qt + 64 * 72;
    LAS float* tot = (LAS float*)(lds + 2 * 64 * 72 * 2);
    LAS bf16_t* sq = (LAS bf16_t*)(lds + 20480);
    LAS bf16_t* sf = sq + 64 * 72; LAS bf16_t* si = sf + 64 * 72;
    int tid = threadIdx.x; asm volatile("" : "+v"(tid)); const int lane = tid & 63, wid = tid >> 6, fr = lane & 15, fq = lane >> 4;
    for (int item = (blockIdx.x + 64) % gridDim.x; item < 2080; item += gridDim.x) {
        const int h = item & 3; bf16_t* hi = hbuf + (size_t)item * HITEM;
        { const int t_ = tid >> 3, d8 = (tid & 7) * 8; const u32x4 va = *(const u32x4*)(hi + t_ * 64 + d8), vb = *(const u32x4*)(hi + 4096 + t_ * 64 + d8), vc = *(const u32x4*)(hi + 8192 + t_ * 64 + d8);
          *(LAS u32x4*)(sq + t_ * 72 + d8) = va; *(LAS u32x4*)(sf + t_ * 72 + d8) = vb; *(LAS u32x4*)(si + t_ * 72 + d8) = vc; }
        __syncthreads();
        const int d = tid & 63, seg = tid >> 6;
        float lb = 0.f; if (l == 1) lb = sigmoidf_(p.in[24][256 + h * 64 + d] - p.in[24][h * 64 + d]);
        float qc[8], kf[8], bc[8], vv[8]; float run = 0.f;
#pragma unroll
        for (int i = 0; i < 8; ++i) { const int t = seg * 8 + i; const float cq = bf2f(sq[t * 72 + d]), cf = bf2f(sf[t * 72 + d]); vv[i] = bf2f(si[t * 72 + d]);
            qc[i] = siluf_(cq); const float f = lb + (1.0f - lb) * sigmoidf_(cf); kf[i] = 1.0f - f; run += __logf(f); bc[i] = run; }
        tot[seg * 64 + d] = run;
        asm volatile("s_waitcnt vmcnt(0)" ::: "memory");
        __syncthreads();
        float pre = 0.f, ref = 0.f, all = 0.f;
#pragma unroll
        for (int s = 0; s < 8; ++s) { const float tv = tot[s * 64 + d]; if (s < seg) pre += tv; if (s < 4) ref += tv; all += tv; }
        { float qh8[8], kh8[8];
#pragma unroll
          for (int i = 0; i < 8; ++i) { const int t = seg * 8 + i; const float bct = pre + bc[i];
              qt[t * 72 + d] = f2bf(qc[i] * __expf(bct - ref)); kt[t * 72 + d] = f2bf(kf[i] * __expf(ref - bct));
              qh8[i] = qc[i] * __expf(bct); kh8[i] = kf[i] * __expf(all - bct); }
#pragma unroll
          for (int i = 0; i < 8; ++i) sq[(seg * 8 + i) * 72 + d] = f2bf(qh8[i]);
          *(u32x4*)(hi + 4096 + d * 64 + seg * 8) = pack8(kh8);
          *(u32x4*)(hi + 8192 + d * 64 + seg * 8) = pack8(vv);
          if (seg == 0) eh[(size_t)item * 64 + d] = __expf(all); }
        __syncthreads();
        { const int t_ = tid >> 3, d8 = (tid & 7) * 8; *(u32x4*)(hi + t_ * 64 + d8) = *(const LAS u32x4*)(sq + t_ * 72 + d8); }
        { const int ti = wid >> 1;
#pragma unroll
          for (int tjj = 0; tjj < 2; ++tjj) { const int tj = (wid & 1) * 2 + tjj; f32x4 a = (f32x4){0.f, 0.f, 0.f, 0.f};
              if (tj <= ti) {
#pragma unroll
                  for (int kk = 0; kk < 2; ++kk) a = mfma16(*(const LAS bf16x8*)(qt + (ti * 16 + fr) * 72 + kk * 32 + fq * 8), *(const LAS bf16x8*)(kt + (tj * 16 + fr) * 72 + kk * 32 + fq * 8), a); }
#pragma unroll
              for (int jj = 0; jj < 4; ++jj) { const int i = ti * 16 + fq * 4 + jj, j = tj * 16 + fr; sf[i * 72 + j] = f2bf(j <= i ? a[jj] : 0.f); } } }
        __syncthreads();
        { const int t_ = tid >> 3, d8 = (tid & 7) * 8; *(u32x4*)(hi + 12288 + t_ * 64 + d8) = *(const LAS u32x4*)(sf + t_ * 72 + d8); }
    }
    __syncthreads();
}

__device__ __forceinline__ void rg_prep(const Params& p, int l, LAS unsigned char* lds) {
    unsigned char* ws = p.ws;
    const bf16_t* bx = (const bf16_t*)(ws + R_BX); bf16_t* hloc = (bf16_t*)(ws + R_HLOC); bf16_t* pcum = (bf16_t*)(ws + R_PCUM); float* sumA = (float*)(ws + W_SUMA); float* sumH = (float*)(ws + W_SUMH);
    LAS bf16_t* xs = (LAS bf16_t*)lds;
    LAS bf16_t* wT = (LAS bf16_t*)(lds + 64 * 264 * 2);

    int tid = threadIdx.x; asm volatile("" : "+v"(tid)); const int lane = tid & 63, wid = tid >> 6, fr = lane & 15, fq = lane >> 4;
    const float* cw = p.in[17] + (size_t)l * 4 * 256; const float* cb = p.in[18] + l * 256;
    for (int idx = tid; idx < 32768; idx += 512) { const int g = idx >> 14, nb = (idx >> 12) & 3, i = (idx >> 6) & 63, j = idx & 63; const float v = (g ? p.in[21] : p.in[19])[(size_t)l * 16384 + nb * 4096 + i * 64 + j];
        wT[((g * 4 + nb) * 64 + j) * 72 + i] = f2bf(v); }
    for (int chunk_ = (blockIdx.x + 128) % gridDim.x; chunk_ < NCHUNK; chunk_ += gridDim.x) {
        const int chunk = chunk_; const bool samp = chunk >= 512; const int b = samp ? chunk - 512 : chunk >> 6, n = samp ? 0 : (chunk & 63);
        __syncthreads();
        { const int row = tid >> 3, cgp = tid & 7;
#pragma unroll
          for (int q8 = 0; q8 < 4; ++q8) { const int c = cgp * 32 + q8 * 8; float a8[8];
              { const f32x4 b0 = *(const f32x4*)(cb + c), b1 = *(const f32x4*)(cb + c + 4); a8[0] = b0[0]; a8[1] = b0[1]; a8[2] = b0[2]; a8[3] = b0[3]; a8[4] = b1[0]; a8[5] = b1[1]; a8[6] = b1[2]; a8[7] = b1[3]; }
#pragma unroll
              for (int j = 0; j < 4; ++j) { const int rr = row - 3 + j; float x8[8] = {0.f, 0.f, 0.f, 0.f, 0.f, 0.f, 0.f, 0.f};
                  if (rr >= 0 || n > 0) unpack8(*(const u32x4*)(bx + ((size_t)chunk * 64 + rr) * 256 + c), x8);
                  else if (samp) { const float* st = p.in[6] + ((size_t)(l * 8 + b) * 3 + (3 + rr)) * 256 + c; const f32x4 s0 = *(const f32x4*)st, s1 = *(const f32x4*)(st + 4); x8[0] = s0[0]; x8[1] = s0[1]; x8[2] = s0[2]; x8[3] = s0[3]; x8[4] = s1[0]; x8[5] = s1[1]; x8[6] = s1[2]; x8[7] = s1[3]; }
                  const f32x4 w0 = *(const f32x4*)(cw + j * 256 + c), w1 = *(const f32x4*)(cw + j * 256 + c + 4);
                  a8[0] += w0[0] * x8[0]; a8[1] += w0[1] * x8[1]; a8[2] += w0[2] * x8[2]; a8[3] += w0[3] * x8[3]; a8[4] += w1[0] * x8[4]; a8[5] += w1[1] * x8[5]; a8[6] += w1[2] * x8[6]; a8[7] += w1[3] * x8[7]; }
              *(LAS u32x4*)(xs + row * 264 + c) = pack8(a8); } }
        if (samp || n == 63) { float* o = p.out + (samp ? OUT_SBC : OUT_PBC) + (size_t)(l * 8 + b) * 3 * 256;
            for (int i = tid; i < 768; i += 512) { const int j = i >> 8, c = i & 255; o[j * 256 + c] = bf2f(bx[((size_t)chunk * 64 + 61 + j) * 256 + c]); } }
        __syncthreads();
#pragma unroll 1
        for (int pp = 0; pp < 2; ++pp) { const int pair = wid * 2 + pp, nb = pair >> 2, tj = pair & 3, ch = nb * 64 + tj * 16 + fr;
            LAS bf16_t* hbL = (LAS bf16_t*)(lds + 107520) + wid * 2048; LAS bf16_t* pbL = hbL + 1024;
            const float br = p.in[20][l * 256 + ch], bi = p.in[22][l * 256 + ch], sp = softplusf_(-p.in[23][l * 256 + ch]);
            float Ac = 1.0f, Hc = 0.0f;
#pragma unroll 1
            for (int ti = 0; ti < 4; ++ti) { f32x4 ar = (f32x4){0.f, 0.f, 0.f, 0.f}, aig = ar;
#pragma unroll
                for (int kk = 0; kk < 2; ++kk) { const bf16x8 a = *(const LAS bf16x8*)(xs + (ti * 16 + fr) * 264 + nb * 64 + kk * 32 + fq * 8);
                    ar = mfma16(a, *(const LAS bf16x8*)(wT + ((0 * 4 + nb) * 64 + tj * 16 + fr) * 72 + kk * 32 + fq * 8), ar);
                    aig = mfma16(a, *(const LAS bf16x8*)(wT + ((1 * 4 + nb) * 64 + tj * 16 + fr) * 72 + kk * 32 + fq * 8), aig); }
                float Aj[4], Hj[4]; float Ar = 1.0f, Hr = 0.0f;
#pragma unroll
                for (int jj = 0; jj < 4; ++jj) { const int tok = ti * 16 + fq * 4 + jj; const float r = sigmoidf_(ar[jj] + br), ig = sigmoidf_(aig[jj] + bi); const float la = -8.0f * r * sp; const float a = __expf(la);
                    const float mult = sqrtf(fmaxf(1.0f - __expf(2.0f * la), 0.0f)); const float uu = mult * ig * bf2f(xs[tok * 264 + ch]);
                    Hr = a * Hr + uu; Ar = a * Ar; Aj[jj] = Ar; Hj[jj] = Hr; }
                float Ap = Ac, Hp = Hc;
#pragma unroll
                for (int qd = 0; qd < 4; ++qd) { const float Aq = __shfl(Ar, qd * 16 + fr), Hq = __shfl(Hr, qd * 16 + fr);
                    if (qd < fq) { Hp = Aq * Hp + Hq; Ap = Aq * Ap; }
                    Hc = Aq * Hc + Hq; Ac = Aq * Ac; }
#pragma unroll
                for (int jj = 0; jj < 4; ++jj) { const int tl = ti * 16 + fq * 4 + jj; hbL[tl * 16 + fr] = f2bf(Hj[jj] + Aj[jj] * Hp); pbL[tl * 16 + fr] = f2bf(Aj[jj] * Ap); } }
#pragma unroll
            for (int r2 = 0; r2 < 2; ++r2) { const int idx = lane + r2 * 64, tok = idx >> 1, hf = idx & 1; const size_t o = ((size_t)chunk * 64 + tok) * 256 + nb * 64 + tj * 16 + hf * 8;
                *(u32x4*)(hloc + o) = *(const LAS u32x4*)(hbL + tok * 16 + hf * 8); *(u32x4*)(pcum + o) = *(const LAS u32x4*)(pbL + tok * 16 + hf * 8); }
            if (fq == 0) { sumA[(size_t)chunk * 256 + ch] = Ac; sumH[(size_t)chunk * 256 + ch] = Hc; } }
    }
    __syncthreads();
}

__device__ __forceinline__ void rg_apply_chunk(const Params& p, int l, int chunk) {
    unsigned char* ws = p.ws; bf16_t* zbuf = (bf16_t*)(ws + R_ZBUF);
    const bf16_t* hloc = (const bf16_t*)(ws + R_HLOC); const bf16_t* pcum = (const bf16_t*)(ws + R_PCUM); const float* sumA = (const float*)(ws + W_SUMA); const float* sumH = (const float*)(ws + W_SUMH);
    int tid = threadIdx.x; asm volatile("" : "+v"(tid));
    const bool samp = chunk >= 512; const int b = samp ? chunk - 512 : chunk >> 6, n = samp ? 0 : (chunk & 63);
    { const int ch = tid & 255, half = tid >> 8;
            float hin = samp ? p.in[7][(size_t)(l * 8 + b) * 256 + ch] : 0.f;
            for (int m = 0; m < n; ++m) { const size_t o = (size_t)(chunk - n + m) * 256 + ch; hin = sumA[o] * hin + sumH[o]; }
#pragma unroll 1
            for (int t0 = half * 32; t0 < half * 32 + 32; t0 += 8) { float hl[8], pc8[8], zg[8];
#pragma unroll
                for (int i = 0; i < 8; ++i) { const size_t row = (size_t)chunk * 64 + t0 + i; hl[i] = bf2f(hloc[row * 256 + ch]); pc8[i] = bf2f(pcum[row * 256 + ch]); zg[i] = bf2f(zbuf[row * 1024 + 512 + ch]); }
#pragma unroll
                for (int i = 0; i < 8; ++i) { const size_t row = (size_t)chunk * 64 + t0 + i; const float hv = hl[i] + pc8[i] * hin; zbuf[row * 1024 + 512 + ch] = f2bf(hv * gelu_tanh(zg[i]));
                    if (t0 + i == 63 && (samp || n == 63)) p.out[(samp ? OUT_SBH : OUT_PBH) + (size_t)(l * 8 + b) * 256 + ch] = hv; } }
    }
}

constexpr size_t OBUF_H_OFF = 2080ull * 8192;
static_assert((OBUF_H_OFF + 2080ull * 4096) * 2 <= (size_t)T_ALL * 1024 * 4, "o buffers must fit in the y region");
__device__ __forceinline__ void gdn_scan(const Params& p, int l, int seq, int h, int slice, LAS unsigned char* lds) {
    unsigned char* ws = p.ws; const bf16_t* gbuf = (const bf16_t*)(ws + R_GBUF); const float* glb = (const float*)(ws + W_GL); bf16_t* obuf = (bf16_t*)(p.out + OUT_Y);
    LAS bf16_t* StL = (LAS bf16_t*)lds;
    LAS bf16_t* VtL = StL + 32 * 136;
    int tid = threadIdx.x; asm volatile("" : "+v"(tid)); const int lane = tid & 63, w = tid >> 6, fr = lane & 15, fq = lane >> 4, mt = w & 3;
    const bool samp = seq >= 8; const int b = seq & 7; const int nsteps = samp ? 1 : 64, chunk0 = samp ? 512 + b : b * 64;
    f32x4 S[2];
#pragma unroll
    for (int nt = 0; nt < 2; ++nt) { S[nt] = (f32x4){0.f, 0.f, 0.f, 0.f};
        if (samp) { const float* s0 = p.in[5] + ((size_t)((l * 8 + b) * 4 + h)) * 16384;
#pragma unroll
            for (int jj = 0; jj < 4; ++jj) S[nt][jj] = s0[(w * 16 + fq * 4 + jj) * 128 + slice * 32 + nt * 16 + fr]; } }
#define GDN_LOAD(A_, KD_, QK_, UU_, GL_, item_) do { const bf16_t* gi_ = gbuf + (size_t)(item_) * GITEM; const bf16_t* Ab_ = gi_ + (w < 4 ? 24576 : 0) + (mt * 16 + fr) * 128 + fq * 8; \
        _Pragma("unroll") for (int kk = 0; kk < 4; ++kk) A_[kk] = *(const bf16x8*)(Ab_ + kk * 32); \
        _Pragma("unroll") for (int kk = 0; kk < 2; ++kk) KD_[kk] = *(const bf16x8*)(gi_ + 8192 + (w * 16 + fr) * 64 + kk * 32 + fq * 8); \
        if (w >= 4) { _Pragma("unroll") for (int kk = 0; kk < 2; ++kk) QK_[kk] = *(const bf16x8*)(gi_ + 32768 + (mt * 16 + fr) * 64 + kk * 32 + fq * 8); } \
        else { _Pragma("unroll") for (int nt = 0; nt < 2; ++nt) UU_[nt] = *(const u32x2*)(gi_ + 16384 + (slice * 32 + nt * 16 + fr) * 64 + mt * 16 + fq * 4); } \
        GL_ = glb[item_]; } while (0)
    bf16x8 ca[4], ckd[2], cqk[2] = {}; u32x2 cuu[2] = {}; float cgl;
    bf16x8 ma[4], mkd[2], mqk[2] = {}; u32x2 muu[2] = {}; float mgl;
    GDN_LOAD(ca, ckd, cqk, cuu, cgl, chunk0 * 4 + h);
    { const int it1 = (nsteps > 1) ? (chunk0 + 1) * 4 + h : chunk0 * 4 + h; GDN_LOAD(ma, mkd, mqk, muu, mgl, it1); }
    for (int step = 0; step < nsteps; ++step) {
        const int item = (chunk0 + step) * 4 + h;
        bf16x8 na[4], nkd[2], nqk[2] = {}; u32x2 nuu[2] = {}; float ngl;
        { const int nit = (step + 2 < nsteps) ? item + 8 : item; GDN_LOAD(na, nkd, nqk, nuu, ngl, nit); }
#pragma unroll
        for (int nt = 0; nt < 2; ++nt) { u32x2 wv; wv.x = cvt_pk_bf16(S[nt][0], S[nt][1]); wv.y = cvt_pk_bf16(S[nt][2], S[nt][3]); *(LAS u32x2*)(StL + (nt * 16 + fr) * 136 + w * 16 + fq * 4) = wv; }
        __syncthreads();
        f32x4 acc[2] = {(f32x4){0.f, 0.f, 0.f, 0.f}, (f32x4){0.f, 0.f, 0.f, 0.f}};
#pragma unroll
        for (int kk = 0; kk < 4; ++kk)
#pragma unroll
            for (int nt = 0; nt < 2; ++nt) acc[nt] = mfma16(ca[kk], *(const LAS bf16x8*)(StL + (nt * 16 + fr) * 136 + kk * 32 + fq * 8), acc[nt]);
        if (w < 4) {
#pragma unroll
            for (int nt = 0; nt < 2; ++nt) { const u32x2 uw = cuu[nt];
                u32x2 vw; vw.x = cvt_pk_bf16(lo_bf(uw.x) - acc[nt][0], hi_bf(uw.x) - acc[nt][1]); vw.y = cvt_pk_bf16(lo_bf(uw.y) - acc[nt][2], hi_bf(uw.y) - acc[nt][3]);
                *(LAS u32x2*)(VtL + (nt * 16 + fr) * 72 + mt * 16 + fq * 4) = vw; } }
        __syncthreads();
        bf16x8 vB[2][2];
#pragma unroll
        for (int nt = 0; nt < 2; ++nt)
#pragma unroll
            for (int kk = 0; kk < 2; ++kk) vB[nt][kk] = *(const LAS bf16x8*)(VtL + (nt * 16 + fr) * 72 + kk * 32 + fq * 8);
        if (w >= 4) {
#pragma unroll
            for (int kk = 0; kk < 2; ++kk)
#pragma unroll
                for (int nt = 0; nt < 2; ++nt) acc[nt] = mfma16(cqk[kk], vB[nt][kk], acc[nt]);
#pragma unroll
            for (int nt = 0; nt < 2; ++nt) { u32x2 ow; ow.x = cvt_pk_bf16(acc[nt][0], acc[nt][1]); ow.y = cvt_pk_bf16(acc[nt][2], acc[nt][3]);
                *(u32x2*)(obuf + (size_t)item * 8192 + (slice * 32 + nt * 16 + fr) * 64 + mt * 16 + fq * 4) = ow; } }
#pragma unroll
        for (int nt = 0; nt < 2; ++nt) S[nt] *= cgl;
#pragma unroll
        for (int kk = 0; kk < 2; ++kk)
#pragma unroll
            for (int nt = 0; nt < 2; ++nt) S[nt] = mfma16(ckd[kk], vB[nt][kk], S[nt]);
#pragma unroll
        for (int kk = 0; kk < 4; ++kk) { ca[kk] = ma[kk]; ma[kk] = na[kk]; }
#pragma unroll
        for (int kk = 0; kk < 2; ++kk) { ckd[kk] = mkd[kk]; cqk[kk] = mqk[kk]; cuu[kk] = muu[kk]; mkd[kk] = nkd[kk]; mqk[kk] = nqk[kk]; muu[kk] = nuu[kk]; }
        cgl = mgl; mgl = ngl;
    }
    float* so = p.out + (samp ? OUT_SAS : OUT_PAS) + ((size_t)((l * 8 + b) * 4 + h)) * 16384;
#pragma unroll
    for (int nt = 0; nt < 2; ++nt)
#pragma unroll
        for (int jj = 0; jj < 4; ++jj) so[(w * 16 + fq * 4 + jj) * 128 + slice * 32 + nt * 16 + fr] = S[nt][jj];
    __syncthreads();
}
__device__ __forceinline__ void hgrn_scan(const Params& p, int l, int seq, int h, int slice, LAS unsigned char* lds) {
    unsigned char* ws = p.ws; const bf16_t* hbuf = (const bf16_t*)(ws + R_HBUF); const float* eh = (const float*)(ws + W_EH); bf16_t* obuf = (bf16_t*)(p.out + OUT_Y) + OBUF_H_OFF;
    int tid = threadIdx.x; asm volatile("" : "+v"(tid)); const int lane = tid & 63, w = tid >> 6, fr = lane & 15, fq = lane >> 4, wd = w & 3;
    const bool samp = seq >= 8; const int b = seq & 7; const int nsteps = samp ? 1 : 64, chunk0 = samp ? 512 + b : b * 64;
    f32x4 S = (f32x4){0.f, 0.f, 0.f, 0.f};
    if (samp) { const float* s0 = p.in[8] + ((size_t)((l * 8 + b) * 4 + h)) * 4096;
#pragma unroll
        for (int jj = 0; jj < 4; ++jj) S[jj] = s0[(wd * 16 + fq * 4 + jj) * 64 + slice * 16 + fr]; }
#define HG_LOAD(QA_, AT_, KH_, VB_, EV_, item_) do { const bf16_t* hi_ = hbuf + (size_t)(item_) * HITEM; \
        _Pragma("unroll") for (int kk = 0; kk < 2; ++kk) VB_[kk] = *(const bf16x8*)(hi_ + 8192 + (slice * 16 + fr) * 64 + kk * 32 + fq * 8); \
        if (w >= 4) { _Pragma("unroll") for (int kk = 0; kk < 2; ++kk) { QA_[kk] = *(const bf16x8*)(hi_ + (wd * 16 + fr) * 64 + kk * 32 + fq * 8); AT_[kk] = *(const bf16x8*)(hi_ + 12288 + (wd * 16 + fr) * 64 + kk * 32 + fq * 8); } } \
        else { _Pragma("unroll") for (int kk = 0; kk < 2; ++kk) KH_[kk] = *(const bf16x8*)(hi_ + 4096 + (wd * 16 + fr) * 64 + kk * 32 + fq * 8); \
            EV_ = *(const f32x4*)(eh + (size_t)(item_) * 64 + wd * 16 + fq * 4); } } while (0)
    bf16x8 cqa[2] = {}, cat[2] = {}, ckh[2] = {}, cvb[2]; f32x4 cev = (f32x4){0.f, 0.f, 0.f, 0.f};
    bf16x8 mqa[2] = {}, mat[2] = {}, mkh[2] = {}, mvb[2]; f32x4 mev = (f32x4){0.f, 0.f, 0.f, 0.f};
    HG_LOAD(cqa, cat, ckh, cvb, cev, chunk0 * 4 + h);
    { const int it1 = (nsteps > 1) ? (chunk0 + 1) * 4 + h : chunk0 * 4 + h; HG_LOAD(mqa, mat, mkh, mvb, mev, it1); }
    for (int step = 0; step < nsteps; ++step) {
        const int item = (chunk0 + step) * 4 + h;
        bf16x8 nqa[2] = {}, nat[2] = {}, nkh[2] = {}, nvb[2]; f32x4 nev = (f32x4){0.f, 0.f, 0.f, 0.f};
        { const int nit = (step + 2 < nsteps) ? item + 8 : item; HG_LOAD(nqa, nat, nkh, nvb, nev, nit); }
        LAS bf16_t* StL = (LAS bf16_t*)lds + (step & 1) * (16 * 72);
        if (w < 4) { u32x2 wv; wv.x = cvt_pk_bf16(S[0], S[1]); wv.y = cvt_pk_bf16(S[2], S[3]); *(LAS u32x2*)(StL + fr * 72 + w * 16 + fq * 4) = wv; }
        __syncthreads();
        if (w >= 4) { f32x4 o = (f32x4){0.f, 0.f, 0.f, 0.f};
#pragma unroll
            for (int kk = 0; kk < 2; ++kk) o = mfma16(cqa[kk], *(const LAS bf16x8*)(StL + fr * 72 + kk * 32 + fq * 8), o);
#pragma unroll
            for (int kk = 0; kk < 2; ++kk) o = mfma16(cat[kk], cvb[kk], o);
            u32x2 ow; ow.x = cvt_pk_bf16(o[0], o[1]); ow.y = cvt_pk_bf16(o[2], o[3]); *(u32x2*)(obuf + (size_t)item * 4096 + (slice * 16 + fr) * 64 + wd * 16 + fq * 4) = ow;
        } else { S = S * cev;
#pragma unroll
            for (int kk = 0; kk < 2; ++kk) S = mfma16(ckh[kk], cvb[kk], S); }
#pragma unroll
        for (int kk = 0; kk < 2; ++kk) { cqa[kk] = mqa[kk]; cat[kk] = mat[kk]; ckh[kk] = mkh[kk]; cvb[kk] = mvb[kk]; mqa[kk] = nqa[kk]; mat[kk] = nat[kk]; mkh[kk] = nkh[kk]; mvb[kk] = nvb[kk]; }
        cev = mev; mev = nev;
    }
    if (w < 4) { float* so = p.out + (samp ? OUT_SCS : OUT_PCS) + ((size_t)((l * 8 + b) * 4 + h)) * 4096;
#pragma unroll
        for (int jj = 0; jj < 4; ++jj) so[(w * 16 + fq * 4 + jj) * 64 + slice * 16 + fr] = S[jj]; }
    __syncthreads();
}
__device__ __forceinline__ void scan_phase(const Params& p, int l, LAS unsigned char* lds) {
    for (int x = blockIdx.x; x < 256; x += gridDim.x) {
        const int y = x & 127, xcd = y & 7, r = y >> 3, chain = xcd * 4 + (r >> 2), slice = r & 3, b = chain >> 2, h = chain & 3;
        if (x < 128) {
#pragma unroll 1
            for (int sq = 0; sq < 2; ++sq) gdn_scan(p, l, sq * 8 + b, h, slice, lds); }
        else {
#pragma unroll 1
            for (int sq = 0; sq < 2; ++sq) hgrn_scan(p, l, sq * 8 + b, h, slice, lds);
#pragma unroll 1
            for (int chunk = x - 128; chunk < NCHUNK; chunk += 128) rg_apply_chunk(p, l, chunk); }
    }
}

__device__ __forceinline__ void apply_phase(const Params& p, int l, LAS unsigned char* lds) {
    unsigned char* ws = p.ws;
    const bf16_t* gbuf = (const bf16_t*)(ws + R_GBUF); const bf16_t* hbuf = (const bf16_t*)(ws + R_HBUF); bf16_t* zbuf = (bf16_t*)(ws + R_ZBUF);
    const bf16_t* hloc = (const bf16_t*)(ws + R_HLOC); const bf16_t* pcum = (const bf16_t*)(ws + R_PCUM); const float* sumA = (const float*)(ws + W_SUMA); const float* sumH = (const float*)(ws + W_SUMH);
    LAS bf16_t* ot = (LAS bf16_t*)lds;
    int tid = threadIdx.x; asm volatile("" : "+v"(tid));
    for (int it = blockIdx.x; it < NCHUNK * 8; it += gridDim.x) {
        const int chunk = it >> 3, sub = it & 7; const bool samp = chunk >= 512; const int b = samp ? chunk - 512 : chunk >> 6, n = samp ? 0 : (chunk & 63);
        if (sub < 4) { const int h = sub; const bf16_t* oT = (const bf16_t*)(p.out + OUT_Y) + (size_t)(chunk * 4 + h) * 8192;
            __syncthreads();
#pragma unroll
            for (int i = 0; i < 2; ++i) { const int pc = tid + i * 512, dv = pc >> 3, t8 = (pc & 7) * 8; *(LAS u32x4*)(ot + dv * 72 + t8) = *(const u32x4*)(oT + dv * 64 + t8); }
            __syncthreads();
            const int tok = tid >> 3, cgp = tid & 7; float v[16]; float ss = 0.f;
#pragma unroll
            for (int i = 0; i < 16; ++i) { v[i] = bf2f(ot[(cgp * 16 + i) * 72 + tok]); ss += v[i] * v[i]; }
            ss += __shfl_xor(ss, 1); ss += __shfl_xor(ss, 2); ss += __shfl_xor(ss, 4);
            const float rn = rsqrtf(ss * (1.0f / 128.0f) + EPS);
            bf16_t* zp = zbuf + ((size_t)chunk * 64 + tok) * 1024 + h * 128 + cgp * 16; const float* an = p.in[16] + l * 128 + cgp * 16;
            float z[16]; unpack8(*(const u32x4*)zp, z); unpack8(*(const u32x4*)(zp + 8), z + 8);
#pragma unroll
            for (int i = 0; i < 16; ++i) v[i] = v[i] * rn * an[i] * siluf_(z[i]);
            *(u32x4*)zp = pack8(v); *(u32x4*)(zp + 8) = pack8(v + 8);
        } else if (sub < 8) { const int h = sub - 4; const bf16_t* oT = (const bf16_t*)(p.out + OUT_Y) + OBUF_H_OFF + (size_t)(chunk * 4 + h) * 4096;
            __syncthreads();
            { const int dv = tid >> 3, t8 = (tid & 7) * 8; *(LAS u32x4*)(ot + dv * 72 + t8) = *(const u32x4*)(oT + dv * 64 + t8); }
            __syncthreads();
            const int tok = tid >> 3, cgp = tid & 7; float v[8]; float ss = 0.f;
#pragma unroll
            for (int i = 0; i < 8; ++i) { v[i] = bf2f(ot[(cgp * 8 + i) * 72 + tok]); ss += v[i] * v[i]; }
            ss += __shfl_xor(ss, 1); ss += __shfl_xor(ss, 2); ss += __shfl_xor(ss, 4);
            const float rn = rsqrtf(ss * (1.0f / 64.0f) + EPS);
            bf16_t* zp = zbuf + ((size_t)chunk * 64 + tok) * 1024 + 768 + h * 64 + cgp * 8; const float* cn = p.in[25] + l * 64 + cgp * 8;
            float z[8]; unpack8(*(const u32x4*)zp, z);
#pragma unroll
            for (int i = 0; i < 8; ++i) v[i] = v[i] * rn * cn[i] * siluf_(z[i]);
            *(u32x4*)zp = pack8(v);
        }
    }
    __syncthreads();
}

__device__ __forceinline__ void attn_phase(const Params& p, int l, LAS unsigned char* lds) {
    unsigned char* ws = p.ws;
    const bf16_t* qbuf = (const bf16_t*)(ws + R_QBUF); bf16_t* oatt = (bf16_t*)(ws + R_OATT);
    int tid = threadIdx.x; asm volatile("" : "+v"(tid)); const int lane = tid & 63, w = tid >> 6, fr = lane & 15, fq = lane >> 4;
    for (int item = blockIdx.x; item < 1056; item += gridDim.x) {
        int row0, seq, h, nw;
        if (item < 1024) { const int tile = item >> 2; h = item & 3; row0 = tile * 128; seq = row0 >> 12; nw = 8; }
        else { const int i2 = item - 1024; seq = 8 + (i2 >> 2); h = i2 & 3; row0 = T_P + (i2 >> 2) * 64; nw = 4; }
        const bf16_t* Kp = (const bf16_t*)(ws + W_KB) + (size_t)(l * 16 + seq) * 256 * 1024 + h * 256;
        const bf16_t* Vp = (const bf16_t*)(ws + W_VT) + (size_t)((l * 16 + seq) * 4 + h) * 65536;
        const bool active = w < nw;
        const int qrow = row0 + (active ? w : 0) * 16 + fr;
        bf16x8 qB[8];
#pragma unroll
        for (int kk = 0; kk < 8; ++kk) qB[kk] = *(const bf16x8*)(qbuf + (size_t)qrow * 1024 + h * 256 + kk * 32 + fq * 8);
        f32x4 sacc[16];
#pragma unroll
        for (int i = 0; i < 16; ++i) sacc[i] = (f32x4){0.f, 0.f, 0.f, 0.f};
        bf16x8 pk[8]; float inv = 0.f;
        u32x4 stA[4], stB[4];
#pragma unroll
        for (int i = 0; i < 4; ++i) { const int idx = tid + i * 512, r = idx >> 5, c8 = (idx & 31) * 8; stA[i] = *(const u32x4*)(Kp + (size_t)r * 1024 + c8); stB[i] = *(const u32x4*)(Kp + (size_t)(64 + r) * 1024 + c8); }
        __syncthreads();
        auto round = [&](auto R8c) __attribute__((always_inline)) {
            constexpr int r8 = decltype(R8c)::value;
            LAS bf16_t* buf = (LAS bf16_t*)(lds + (r8 & 1) * 33792);
#pragma unroll
            for (int i = 0; i < 4; ++i) { const int idx = tid + i * 512, r = idx >> 5, c8 = (idx & 31) * 8; *(LAS u32x4*)(buf + r * 264 + c8) = (r8 & 1) ? stB[i] : stA[i]; }
            __syncthreads();
            if constexpr (r8 < 6) { constexpr int nr = r8 + 2;
#pragma unroll
                for (int i = 0; i < 4; ++i) { const int idx = tid + i * 512, r = idx >> 5, c8 = (idx & 31) * 8;
                    const u32x4 v = nr < 4 ? *(const u32x4*)(Kp + (size_t)(nr * 64 + r) * 1024 + c8) : *(const u32x4*)(Vp + (size_t)((nr - 4) * 64 + r) * 256 + c8);
                    if (r8 & 1) stB[i] = v; else stA[i] = v; } }
            if (active) {
                if constexpr (r8 < 4) {
#pragma unroll
                    for (int mt = 0; mt < 4; ++mt)
#pragma unroll
                        for (int kk = 0; kk < 8; ++kk) sacc[r8 * 4 + mt] = mfma16(*(const LAS bf16x8*)(buf + (mt * 16 + fr) * 264 + kk * 32 + fq * 8), qB[kk], sacc[r8 * 4 + mt]);
                    if constexpr (r8 == 3) { float mx = -3.0e38f;
#pragma unroll
                        for (int i = 0; i < 16; ++i) mx = fmaxf(mx, fmaxf(fmaxf(sacc[i][0], sacc[i][1]), fmaxf(sacc[i][2], sacc[i][3])));
                        mx = fmaxf(mx, __shfl_xor(mx, 16)); mx = fmaxf(mx, __shfl_xor(mx, 32));
                        float sm = 0.f;
#pragma unroll
                        for (int i = 0; i < 16; ++i) {
#pragma unroll
                            for (int jj = 0; jj < 4; ++jj) { const float e = __expf(sacc[i][jj] - mx); sacc[i][jj] = e; sm += e; } }
                        sm += __shfl_xor(sm, 16); sm += __shfl_xor(sm, 32); inv = 1.0f / sm;
#pragma unroll
                        for (int s = 0; s < 8; ++s) { u32x4 wv; wv.x = cvt_pk_bf16(sacc[2 * s][0], sacc[2 * s][1]); wv.y = cvt_pk_bf16(sacc[2 * s][2], sacc[2 * s][3]); wv.z = cvt_pk_bf16(sacc[2 * s + 1][0], sacc[2 * s + 1][1]); wv.w = cvt_pk_bf16(sacc[2 * s + 1][2], sacc[2 * s + 1][3]);
                            pk[s] = __builtin_bit_cast(bf16x8, wv); } }
                } else { constexpr int dt = r8 - 4;
#pragma unroll
                    for (int mt = 0; mt < 4; ++mt) { f32x4 o = (f32x4){0.f, 0.f, 0.f, 0.f};
#pragma unroll
                        for (int s = 0; s < 8; ++s) { const u32x2 lo = *(const LAS u32x2*)(buf + (mt * 16 + fr) * 264 + 32 * s + 4 * fq), hi2 = *(const LAS u32x2*)(buf + (mt * 16 + fr) * 264 + 32 * s + 16 + 4 * fq);
                            u32x4 av; av.x = lo.x; av.y = lo.y; av.z = hi2.x; av.w = hi2.y; o = mfma16(__builtin_bit_cast(bf16x8, av), pk[s], o); }
                        u32x2 ow; ow.x = cvt_pk_bf16(o[0] * inv, o[1] * inv); ow.y = cvt_pk_bf16(o[2] * inv, o[3] * inv);
                        *(u32x2*)(oatt + (size_t)qrow * 1024 + h * 256 + dt * 64 + mt * 16 + fq * 4) = ow; } }
            }
        };
        round(std::integral_constant<int, 0>{}); round(std::integral_constant<int, 1>{}); round(std::integral_constant<int, 2>{}); round(std::integral_constant<int, 3>{});
        round(std::integral_constant<int, 4>{}); round(std::integral_constant<int, 5>{}); round(std::integral_constant<int, 6>{}); round(std::integral_constant<int, 7>{});
    }
    __syncthreads();
}

__device__ __forceinline__ void final_norm(const Params& p) {
    const float* ssq = (const float*)(p.ws + W_SSQ) + 6ull * T_ALL; const float* g = p.in[38]; float* y = p.out + OUT_Y;
    int tidl = threadIdx.x; asm volatile("" : "+v"(tidl)); const int lane = tidl & 63, gw = blockIdx.x * 8 + (tidl >> 6), nw = gridDim.x * 8;
    for (int r = gw; r < T_ALL; r += nw) { const float rs = rsqrtf(ssqv(ssq, r) * (1.0f / 1024.0f) + EPS);
#pragma unroll
        for (int i = 0; i < 4; ++i) { const int c = i * 256 + lane * 4; f32x4 x = *(const f32x4*)(y + (size_t)r * 1024 + c); const f32x4 gg = *(const f32x4*)(g + c); x = x * rs * gg; *(f32x4*)(y + (size_t)r * 1024 + c) = x; } }
}

#define XB_TMO      128
#define XB_XCNT(j)  (256  + 64 * (j))
#define XB_XSUB(j)  (1280 + 64 * (j))
#define XB_XGEN(j)  (2304 + 64 * (j))
#define XB_TOP      3328
#define XB_TOPGEN   3392
#define XB_SPIN_CAP (1u << 18)
constexpr int XB_LDS_OFF = LDS_BYTES - 16;
__device__ __forceinline__ unsigned xb_ld(unsigned* p)              { return __hip_atomic_load(p, __ATOMIC_RELAXED, __HIP_MEMORY_SCOPE_AGENT); }
__device__ __forceinline__ unsigned xb_add(unsigned* p, unsigned v) { return __hip_atomic_fetch_add(p, v, __ATOMIC_RELAXED, __HIP_MEMORY_SCOPE_AGENT); }
__device__ __forceinline__ unsigned xb_xcc_id() { return (unsigned)__builtin_amdgcn_s_getreg((3 << 11) | 20) & 0xFu; }
#define XB_SPIN(cond, bar) do { unsigned _sp = 0; while (cond) { __builtin_amdgcn_s_sleep(1); \
    if ((++_sp & 255u) == 0u) { if (xb_ld(&(bar)[XB_TMO])) break; if (_sp > XB_SPIN_CAP) { atomicAdd(&(bar)[XB_TMO], 1u); break; } } } } while (0)
__device__ __forceinline__ void xcd_barrier_post(unsigned* bar) { if (threadIdx.x == 0) (void)xb_add(&bar[XB_XCNT(xb_xcc_id())], 1u); }
__device__ __forceinline__ void xcd_barrier_complete(unsigned* bar, unsigned x, unsigned& nloc, unsigned& nx) {
    const unsigned G = gridDim.x * gridDim.y * gridDim.z;
    unsigned sum, cnt, mine, sp = 0u;
    for (;;) {
        sum = 0u; cnt = 0u; mine = 0u;
#pragma unroll
        for (unsigned j = 0; j < 16; ++j) { const unsigned c = xb_ld(&bar[XB_XCNT(j)]); sum += c; cnt += (c > 0u) ? 1u : 0u; mine = (j == x) ? c : mine; }
        if (sum == G) break;
        __builtin_amdgcn_s_sleep(1);
        if ((++sp & 255u) == 0u) { if (xb_ld(&bar[XB_TMO])) break; if (sp > XB_SPIN_CAP) { atomicAdd(&bar[XB_TMO], 1u); break; } }
    }
    nloc = mine > 0u ? mine : 1u; nx = cnt > 0u ? cnt : 1u;
}
__device__ __forceinline__ void xcd_barrier(unsigned char* ws, LAS unsigned char* lds) {
    asm volatile("s_waitcnt vmcnt(0)" ::: "memory");
    __syncthreads();
    if (threadIdx.x == 0) {
        unsigned* bar = (unsigned*)(ws + W_BAR); volatile LAS unsigned* st = (volatile LAS unsigned*)(lds + XB_LDS_OFF); const unsigned x = xb_xcc_id();
        __builtin_amdgcn_s_waitcnt(0);
        unsigned nloc = st[0], nx = st[1];
        if (nloc == 0u) { xcd_barrier_complete(bar, x, nloc, nx); st[0] = nloc; st[1] = nx; }
        const unsigned old = xb_add(&bar[XB_XSUB(x)], 1u);
        const unsigned gen = old / nloc;
        if (old + 1u == (gen + 1u) * nloc) {
            __builtin_amdgcn_fence(__ATOMIC_RELEASE, "agent");
            asm volatile("s_waitcnt vmcnt(0)" ::: "memory");
            const unsigned og = xb_add(&bar[XB_TOP], 1u);
            const unsigned tg = og / nx;
            if (og + 1u == (tg + 1u) * nx) xb_add(&bar[XB_TOPGEN], 1u);
            else XB_SPIN(xb_ld(&bar[XB_TOPGEN]) == tg, bar);
            __builtin_amdgcn_fence(__ATOMIC_ACQUIRE, "agent");
            xb_add(&bar[XB_XGEN(x)], 1u);
            asm volatile("s_waitcnt vmcnt(0)" ::: "memory");
        } else {
            XB_SPIN(xb_ld(&bar[XB_XGEN(x)]) == gen, bar);
            __builtin_amdgcn_fence(__ATOMIC_ACQUIRE, "agent");
            asm volatile("s_waitcnt vmcnt(0)" ::: "memory");
        }
    }
    __syncthreads();
}

__global__ void __launch_bounds__(512, 2) hybrid_fwd(Params p) {
    extern __shared__ __attribute__((aligned(16))) unsigned char smem[];
    LAS unsigned char* lds = (LAS unsigned char*)smem;
    cg::grid_group grid = cg::this_grid();
    unsigned char* ws = p.ws;
    float* ssq = (float*)(ws + W_SSQ);
    bf16_t* xb = (bf16_t*)(ws + W_XB) + XB_PRE * 1024;
    float* xf = p.out + OUT_Y;
    if (threadIdx.x == 0) { volatile LAS unsigned* st_ = (volatile LAS unsigned*)(lds + XB_LDS_OFF); st_[0] = 0u; st_[1] = 0u; }
    __syncthreads();
    xcd_barrier_post((unsigned*)(ws + W_BAR));

    if (TIMING && blockIdx.x == 0 && threadIdx.x == 0) { unsigned long long* tmr_ = (unsigned long long*)(p.ws + W_SSQ + (7ull * T_ALL + 4096) * 4); for (int i = 0; i < 31; ++i) tmr_[i] = 0ull; tmr_[31] = __builtin_amdgcn_s_memrealtime(); tmr_[30] = tmr_[31]; }
    phase0(p, lds);
    if (p.ws == nullptr) grid.sync();
    xcd_barrier(ws, lds); TMARK(0);
    { EpiKV E{p.out, ssq + 7ull * T_ALL}; pg8::gemm_phase<EpiKV, 0>(lds, (const bf16_t*)(ws + W_MEMB), (const bf16_t*)(ws + W_BKV), 1024, 8, 16, E); }
    xcd_barrier(ws, lds); TMARK(1);
#pragma unroll 1
    for (int l_ = 0; l_ < 2; ++l_) {
        int l = l_; asm volatile("" : "+s"(l));
        { EpiProj E{ws, ssq + (size_t)(3 * l) * T_ALL}; pg8::gemm_phase<EpiProj, 0>(lds, xb, (const bf16_t*)(ws + W_BIN) + (size_t)l * NINP * 1024, 1024, 130, 15, E); }
        if (l == 0) kv_prompt_convert(p, lds);
        xcd_barrier(ws, lds); TMARK(2);
        if (STOP_AFTER <= 1) return;
        gdn_prep(p, l, lds); TMARK(3); hgrn_prep(p, l, lds); TMARK(4); rg_prep(p, l, lds);
        xcd_barrier(ws, lds); TMARK(5);
        if (STOP_AFTER <= 2) return;
        scan_phase(p, l, lds);
        xcd_barrier(ws, lds); TMARK(6);
        if (STOP_AFTER <= 3) return;
        apply_phase(p, l, lds);
        xcd_barrier(ws, lds); TMARK(7);
        if (STOP_AFTER <= 4) return;
        { EpiRes E{nullptr, xb, ssq + (size_t)(3 * l + 1) * T_ALL}; pg8::gemm_phase<EpiRes, 0>(lds, (const bf16_t*)(ws + R_ZBUF), (const bf16_t*)(ws + W_BOUT) + (size_t)l * 1024 * 1024, 1024, 128, 4, E);
          small_gemm<0>((const bf16_t*)(ws + R_ZBUF), (const bf16_t*)(ws + W_BOUT) + (size_t)l * 1024 * 1024, 1024, xb, nullptr, ssq + (size_t)(3 * l + 1) * T_ALL, nullptr); }
        xcd_barrier(ws, lds); TMARK(8);
        { EpiQ E{(bf16_t*)(ws + R_QBUF), ssq + (size_t)(3 * l + 1) * T_ALL}; pg8::gemm_phase<EpiQ, 0>(lds, xb, (const bf16_t*)(ws + W_BQ) + (size_t)l * 1024 * 1024, 1024, 128, 4, E);
          small_gemm<1>(xb, (const bf16_t*)(ws + W_BQ) + (size_t)l * 1024 * 1024, 1024, (bf16_t*)(ws + R_QBUF), nullptr, nullptr, ssq + (size_t)(3 * l + 1) * T_ALL); }
        xcd_barrier(ws, lds); TMARK(9);
        if (STOP_AFTER <= 5) return;
        attn_phase(p, l, lds);
        xcd_barrier(ws, lds); TMARK(10);
        if (STOP_AFTER <= 6) return;
        { EpiRes E{nullptr, xb, ssq + (size_t)(3 * l + 2) * T_ALL}; pg8::gemm_phase<EpiRes, 0>(lds, (const bf16_t*)(ws + R_OATT), (const bf16_t*)(ws + W_BO) + (size_t)l * 1024 * 1024, 1024, 128, 4, E);
          small_gemm<0>((const bf16_t*)(ws + R_OATT), (const bf16_t*)(ws + W_BO) + (size_t)l * 1024 * 1024, 1024, xb, nullptr, ssq + (size_t)(3 * l + 2) * T_ALL, nullptr); }
        xcd_barrier(ws, lds); TMARK(11);
        { EpiUp E{(bf16_t*)(ws + R_ACT), ssq + (size_t)(3 * l + 2) * T_ALL, p.in[35] + (size_t)l * 3 * DFF2, p.in[36] + (size_t)l * DFF2, p.in[9] + (size_t)l * 8 * 2 * DFF2, p.out + OUT_PFC + (size_t)l * 8 * 2 * DFF2, p.out + OUT_SFC + (size_t)l * 8 * 2 * DFF2};
          if (STOP_AFTER <= 7) return;
          pg8::gemm_phase<EpiUp, 1>(lds, xb - 2 * 1024, (const bf16_t*)(ws + W_BUP) + (size_t)l * DFF2 * 1024, 1024, 133, 22, E); }
        xcd_barrier(ws, lds); TMARK(12);
        if (STOP_AFTER <= 8) return;
        { EpiRes E{l == 1 ? xf : nullptr, xb, ssq + (size_t)(3 * l + 3) * T_ALL}; pg8::gemm_phase<EpiRes, 0>(lds, (const bf16_t*)(ws + R_ACT), (const bf16_t*)(ws + W_BDN) + (size_t)l * 1024 * DFF, DFF, 128, 4, E);
          small_gemm<0>((const bf16_t*)(ws + R_ACT), (const bf16_t*)(ws + W_BDN) + (size_t)l * 1024 * DFF, DFF, xb, l == 1 ? xf : nullptr, ssq + (size_t)(3 * l + 3) * T_ALL, nullptr); }
        xcd_barrier(ws, lds); TMARK(13);
    }
    final_norm(p);
    if (TIMING) { xcd_barrier(ws, lds); TMARK(14);
        if (blockIdx.x == 0) { const unsigned long long* tmr_ = (const unsigned long long*)(p.ws + W_SSQ + (7ull * T_ALL + 4096) * 4);
#pragma unroll 1
            for (int k = 0; k < 16; ++k) { unsigned long long d = (k < 15) ? tmr_[(TIMING == 2 && k < 4) ? 20 + k : k] : (tmr_[31] - tmr_[30]); unsigned n = (unsigned)(d / 100ull); if (k == 15) n /= 2; if (n < 1) n = 1; if (n > 4000) n = 4000;
                const size_t off_ = k == 0 ? OUT_Y : k == 1 ? OUT_Y + (size_t)T_P * 1024 : k == 2 ? OUT_PMK : k == 3 ? OUT_PMV : k == 4 ? OUT_PAC : k == 5 ? OUT_PAS : k == 6 ? OUT_PBC : k == 7 ? OUT_PBH : k == 8 ? OUT_PCS : k == 9 ? OUT_PFC : k == 10 ? OUT_SAC : k == 11 ? OUT_SAS : k == 12 ? OUT_SBC : k == 13 ? OUT_SBH : k == 14 ? OUT_SCS : OUT_SFC; unsigned* o = (unsigned*)(p.out + off_); for (unsigned i = threadIdx.x; i < 4096; i += 512) o[i] = (i < n) ? 0xAAAAAAAAu : 0u; } } }
}

extern "C" void kernel_launch(void* const* d_in, const int* in_sizes, int n_in, void* d_out, int out_size, void* d_ws, size_t ws_size, hipStream_t stream) {
    static int grid = 0;
    if (grid == 0) {
        if (n_in != 39 || (size_t)out_size != OUT_TOTAL || ws_size < WS_NEED) { fprintf(stderr, "kernel_launch: unexpected shapes (n_in %d out %d ws %zu need %zu)\n", n_in, out_size, ws_size, (size_t)WS_NEED); grid = -1; return; }
        int dev = 0, cus = 0, per_cu = 0;
        hipGetDevice(&dev); hipDeviceGetAttribute(&cus, hipDeviceAttributeMultiprocessorCount, dev);
        hipFuncSetAttribute((const void*)hybrid_fwd, hipFuncAttributeMaxDynamicSharedMemorySize, LDS_BYTES);
        hipOccupancyMaxActiveBlocksPerMultiprocessor(&per_cu, (const void*)hybrid_fwd, 512, LDS_BYTES);
        if (per_cu < 1) per_cu = 1;
        (void)hipGetLastError();
        grid = cus * 1;
        if (grid > 256) grid = 256;
    }
    if (grid < 0) return;
    Params p{};
    for (int i = 0; i < 39; ++i) p.in[i] = (const float*)d_in[i];
    p.out = (float*)d_out; p.ws = (unsigned char*)d_ws;
    (void)hipMemsetAsync((unsigned char*)d_ws + W_BAR, 0, XCD_BAR_BYTES, stream);
    void* args[] = {&p};
    hipError_t e = hipLaunchCooperativeKernel((const void*)hybrid_fwd, dim3(grid), dim3(512), args, LDS_BYTES, stream);
    if (e != hipSuccess) fprintf(stderr, "cooperative launch failed: %s (grid %d)\n", hipGetErrorString(e), grid);
}
```

```cpp
#include <hip/hip_runtime.h>
#include <hip/hip_cooperative_groups.h>
#include <cstdio>
#include <type_traits>
namespace cg = cooperative_groups;

#define LAS __attribute__((address_space(3)))
typedef unsigned short bf16_t;
typedef short bf16x8 __attribute__((ext_vector_type(8)));
typedef short bf16x4 __attribute__((ext_vector_type(4)));
typedef float f32x4 __attribute__((ext_vector_type(4)));
typedef unsigned u32x4 __attribute__((ext_vector_type(4)));
typedef unsigned u32x2 __attribute__((ext_vector_type(2)));

constexpr int T_ALL = 33280, T_P = 32768, NCHUNK = 520, DM = 1024, NINP = 3840, DFF = 2816, DFF2 = 5632;
constexpr float EPS = 1e-6f;
constexpr size_t OUT_Y = 0;
constexpr size_t OUT_PMK = OUT_Y + (size_t)T_ALL * 1024;
constexpr size_t OUT_PMV = OUT_PMK + 2ull * 8 * 256 * 1024;
constexpr size_t SZ_AC = 2ull * 8 * 3 * 1536, SZ_AS = 2ull * 8 * 4 * 128 * 128, SZ_BC = 2ull * 8 * 3 * 256, SZ_BH = 2ull * 8 * 256, SZ_CS = 2ull * 8 * 4 * 64 * 64, SZ_FC = 2ull * 8 * 2 * 5632;
constexpr size_t OUT_PAC = OUT_PMV + 2ull * 8 * 256 * 1024;
constexpr size_t OUT_PAS = OUT_PAC + SZ_AC;
constexpr size_t OUT_PBC = OUT_PAS + SZ_AS;
constexpr size_t OUT_PBH = OUT_PBC + SZ_BC;
constexpr size_t OUT_PCS = OUT_PBH + SZ_BH;
constexpr size_t OUT_PFC = OUT_PCS + SZ_CS;
constexpr size_t OUT_SAC = OUT_PFC + SZ_FC;
constexpr size_t OUT_SAS = OUT_SAC + SZ_AC;
constexpr size_t OUT_SBC = OUT_SAS + SZ_AS;
constexpr size_t OUT_SBH = OUT_SBC + SZ_BC;
constexpr size_t OUT_SCS = OUT_SBH + SZ_BH;
constexpr size_t OUT_SFC = OUT_SCS + SZ_CS;
constexpr size_t OUT_TOTAL = OUT_SFC + SZ_FC;

constexpr size_t AL(size_t x) { return (x + 255) & ~(size_t)255; }
constexpr size_t W_BIN = 0;
constexpr size_t W_BOUT = W_BIN + 2ull * NINP * 1024 * 2;
constexpr size_t W_BQ = W_BOUT + 2ull * 1024 * 1024 * 2;
constexpr size_t W_BO = W_BQ + 2ull * 1024 * 1024 * 2;
constexpr size_t W_BKV = W_BO + 2ull * 1024 * 1024 * 2;
constexpr size_t W_BUP = W_BKV + 4096ull * 1024 * 2;
constexpr size_t W_BDN = W_BUP + 2ull * DFF2 * 1024 * 2;
constexpr size_t W_MEMB = W_BDN + 2ull * 1024 * DFF * 2;
constexpr size_t W_KB = W_MEMB + 2048ull * 1024 * 2;
constexpr size_t W_VT = W_KB + 2ull * 16 * 256 * 1024 * 2;
constexpr size_t XB_PRE = 2, XB_ROWS = (size_t)T_ALL + 2 + 318;
constexpr size_t W_XB = W_VT + 2ull * 16 * 256 * 1024 * 2;
constexpr size_t W_SSQ = W_XB + XB_ROWS * 1024 * 2;
constexpr size_t W_GL = W_SSQ + 8ull * T_ALL * 4;
constexpr size_t W_EH = AL(W_GL + 2080 * 4);
constexpr size_t W_SUMA = W_EH + 2080ull * 64 * 4;
constexpr size_t W_SUMH = W_SUMA + 520ull * 256 * 4;
constexpr size_t W_BAR = AL(W_SUMH + 520ull * 256 * 4);
constexpr size_t XCD_BAR_BYTES = 3456 * 4 + 256;
constexpr size_t W_QCTR = W_BAR + 3456 * 4;
constexpr size_t W_R = AL(W_BAR + XCD_BAR_BYTES);
constexpr size_t GITEM = 36864;
constexpr size_t HITEM = 16384;
constexpr size_t R_GBUF = W_R;
constexpr size_t R_HBUF = R_GBUF + 2080ull * GITEM * 2;
constexpr size_t R_ZBUF = R_HBUF + 2080ull * HITEM * 2;
constexpr size_t R_BX = R_ZBUF + (size_t)T_ALL * 1024 * 2;
constexpr size_t R_HLOC = R_BX + (size_t)T_ALL * 256 * 2;
constexpr size_t R_PCUM = R_HLOC + (size_t)T_ALL * 256 * 2;
constexpr size_t R_HALO = R_PCUM + (size_t)T_ALL * 256 * 2;
constexpr size_t R_GATES = AL(R_HALO + 520ull * 3 * 1536 * 2);
constexpr size_t R_END1 = R_GATES + (size_t)T_ALL * 8 * 4;
constexpr size_t R_QBUF = W_R;
constexpr size_t R_OATT = R_QBUF + (size_t)T_ALL * 1024 * 2;
constexpr size_t R_ACT = W_R;
constexpr size_t R_END3 = R_ACT + ((size_t)T_ALL + 256) * DFF * 2;
constexpr size_t WS_NEED = (R_END1 > R_END3 ? R_END1 : R_END3);
static_assert(WS_NEED <= 512ull * 1024 * 1024, "workspace map exceeds 512 MiB");

constexpr int LDS_BYTES = 147456;
#ifndef TIMING
#define TIMING 0
#endif
#define TSCAN(k) do { if (TIMING == 2 && blockIdx.x == 0 && threadIdx.x == 0) { unsigned long long* tmr_ = (unsigned long long*)(p.ws + W_SSQ + (7ull * T_ALL + 4096) * 4); const unsigned long long t_ = __builtin_amdgcn_s_memrealtime(); tmr_[k] += t_ - tmr_[29]; tmr_[29] = t_; } } while (0)
#define TMARK(k) do { if (TIMING && blockIdx.x == 0 && threadIdx.x == 0) { unsigned long long* tmr_ = (unsigned long long*)(p.ws + W_SSQ + (7ull * T_ALL + 4096) * 4); const unsigned long long t_ = __builtin_amdgcn_s_memrealtime(); tmr_[k] += t_ - tmr_[31]; tmr_[31] = t_; } } while (0)
#ifndef STOP_AFTER
#define STOP_AFTER 99
#endif

struct Params {
    const float* in[39];
    float* out;
    unsigned char* ws;
};

__device__ __forceinline__ float bf2f(bf16_t b) { return __uint_as_float(((unsigned)b) << 16); }
typedef float f32x2_t __attribute__((ext_vector_type(2)));
typedef __bf16 bf16x2_t __attribute__((ext_vector_type(2)));
__device__ __forceinline__ unsigned cvt_pk_bf16(float lo, float hi) { const f32x2_t v = {lo, hi}; const bf16x2_t r = __builtin_convertvector(v, bf16x2_t); return __builtin_bit_cast(unsigned, r); }
__device__ __forceinline__ bf16_t f2bf(float f) { return (bf16_t)(cvt_pk_bf16(f, 0.f) & 0xffffu); }
__device__ __forceinline__ float lo_bf(unsigned w) { return __uint_as_float(w << 16); }
__device__ __forceinline__ float hi_bf(unsigned w) { return __uint_as_float(w & 0xffff0000u); }
__device__ __forceinline__ float sigmoidf_(float x) { return __builtin_amdgcn_rcpf(1.0f + __expf(-x)); }
__device__ __forceinline__ float siluf_(float x) { return x * __builtin_amdgcn_rcpf(1.0f + __expf(-x)); }
__device__ __forceinline__ float softplusf_(float x) { return x > 20.f ? x : log1pf(__expf(x)); }
__device__ __forceinline__ float gelu_tanh(float x) { const float u = 0.7978845608028654f * (x + 0.044715f * x * x * x); return 0.5f * x * (1.0f + tanhf(u)); }
__device__ __forceinline__ float ssqv(const float* ssq, int row) { return (float)__float_as_uint(ssq[row]) * (1.0f / 4096.0f); }
__device__ __forceinline__ unsigned ssq_fix(float s) { return (unsigned)(s * 4096.0f + 0.5f); }
__device__ __forceinline__ f32x4 mfma16(bf16x8 a, bf16x8 b, f32x4 c) { return __builtin_amdgcn_mfma_f32_16x16x32_bf16(a, b, c, 0, 0, 0); }
__device__ __forceinline__ void unpack8(u32x4 w, float* f) { f[0] = lo_bf(w.x); f[1] = hi_bf(w.x); f[2] = lo_bf(w.y); f[3] = hi_bf(w.y); f[4] = lo_bf(w.z); f[5] = hi_bf(w.z); f[6] = lo_bf(w.w); f[7] = hi_bf(w.w); }
__device__ __forceinline__ u32x4 pack8(const float* f) { u32x4 w; w.x = cvt_pk_bf16(f[0], f[1]); w.y = cvt_pk_bf16(f[2], f[3]); w.z = cvt_pk_bf16(f[4], f[5]); w.w = cvt_pk_bf16(f[6], f[7]); return w; }

namespace pg8 {
constexpr int BM = 256, BK = 64, HALF = 128, HTB = HALF * BK * 2, STAGE_BYTES = 8 * HTB, NXCD = 8, WGM = 8;
__device__ __forceinline__ int lds_byte(int r, int c) { const int st = (r >> 4) * 2 + (c >> 5), rr = r & 15, cc = c & 31, ob = rr * 64 + cc * 2; return st * 1024 + (ob ^ (((ob >> 9) & 1) << 5)); }
__device__ __forceinline__ void stage_rc(int b, int& R, int& C) { const int st = b / 1024, sb = b % 1024, swz = sb ^ (((sb >> 9) & 1) << 5); R = (st >> 1) * 16 + swz / 64; C = (st & 1) * 32 + (swz % 64) / 2; }
__device__ __forceinline__ int perm32(int rho) { const int n = rho >> 4, i = rho & 15; return 8 * (i >> 2) + 4 * n + (i & 3); }
struct Unit { int pm, pn; };
struct Order {
    int nM, nN, nwg, G, c;
    __device__ void init(int nM_, int nN_, int G_, int c_) { nM = nM_; nN = nN_; nwg = nM * nN; G = G_; c = c_; }
    __device__ bool next(int i, Unit& u) const {
        const long L = (long)i * G + c; if (L >= nwg) return false;
        int wgid = (int)L; { const int q = nwg / NXCD, r = nwg % NXCD, xcd = wgid % NXCD, off = wgid / NXCD; wgid = (xcd < r ? xcd * (q + 1) : r * (q + 1) + (xcd - r) * q) + off; }
        const int nig = WGM * nN, gid = wgid / nig, fm = gid * WGM, gsz = (nM - fm) < WGM ? (nM - fm) : WGM;
        u.pm = fm + ((wgid % nig) % gsz); u.pn = (wgid % nig) / gsz; return true;
    }
};
template <class Epi, int AMODE>
__device__ __forceinline__ void gemm_phase(LAS unsigned char* lds, const bf16_t* A, const bf16_t* Bt, int K, int nM, int nN, const Epi& E) {
    int tid = threadIdx.x; asm volatile("" : "+v"(tid)); const int wid = __builtin_amdgcn_readfirstlane(tid >> 6), lane = tid & 63, wr = wid >> 2, wc = wid & 3, fr = lane & 15, fq = lane >> 4;
    const int nt = K / BK;
    unsigned voffA[2], voffB[2];
#pragma unroll
    for (int i = 0; i < 2; ++i) { int R, C; stage_rc(tid * 16 + i * 8192, R, C); const int Rb = Epi::PERM ? ((R & ~31) + perm32(R & 31)) : R;
        const int Ra = AMODE ? ((R >> 6) * 126 + (R & 63)) : R;
        voffA[i] = (unsigned)(Ra * K + C) * 2u; voffB[i] = (unsigned)(Rb * K + C) * 2u; }
    const size_t kstep = (size_t)(BK * 2);
    const size_t hstepB = (size_t)HALF * K * 2, tstepB = 2 * hstepB;
    const size_t hstepA = AMODE ? (size_t)64 * K * 2 : hstepB, tstepA = AMODE ? (size_t)252 * K * 2 : tstepB;
    const unsigned ldsw = (unsigned)wid * 1024u;
    const int aoff = lds_byte(wr * 64 + fr, fq * 8), boff = lds_byte(wc * 32 + fr, fq * 8);
#define PG8_SA(b, h) (((b) * 2 + (h)) * HTB)
#define PG8_SB(b, h) ((4 + (b) * 2 + (h)) * HTB)
#define PG8_STAGE(bufoff, gbase, voff) do { _Pragma("unroll") for (int _i = 0; _i < 2; ++_i) \
        __builtin_amdgcn_global_load_lds((const unsigned*)((const char*)(gbase) + (voff)[_i]), (LAS unsigned*)(lds + (bufoff) + ldsw + _i * 8192), 16, 0, 0); } while (0)
#define PG8_LDA(dst, b, h) do { _Pragma("unroll") for (int m = 0; m < 4; ++m) _Pragma("unroll") for (int k = 0; k < 2; ++k) dst[m][k] = *(const LAS bf16x8*)(lds + PG8_SA(b, h) + aoff + m * 2048 + k * 1024); } while (0)
#define PG8_LDB(dst, b, h) do { _Pragma("unroll") for (int n = 0; n < 2; ++n) _Pragma("unroll") for (int k = 0; k < 2; ++k) dst[n][k] = *(const LAS bf16x8*)(lds + PG8_SB(b, h) + boff + n * 2048 + k * 1024); } while (0)
#define PG8_MMA(ai, bj, At, Bt_) do { __builtin_amdgcn_s_setprio(1); _Pragma("unroll") for (int m = 0; m < 4; ++m) _Pragma("unroll") for (int n = 0; n < 2; ++n) _Pragma("unroll") for (int k = 0; k < 2; ++k) \
        acc[ai][bj][m][n] = __builtin_amdgcn_mfma_f32_16x16x32_bf16(Bt_[n][k], At[m][k], acc[ai][bj][m][n], 0, 0, 0); __builtin_amdgcn_s_setprio(0); } while (0)
#define PG8_WAIT_V(n) asm volatile("s_waitcnt vmcnt(" #n ")" ::: "memory")
#define PG8_WAIT_L(n) asm volatile("s_waitcnt lgkmcnt(" #n ")" ::: "memory")
#define PG8_BAR __builtin_amdgcn_s_barrier()
#define PG8_SCHED __builtin_amdgcn_sched_barrier(0)
    int bid_ = blockIdx.x; asm volatile("" : "+s"(bid_));
    Order S; S.init(nM, nN, gridDim.x, bid_);
    Unit cur, nxt; int ui = 0;
    if (!S.next(0, cur)) return;
    f32x4 acc[2][2][4][2];
    if constexpr (Epi::PRELOAD) E.preload(acc, cur, wr, wc);
    else {
#pragma unroll
    for (int a = 0; a < 2; ++a)
#pragma unroll
        for (int b = 0; b < 2; ++b)
#pragma unroll
            for (int m = 0; m < 4; ++m)
#pragma unroll
                for (int n = 0; n < 2; ++n) acc[a][b][m][n] = (f32x4){0.f, 0.f, 0.f, 0.f}; }
    bf16x8 At[4][2], B0[2][2], B1[2][2];
    const char* cA = (const char*)A + (size_t)cur.pm * tstepA; const char* cB = (const char*)Bt + (size_t)cur.pn * tstepB;
    PG8_STAGE(PG8_SB(0, 0), cB, voffB); PG8_STAGE(PG8_SA(0, 0), cA, voffA); PG8_STAGE(PG8_SB(0, 1), cB + hstepB, voffB); PG8_STAGE(PG8_SA(0, 1), cA + hstepA, voffA);
    if (wr == 1) PG8_BAR;
    PG8_WAIT_V(4); PG8_BAR;
    PG8_STAGE(PG8_SB(1, 0), cB + kstep, voffB); PG8_STAGE(PG8_SA(1, 0), cA + kstep, voffA); PG8_STAGE(PG8_SB(1, 1), cB + hstepB + kstep, voffB);
    PG8_WAIT_V(6); PG8_BAR;
    for (;;) {
        const bool has_next = S.next(ui + 1, nxt);
        const char* nA = has_next ? (const char*)A + (size_t)nxt.pm * tstepA : cA; const char* nB = has_next ? (const char*)Bt + (size_t)nxt.pn * tstepB : cB;
        for (int t = 0; t < nt; t += 2) {
            const bool last = (t == nt - 2);
            const char* a1 = cA + (size_t)(t + 1) * kstep;
            const char* a2 = last ? nA : cA + (size_t)(t + 2) * kstep; const char* b2 = last ? nB : cB + (size_t)(t + 2) * kstep;
            const char* a3 = a2 + kstep; const char* b3 = b2 + kstep;
            PG8_LDB(B0, 0, 0); PG8_SCHED; PG8_LDA(At, 0, 0); PG8_STAGE(PG8_SA(1, 1), a1 + hstepA, voffA);
            PG8_WAIT_L(8); PG8_BAR; PG8_WAIT_L(0); PG8_MMA(0, 0, At, B0); PG8_BAR; PG8_SCHED;
            PG8_LDB(B1, 0, 1); PG8_STAGE(PG8_SB(0, 0), b2, voffB);
            PG8_BAR; PG8_WAIT_L(0); PG8_MMA(0, 1, At, B1); PG8_BAR;
            PG8_LDA(At, 0, 1); PG8_STAGE(PG8_SA(0, 0), a2, voffA);
            PG8_BAR; PG8_WAIT_L(0); PG8_MMA(1, 0, At, B0); PG8_BAR; PG8_SCHED;
            PG8_STAGE(PG8_SB(0, 1), b2 + hstepB, voffB);
            PG8_WAIT_V(6); PG8_BAR; PG8_MMA(1, 1, At, B1); PG8_BAR;
            PG8_LDB(B0, 1, 0); PG8_SCHED; PG8_LDA(At, 1, 0); PG8_STAGE(PG8_SA(0, 1), a2 + hstepA, voffA);
            PG8_WAIT_L(8); PG8_BAR; PG8_WAIT_L(0); PG8_MMA(0, 0, At, B0); PG8_BAR; PG8_SCHED;
            PG8_LDB(B1, 1, 1); PG8_STAGE(PG8_SB(1, 0), b3, voffB);
            PG8_BAR; PG8_WAIT_L(0); PG8_MMA(0, 1, At, B1); PG8_BAR;
            PG8_LDA(At, 1, 1); PG8_STAGE(PG8_SA(1, 0), a3, voffA);
            PG8_BAR; PG8_WAIT_L(0); PG8_MMA(1, 0, At, B0); PG8_BAR; PG8_SCHED;
            PG8_STAGE(PG8_SB(1, 1), b3 + hstepB, voffB);
            PG8_WAIT_V(6); PG8_BAR; PG8_MMA(1, 1, At, B1); PG8_BAR;
        }
        E(acc, cur, wr, wc, fr, fq);
        if (!has_next) break;
        if constexpr (Epi::PRELOAD) E.preload(acc, nxt, wr, wc);
        else {
#pragma unroll
        for (int a = 0; a < 2; ++a)
#pragma unroll
            for (int b = 0; b < 2; ++b)
#pragma unroll
                for (int m = 0; m < 4; ++m)
#pragma unroll
                    for (int n = 0; n < 2; ++n) acc[a][b][m][n] = (f32x4){0.f, 0.f, 0.f, 0.f}; }
        cur = nxt; cA = nA; cB = nB; ++ui;
    }
    PG8_WAIT_V(0);
    if (wr == 0) PG8_BAR;
    PG8_BAR;
#undef PG8_SA
#undef PG8_SB
#undef PG8_STAGE
#undef PG8_LDA
#undef PG8_LDB
#undef PG8_MMA
#undef PG8_WAIT_V
#undef PG8_WAIT_L
#undef PG8_BAR
#undef PG8_SCHED
}
}
using pg8::Unit;
typedef f32x4 AccT[2][2][4][2];

struct EpiKV {
    static constexpr bool PERM = false, PRELOAD = false;
    float* out; const float* ssq;
    __device__ __forceinline__ void operator()(const AccT& acc, const Unit& u, int wr, int wc, int fr, int fq) const {
        { int ln_ = (int)__builtin_amdgcn_mbcnt_hi(~0u, __builtin_amdgcn_mbcnt_lo(~0u, 0u)); asm volatile("" : "+v"(ln_)); fr = ln_ & 15; fq = ln_ >> 4; }
        const int which = u.pn >> 2;
        float* base = out + ((which & 1) ? OUT_PMV : OUT_PMK) + (size_t)(which >> 1) * 2048 * 1024 + (u.pn & 3) * 256 + wc * 32 + 4 * fq;
#pragma unroll
        for (int ai = 0; ai < 2; ++ai)
#pragma unroll
            for (int m = 0; m < 4; ++m) { const int row = u.pm * 256 + ai * 128 + wr * 64 + m * 16 + fr; const float rs = rsqrtf(ssqv(ssq, row) * (1.0f / 1024.0f) + EPS);
                float* rowp = base + (size_t)row * 1024;
#pragma unroll
                for (int bj = 0; bj < 2; ++bj)
#pragma unroll
                    for (int n = 0; n < 2; ++n) *(f32x4*)(rowp + bj * 128 + n * 16) = acc[ai][bj][m][n] * rs; }
    }
};
struct EpiRes {
    static constexpr bool PERM = false, PRELOAD = true;
    float* xf; bf16_t* xb; float* ssq;
    __device__ __forceinline__ void preload(AccT& acc, const Unit& u, int wr, int wc) const {
        int ln_ = (int)__builtin_amdgcn_mbcnt_hi(~0u, __builtin_amdgcn_mbcnt_lo(~0u, 0u)); asm volatile("" : "+v"(ln_)); const int fr = ln_ & 15, fq = ln_ >> 4;
        const int col0 = u.pn * 256 + wc * 32 + 4 * fq;
#pragma unroll
        for (int ai = 0; ai < 2; ++ai)
#pragma unroll
            for (int m = 0; m < 4; ++m) { const int row = u.pm * 256 + ai * 128 + wr * 64 + m * 16 + fr; const bf16_t* rowb = xb + (size_t)row * 1024 + col0;
#pragma unroll
                for (int bj = 0; bj < 2; ++bj)
#pragma unroll
                    for (int n = 0; n < 2; ++n) { const u32x2 o = *(const u32x2*)(rowb + bj * 128 + n * 16); acc[ai][bj][m][n] = (f32x4){lo_bf(o.x), hi_bf(o.x), lo_bf(o.y), hi_bf(o.y)}; } }
    }
    __device__ __forceinline__ void operator()(const AccT& acc, const Unit& u, int wr, int wc, int fr, int fq) const {
        { int ln_ = (int)__builtin_amdgcn_mbcnt_hi(~0u, __builtin_amdgcn_mbcnt_lo(~0u, 0u)); asm volatile("" : "+v"(ln_)); fr = ln_ & 15; fq = ln_ >> 4; }
        const int col0 = u.pn * 256 + wc * 32 + 4 * fq;
#pragma unroll
        for (int ai = 0; ai < 2; ++ai)
#pragma unroll
            for (int m = 0; m < 4; ++m) { const int row = u.pm * 256 + ai * 128 + wr * 64 + m * 16 + fr; bf16_t* rowb = xb + (size_t)row * 1024 + col0;
                float s = 0.f;
#pragma unroll
                for (int bj = 0; bj < 2; ++bj)
#pragma unroll
                    for (int n = 0; n < 2; ++n) { const f32x4 x = acc[ai][bj][m][n];
                        u32x2 w; w.x = cvt_pk_bf16(x[0], x[1]); w.y = cvt_pk_bf16(x[2], x[3]); *(u32x2*)(rowb + bj * 128 + n * 16) = w;
                        if (xf) *(f32x4*)(xf + (size_t)row * 1024 + col0 + bj * 128 + n * 16) = x;
                        s += (x[0] * x[0] + x[1] * x[1]) + (x[2] * x[2] + x[3] * x[3]); }
                s += __shfl_xor(s, 16); s += __shfl_xor(s, 32);
                if (fq == 0) atomicAdd((unsigned*)(ssq + row), ssq_fix(s)); }
    }
};
struct EpiQ {
    static constexpr bool PERM = true, PRELOAD = false;
    bf16_t* q; const float* ssq;
    __device__ __forceinline__ void operator()(const AccT& acc, const Unit& u, int wr, int wc, int fr, int fq) const {
        { int ln_ = (int)__builtin_amdgcn_mbcnt_hi(~0u, __builtin_amdgcn_mbcnt_lo(~0u, 0u)); asm volatile("" : "+v"(ln_)); fr = ln_ & 15; fq = ln_ >> 4; }
        const int col0 = u.pn * 256 + wc * 32 + 8 * fq;
#pragma unroll
        for (int ai = 0; ai < 2; ++ai)
#pragma unroll
            for (int m = 0; m < 4; ++m) { const int row = u.pm * 256 + ai * 128 + wr * 64 + m * 16 + fr; const float rs = rsqrtf(ssqv(ssq, row) * (1.0f / 1024.0f) + EPS);
                bf16_t* rowp = q + (size_t)row * 1024 + col0;
#pragma unroll
                for (int bj = 0; bj < 2; ++bj) { const f32x4 v0 = acc[ai][bj][m][0] * rs, v1 = acc[ai][bj][m][1] * rs; u32x4 w; w.x = cvt_pk_bf16(v0[0], v0[1]); w.y = cvt_pk_bf16(v0[2], v0[3]); w.z = cvt_pk_bf16(v1[0], v1[1]); w.w = cvt_pk_bf16(v1[2], v1[3]);
                    *(u32x4*)(rowp + bj * 128) = w; } }
    }
};
struct EpiProj {
    static constexpr bool PERM = true, PRELOAD = false;
    unsigned char* ws; const float* ssq;
    __device__ __forceinline__ void operator()(const AccT& acc, const Unit& u, int wr, int wc, int fr, int fq) const {
        { int ln_ = (int)__builtin_amdgcn_mbcnt_hi(~0u, __builtin_amdgcn_mbcnt_lo(~0u, 0u)); asm volatile("" : "+v"(ln_)); fr = ln_ & 15; fq = ln_ >> 4; }
        bf16_t* gbuf = (bf16_t*)(ws + R_GBUF); bf16_t* hbuf = (bf16_t*)(ws + R_HBUF); bf16_t* zbuf = (bf16_t*)(ws + R_ZBUF); bf16_t* bx = (bf16_t*)(ws + R_BX); bf16_t* halo = (bf16_t*)(ws + R_HALO); float* gates = (float*)(ws + R_GATES);
        const int pn = u.pn;
#pragma unroll
        for (int ai = 0; ai < 2; ++ai)
#pragma unroll
            for (int m = 0; m < 4; ++m) { const int row = u.pm * 256 + ai * 128 + wr * 64 + m * 16 + fr; const float rs = rsqrtf(ssqv(ssq, row) * (1.0f / 1024.0f) + EPS);
                const int chunk = row >> 6, t = row & 63;
#pragma unroll
                for (int bj = 0; bj < 2; ++bj) { const f32x4 v0 = acc[ai][bj][m][0] * rs, v1 = acc[ai][bj][m][1] * rs;
                    const int cc = bj * 128 + wc * 32 + 8 * fq;
                    if (pn == 14) { if (cc == 0) { *(f32x4*)(gates + (size_t)row * 8) = v0; *(f32x4*)(gates + (size_t)row * 8 + 4) = v1; } continue; }
                    u32x4 w; w.x = cvt_pk_bf16(v0[0], v0[1]); w.y = cvt_pk_bf16(v0[2], v0[3]); w.z = cvt_pk_bf16(v1[0], v1[1]); w.w = cvt_pk_bf16(v1[2], v1[3]);
                    if (pn < 6) { const int which = pn >> 1, head = (pn & 1) * 2 + bj, d = wc * 32 + 8 * fq;
                        *(u32x4*)(gbuf + (size_t)(chunk * 4 + head) * GITEM + which * 8192 + t * 128 + d) = w;
                        if (t >= 61) *(u32x4*)(halo + (size_t)(chunk * 3 + (t - 61)) * 1536 + which * 512 + head * 128 + d) = w; }
                    else if (pn < 8) *(u32x4*)(zbuf + (size_t)row * 1024 + (pn - 6) * 256 + cc) = w;
                    else if (pn == 8) *(u32x4*)(bx + (size_t)row * 256 + cc) = w;
                    else if (pn == 9) *(u32x4*)(zbuf + (size_t)row * 1024 + 512 + cc) = w;
                    else if (pn < 13) { const int which = pn - 10, head = cc >> 6, d = cc & 63;
                        *(u32x4*)(hbuf + (size_t)(chunk * 4 + head) * HITEM + which * 4096 + t * 64 + d) = w; }
                    else *(u32x4*)(zbuf + (size_t)row * 1024 + 768 + cc) = w; } }
    }
};
struct EpiUp {
    static constexpr bool PERM = true, PRELOAD = false;
    bf16_t* act; const float* ssq; const float* convw; const float* convb; const float* state; float* outp; float* outs;
    __device__ __forceinline__ void operator()(const AccT& acc, const Unit& u, int wr, int wc, int fr, int fq) const {
        { int ln_ = (int)__builtin_amdgcn_mbcnt_hi(~0u, __builtin_amdgcn_mbcnt_lo(~0u, 0u)); asm volatile("" : "+v"(ln_)); fr = ln_ & 15; fq = ln_ >> 4; }
        const int lane = fq * 16 + fr;
        const int grow0 = u.pm * 252 + wr * 126 - 2;
        const int cbase = u.pn * 128 + wc * 32 + 8 * fq;
        (void)lane;
        float rsv[8];
#pragma unroll
        for (int g = 0; g < 8; ++g) { int grow = grow0 + g * 16 + fr; grow = grow < 0 ? 0 : (grow >= T_ALL ? T_ALL - 1 : grow); rsv[g] = rsqrtf(ssqv(ssq, grow) * (1.0f / 1024.0f) + EPS); }
#pragma unroll
        for (int n = 0; n < 2; ++n) {
            const int c = cbase + 4 * n;
            f32x4 wg[3], wv[3];
#pragma unroll
            for (int j = 0; j < 3; ++j) { wg[j] = *(const f32x4*)(convw + j * DFF2 + c); wv[j] = *(const f32x4*)(convw + j * DFF2 + DFF + c); }
            const f32x4 bg = *(const f32x4*)(convb + c), bv = *(const f32x4*)(convb + DFF + c);
            f32x4 pg_g = (f32x4){0.f, 0.f, 0.f, 0.f}, pg_v = pg_g;
#pragma unroll
            for (int g = 0; g < 8; ++g) {
                const int ai = g >> 2, m = g & 3;
                const f32x4 cg_ = acc[ai][0][m][n] * rsv[g], cv_ = acc[ai][1][m][n] * rsv[g];
                f32x4 p1g, p2g, p1v, p2v;
#pragma unroll
                for (int j = 0; j < 4; ++j) {
#define ROR1(x) __builtin_bit_cast(float, __builtin_amdgcn_update_dpp(0, __builtin_bit_cast(int, (float)(x)), 0x121, 0xf, 0xf, false))
#define ROR2(x) __builtin_bit_cast(float, __builtin_amdgcn_update_dpp(0, __builtin_bit_cast(int, (float)(x)), 0x122, 0xf, 0xf, false))
                    const float a1 = ROR1(cg_[j]), b1 = ROR1(pg_g[j]), a2 = ROR2(cg_[j]), b2 = ROR2(pg_g[j]);
                    p1g[j] = fr >= 1 ? a1 : b1; p2g[j] = fr >= 2 ? a2 : b2;
                    const float c1 = ROR1(cv_[j]), d1 = ROR1(pg_v[j]), c2 = ROR2(cv_[j]), d2 = ROR2(pg_v[j]);
                    p1v[j] = fr >= 1 ? c1 : d1; p2v[j] = fr >= 2 ? c2 : d2;
                }
                const int rho = g * 16 + fr, grow = grow0 + rho;
                if (rho >= 2 && grow < T_ALL) {
                    const bool samp = grow >= T_P; const int s = samp ? ((grow - T_P) & 63) : (grow & 4095); const int b = samp ? ((grow - T_P) >> 6) : (grow >> 12); const int L = samp ? 64 : 4096;
                    if (s < 2) {
                        f32x4 s0g = (f32x4){0.f, 0.f, 0.f, 0.f}, s1g = s0g, s0v = s0g, s1v = s0g;
                        if (samp) { const float* st = state + (size_t)b * 2 * DFF2; s0g = *(const f32x4*)(st + c); s1g = *(const f32x4*)(st + DFF2 + c); s0v = *(const f32x4*)(st + DFF + c); s1v = *(const f32x4*)(st + DFF2 + DFF + c); }
                        if (s == 0) { p1g = s1g; p2g = s0g; p1v = s1v; p2v = s0v; } else { p2g = s1g; p2v = s1v; }
                    }
                    const f32x4 yg = wg[0] * p2g + wg[1] * p1g + wg[2] * cg_ + bg;
                    const f32x4 yv = wv[0] * p2v + wv[1] * p1v + wv[2] * cv_ + bv;
                    u32x2 w; w.x = cvt_pk_bf16(siluf_(yg[0]) * yv[0], siluf_(yg[1]) * yv[1]); w.y = cvt_pk_bf16(siluf_(yg[2]) * yv[2], siluf_(yg[3]) * yv[3]);
                    *(u32x2*)(act + (size_t)grow * DFF + c) = w;
                    if (s >= L - 2) { float* o = (samp ? outs : outp) + ((size_t)b * 2 + (s - (L - 2))) * DFF2; *(f32x4*)(o + c) = cg_; *(f32x4*)(o + DFF + c) = cv_; }
                }
                pg_g = cg_; pg_v = cv_;
            }
        }
    }
};

template <int MODE>
__device__ __forceinline__ void small_gemm(const bf16_t* A, const bf16_t* Bt, int K, bf16_t* outb, float* xf, float* ssq_acc, const float* ssq_rs) {
    int tid = threadIdx.x; asm volatile("" : "+v"(tid)); const int lane = tid & 63, w = tid >> 6, fr = lane & 15, fq = lane >> 4;
    for (int t = blockIdx.x; t < 256; t += gridDim.x) {
        const int tm = t >> 5, tn = t & 31; const int row0 = T_P + tm * 64 + (w >> 1) * 16, col0 = tn * 32 + (w & 1) * 16;
        const bf16_t* ap = A + (size_t)(row0 + fr) * K + fq * 8; const bf16_t* bp = Bt + (size_t)(col0 + fr) * K + fq * 8;
        f32x4 acc = (f32x4){0.f, 0.f, 0.f, 0.f};
#pragma unroll 8
        for (int k = 0; k < K; k += 32) acc = mfma16(*(const bf16x8*)(ap + k), *(const bf16x8*)(bp + k), acc);
#pragma unroll
        for (int jj = 0; jj < 4; ++jj) { const int row = row0 + fq * 4 + jj, col = col0 + fr; const size_t o = (size_t)row * 1024 + col;
            if (MODE == 0) { const float x = bf2f(outb[o]) + acc[jj]; outb[o] = f2bf(x); if (xf) xf[o] = x;
                float sq = x * x; sq += __shfl_xor(sq, 1); sq += __shfl_xor(sq, 2); sq += __shfl_xor(sq, 4); sq += __shfl_xor(sq, 8);
                if (fr == 0) atomicAdd((unsigned*)(ssq_acc + row), ssq_fix(sq)); }
            else { const float rs = rsqrtf(ssqv(ssq_rs, row) * (1.0f / 1024.0f) + EPS); outb[o] = f2bf(acc[jj] * rs); } }
    }
}

__device__ __forceinline__ int src_col8(int mode, int j0) {
    if (mode == 1) { if (j0 < 2048) return j0; if (j0 < 3584) return j0 + 8; if (j0 < 3592) return 2048; return -1; }
    if (mode == 2) { const int pn = j0 >> 8, w = j0 & 255; return w < 128 ? pn * 128 + w : DFF + pn * 128 + (w - 128); }
    return j0;
}
__device__ __noinline__ void transpose_job(const float* W, int ldw, int Kdim, int Nout, int mode, const float* gain, float scale, bf16_t* Bt, LAS unsigned char* lds, int rot) {
    LAS bf16_t* tile = (LAS bf16_t*)lds;
    int tid = threadIdx.x; asm volatile("" : "+v"(tid)); const int ntn = Nout >> 6, ntiles = ntn * (Kdim >> 6);
    for (int t = (int)((blockIdx.x + gridDim.x - (rot % gridDim.x)) % gridDim.x); t < ntiles; t += gridDim.x) {
        const int kt = t / ntn, ntl = t % ntn, k0 = kt * 64, n0 = ntl * 64;
        { const int kk = tid >> 3, ng = tid & 7; const int s = src_col8(mode, n0 + ng * 8);
          f32x4 a = (f32x4){0.f, 0.f, 0.f, 0.f}, b = a;
          if (s >= 0) { const float* p = W + (size_t)(k0 + kk) * ldw + s; a = *(const f32x4*)p; b = *(const f32x4*)(p + 4); }
          const float g = (gain ? gain[k0 + kk] : 1.0f) * scale;
          const float v[8] = {a[0] * g, a[1] * g, a[2] * g, a[3] * g, b[0] * g, b[1] * g, b[2] * g, b[3] * g};
#pragma unroll
          for (int i = 0; i < 8; ++i) tile[(ng * 8 + i) * 72 + kk] = f2bf(v[i]); }
        __syncthreads();
        { const int nl = tid >> 3, kg = tid & 7; const u32x4 w = *(const LAS u32x4*)(tile + nl * 72 + kg * 8); *(u32x4*)(Bt + (size_t)(n0 + nl) * Kdim + k0 + kg * 8) = w; }
        __syncthreads();
    }
}
__device__ __forceinline__ void rows_to_bf16(const float* src, int nrows, bf16_t* dst, float* copy, float* ssq) {
    int tidl = threadIdx.x; asm volatile("" : "+v"(tidl)); const int lane = tidl & 63, gw = blockIdx.x * 8 + (tidl >> 6), nw = gridDim.x * 8;
    for (int r = gw; r < nrows; r += nw) {
        float s = 0.f;
#pragma unroll
        for (int i = 0; i < 4; ++i) { const int c = i * 256 + lane * 4; const f32x4 x = *(const f32x4*)(src + (size_t)r * 1024 + c);
            if (copy) *(f32x4*)(copy + (size_t)r * 1024 + c) = x;
            u32x2 w; w.x = cvt_pk_bf16(x[0], x[1]); w.y = cvt_pk_bf16(x[2], x[3]); *(u32x2*)(dst + (size_t)r * 1024 + c) = w;
            s += (x[0] * x[0] + x[1] * x[1]) + (x[2] * x[2] + x[3] * x[3]); }
#pragma unroll
        for (int o = 32; o >= 1; o >>= 1) s += __shfl_xor(s, o);
        if (lane == 0) ssq[r] = __uint_as_float(ssq_fix(s));
    }
}
__device__ __forceinline__ void convert_flat(const float* src, bf16_t* dst, size_t n8) {
    int tidl = threadIdx.x; asm volatile("" : "+v"(tidl)); for (size_t i = (size_t)blockIdx.x * 512 + tidl; i < n8; i += (size_t)gridDim.x * 512) { const f32x4 a = *(const f32x4*)(src + i * 8), b = *(const f32x4*)(src + i * 8 + 4);
        u32x4 w; w.x = cvt_pk_bf16(a[0], a[1]); w.y = cvt_pk_bf16(a[2], a[3]); w.z = cvt_pk_bf16(b[0], b[1]); w.w = cvt_pk_bf16(b[2], b[3]); *(u32x4*)(dst + i * 8) = w; }
}

__device__ __forceinline__ void phase0(const Params& p, LAS unsigned char* lds) {
    unsigned char* ws = p.ws;
    int rot = 0;
    for (int l = 0; l < 2; ++l) {
        transpose_job(p.in[12] + (size_t)l * 1024 * 3592, 3592, 1024, NINP, 1, p.in[11] + l * 1024, 1.0f, (bf16_t*)(ws + W_BIN) + (size_t)l * NINP * 1024, lds, rot); rot += 60 * 16;
        transpose_job(p.in[26] + (size_t)l * 1024 * 1024, 1024, 1024, 1024, 0, nullptr, 1.0f, (bf16_t*)(ws + W_BOUT) + (size_t)l * 1024 * 1024, lds, rot); rot += 256;
        transpose_job(p.in[29] + (size_t)l * 1024 * 1024, 1024, 1024, 1024, 0, p.in[27] + l * 1024, 0.0625f, (bf16_t*)(ws + W_BQ) + (size_t)l * 1024 * 1024, lds, rot); rot += 256;
        transpose_job(p.in[32] + (size_t)l * 1024 * 1024, 1024, 1024, 1024, 0, nullptr, 1.0f, (bf16_t*)(ws + W_BO) + (size_t)l * 1024 * 1024, lds, rot); rot += 256;
        transpose_job(p.in[30] + (size_t)l * 1024 * 1024, 1024, 1024, 1024, 0, p.in[28] + l * 1024, 1.0f, (bf16_t*)(ws + W_BKV) + (size_t)(l * 2048) * 1024, lds, rot); rot += 256;
        transpose_job(p.in[31] + (size_t)l * 1024 * 1024, 1024, 1024, 1024, 0, p.in[28] + l * 1024, 1.0f, (bf16_t*)(ws + W_BKV) + (size_t)(l * 2048 + 1024) * 1024, lds, rot); rot += 256;
        transpose_job(p.in[34] + (size_t)l * 1024 * DFF2, DFF2, 1024, DFF2, 2, p.in[33] + l * 1024, 1.0f, (bf16_t*)(ws + W_BUP) + (size_t)l * DFF2 * 1024, lds, rot); rot += 88 * 16;
        transpose_job(p.in[37] + (size_t)l * DFF * 1024, 1024, DFF, 1024, 0, nullptr, 1.0f, (bf16_t*)(ws + W_BDN) + (size_t)l * 1024 * DFF, lds, rot); rot += 16 * 44;
        for (int b = 0; b < 8; ++b) for (int h = 0; h < 4; ++h) {
            transpose_job(p.in[3] + ((size_t)(l * 8 + b) * 256) * 1024 + h * 256, 1024, 256, 256, 0, nullptr, 1.0f, (bf16_t*)(ws + W_VT) + ((size_t)((l * 16 + 8 + b) * 4 + h)) * 65536, lds, rot); rot += 16; }
        convert_flat(p.in[2] + (size_t)l * 8 * 256 * 1024, (bf16_t*)(ws + W_KB) + (size_t)(l * 16 + 8) * 256 * 1024, 8ull * 256 * 1024 / 8);
    }
    float* ssq = (float*)(ws + W_SSQ);
    bf16_t* xb = (bf16_t*)(ws + W_XB) + XB_PRE * 1024;
    rows_to_bf16(p.in[0], T_P, xb, nullptr, ssq);
    rows_to_bf16(p.in[1], 512, xb + (size_t)T_P * 1024, nullptr, ssq + T_P);
    rows_to_bf16(p.in[10], 2048, (bf16_t*)(ws + W_MEMB), nullptr, ssq + 7ull * T_ALL);
    int tidz = threadIdx.x; asm volatile("" : "+v"(tidz)); for (size_t i = (size_t)blockIdx.x * 512 + tidz; i < 6ull * T_ALL; i += (size_t)gridDim.x * 512) ssq[T_ALL + i] = 0.f;
}
__device__ __forceinline__ void kv_prompt_convert(const Params& p, LAS unsigned char* lds) {
    unsigned char* ws = p.ws; int rot = 0;
    for (int l = 0; l < 2; ++l) {
        convert_flat(p.out + OUT_PMK + (size_t)l * 2048 * 1024, (bf16_t*)(ws + W_KB) + (size_t)(l * 16) * 256 * 1024, 2048ull * 1024 / 8);
        for (int b = 0; b < 8; ++b) for (int h = 0; h < 4; ++h) {
            transpose_job(p.out + OUT_PMV + ((size_t)(l * 8 + b) * 256) * 1024 + h * 256, 1024, 256, 256, 0, nullptr, 1.0f, (bf16_t*)(ws + W_VT) + ((size_t)((l * 16 + b) * 4 + h)) * 65536, lds, rot); rot += 16; }
    }
}

__device__ __forceinline__ void gdn_prep(const Params& p, int l, LAS unsigned char* lds) {
    unsigned char* ws = p.ws;
    bf16_t* gbuf = (bf16_t*)(ws + R_GBUF); const bf16_t* halo = (const bf16_t*)(ws + R_HALO); const float* gates = (const float*)(ws + R_GATES); float* glb = (float*)(ws + W_GL);
    LAS bf16_t* qs = (LAS bf16_t*)lds;
    LAS bf16_t* ks = qs + 64 * 136; LAS bf16_t* vs = ks + 64 * 136;
    LAS float* Mm = (LAS float*)(lds + 52224);
    LAS float* gc = (LAS float*)(lds + 69632);
    LAS bf16_t* raw = (LAS bf16_t*)(lds + 70400);
    LAS bf16_t* Mb = (LAS bf16_t*)(lds + 70400);
    LAS bf16_t* TinvB = (LAS bf16_t*)(lds + 79616);
    LAS bf16_t* RT = (LAS bf16_t*)(lds + 84736);
    LAS bf16_t* solT = (LAS bf16_t*)(lds + 101120);
    int tid = threadIdx.x; asm volatile("" : "+v"(tid)); const int lane = tid & 63, wid = tid >> 6, fr = lane & 15, fq = lane >> 4;
    const float* convw = p.in[13] + (size_t)l * 4 * 1536;
    LAS float* cwL = (LAS float*)(lds + 137984);
    { const int hh = blockIdx.x & 3; for (int i = tid; i < 1536; i += 512) { const int j = i / 384, c = i % 384; cwL[i] = convw[j * 1536 + (c >> 7) * 512 + hh * 128 + (c & 127)]; } }
    __syncthreads();
    for (int item = blockIdx.x; item < 2080; item += gridDim.x) {
        const int chunk = item >> 2, h = item & 3; const bool samp = chunk >= 512; const int b = samp ? chunk - 512 : chunk >> 6, n = samp ? 0 : (chunk & 63);
        bf16_t* gi = gbuf + (size_t)item * GITEM;
        { u32x4 wv[6];
#pragma unroll
          for (int i = 0; i < 6; ++i) { const int pc = tid + i * 512, r = pc / 48, cp = pc % 48, which = cp >> 4, c8 = (cp & 15) * 8; wv[i] = *(const u32x4*)(gi + which * 8192 + r * 128 + c8); }
#pragma unroll
          for (int i = 0; i < 6; ++i) { const int pc = tid + i * 512, r = pc / 48, cp = pc % 48, which = cp >> 4, c8 = (cp & 15) * 8; *(LAS u32x4*)(raw + (r + 3) * 392 + which * 128 + c8) = wv[i]; }
          if (tid < 144) { const int r = tid / 48, cp = tid % 48, which = cp >> 4, c8 = (cp & 15) * 8; u32x4 w = (u32x4){0u, 0u, 0u, 0u};
            if (n > 0) w = *(const u32x4*)(halo + (size_t)((chunk - 1) * 3 + r) * 1536 + which * 512 + h * 128 + c8);
            else if (samp) { const float* st = p.in[4] + ((size_t)(l * 8 + b) * 3 + r) * 1536 + which * 512 + h * 128 + c8; const f32x4 a = *(const f32x4*)st, bb = *(const f32x4*)(st + 4);
                w.x = cvt_pk_bf16(a[0], a[1]); w.y = cvt_pk_bf16(a[2], a[3]); w.z = cvt_pk_bf16(bb[0], bb[1]); w.w = cvt_pk_bf16(bb[2], bb[3]); }
            *(LAS u32x4*)(raw + r * 392 + which * 128 + c8) = w; } }
        __syncthreads();
        if (samp || n == 63) { float* o = p.out + (samp ? OUT_SAC : OUT_PAC) + (size_t)(l * 8 + b) * 3 * 1536;
            for (int i = tid; i < 3 * 384; i += 512) { const int j = i / 384, c = i % 384, which = c >> 7, d = c & 127; o[j * 1536 + which * 512 + h * 128 + d] = bf2f(raw[(64 + j) * 392 + c]); } }
        { const int row = tid >> 3, cgp = tid & 7;
#pragma unroll 1
          for (int which = 0; which < 3; ++which) { float y[16]; float ss = 0.f;
#pragma unroll
              for (int hf = 0; hf < 2; ++hf) { const int c = cgp * 16 + hf * 8; float a8[8] = {0.f, 0.f, 0.f, 0.f, 0.f, 0.f, 0.f, 0.f};
#pragma unroll
                  for (int j = 0; j < 4; ++j) { float x8[8]; unpack8(*(const LAS u32x4*)(raw + (row + j) * 392 + which * 128 + c), x8); LAS const float* wp = cwL + j * 384 + which * 128 + c; const f32x4 w0 = *(LAS const f32x4*)wp, w1 = *(LAS const f32x4*)(wp + 4);
                      a8[0] += w0[0] * x8[0]; a8[1] += w0[1] * x8[1]; a8[2] += w0[2] * x8[2]; a8[3] += w0[3] * x8[3]; a8[4] += w1[0] * x8[4]; a8[5] += w1[1] * x8[5]; a8[6] += w1[2] * x8[6]; a8[7] += w1[3] * x8[7]; }
#pragma unroll
                  for (int i = 0; i < 8; ++i) { const float v = siluf_(a8[i]); y[hf * 8 + i] = v; ss += v * v; } }
              float sc = 1.0f;
              if (which < 2) { ss += __shfl_xor(ss, 1); ss += __shfl_xor(ss, 2); ss += __shfl_xor(ss, 4); sc = rsqrtf(ss + 1e-6f) * (which == 0 ? 0.08838834764831845f : 1.0f); }
#pragma unroll
              for (int i = 0; i < 16; ++i) y[i] *= sc;
              LAS bf16_t* dst = (which == 0 ? qs : (which == 1 ? ks : vs)) + row * 136 + cgp * 16;
              *(LAS u32x4*)dst = pack8(y); *(LAS u32x4*)(dst + 8) = pack8(y + 8); } }
        if (wid == 0) { const size_t rowg = (size_t)chunk * 64 + lane; const float ab = gates[rowg * 8 + h], aa = gates[rowg * 8 + 4 + h];
            const float beta = sigmoidf_(ab); float g = -__expf(p.in[14][l * 4 + h]) * softplusf_(aa + p.in[15][l * 4 + h]);
#pragma unroll
            for (int o = 1; o < 64; o <<= 1) { const float v = __shfl_up(g, o); if (lane >= o) g += v; }
            gc[lane] = g; gc[64 + lane] = beta; gc[128 + lane] = __expf(g); }
        __syncthreads();
        { const int ti = wid >> 1;
#pragma unroll
          for (int tjj = 0; tjj < 2; ++tjj) { const int tj = (wid & 1) * 2 + tjj;
              f32x4 akk = (f32x4){0.f, 0.f, 0.f, 0.f}, aqk = akk;
              if (tj <= ti) {
#pragma unroll
                  for (int kk = 0; kk < 4; ++kk) { const bf16x8 ak = *(const LAS bf16x8*)(ks + (ti * 16 + fr) * 136 + kk * 32 + fq * 8), aq = *(const LAS bf16x8*)(qs + (ti * 16 + fr) * 136 + kk * 32 + fq * 8), bk = *(const LAS bf16x8*)(ks + (tj * 16 + fr) * 136 + kk * 32 + fq * 8);
                      akk = mfma16(ak, bk, akk); aqk = mfma16(aq, bk, aqk); } }
              f32x4 mrow;
#pragma unroll
              for (int jj = 0; jj < 4; ++jj) { const int i = ti * 16 + fq * 4 + jj, j = tj * 16 + fr; float mval = 0.f, qv = 0.f;
                  if (j <= i) { const float dec = __expf(gc[i] - gc[j]); qv = aqk[jj] * dec; if (j < i) mval = gc[64 + i] * akk[jj] * dec; }
                  mrow[jj] = mval; Mb[i * 72 + j] = (tj < ti) ? f2bf(mval) : (bf16_t)0;
                  gi[32768 + i * 64 + j] = f2bf(qv); }
              if (tj <= ti) *(LAS f32x4*)(Mm + (tj * 16 + fr) * 68 + ti * 16 + fq * 4) = mrow; } }
        __syncthreads();
        if (tid < 64) { int tl_ = tid; asm volatile("" : "+v"(tl_)); const int I = tl_ >> 4, c = tl_ & 15; float x[16];
#pragma unroll
            for (int i = 0; i < 16; ++i) x[i] = (i == c) ? 1.0f : 0.0f;
#pragma unroll
            for (int j = 0; j < 15; ++j) {
#pragma unroll
                for (int q4 = 0; q4 < 4; ++q4) { if (q4 * 4 + 3 <= j) continue; const f32x4 mv = *(const LAS f32x4*)(Mm + (I * 16 + j) * 68 + I * 16 + q4 * 4);
#pragma unroll
                    for (int e = 0; e < 4; ++e) if (q4 * 4 + e > j) x[q4 * 4 + e] -= mv[e] * x[j]; } }
#pragma unroll
            for (int i = 0; i < 16; ++i) { TinvB[(I * 16 + i) * 40 + c] = f2bf(x[i]); TinvB[(I * 16 + i) * 40 + 16 + c] = 0; }
        } else if (tid < 256) { const u32x4 z4 = (u32x4){0u, 0u, 0u, 0u};
            for (int i = tid - 64; i < 3328; i += 192) *(LAS u32x4*)(lds + 84736 + i * 16) = z4;
        } else { const int t2 = tid - 256; const float glast = gc[63];
#pragma unroll
            for (int it = 0; it < 4; ++it) { const int idx = t2 + it * 256, i = idx >> 4, c8 = (idx & 15) * 8; float v[8]; unpack8(*(const LAS u32x4*)(qs + i * 136 + c8), v); const float e = gc[128 + i];
#pragma unroll
                for (int k = 0; k < 8; ++k) v[k] *= e;
                *(u32x4*)(gi + i * 128 + c8) = pack8(v); }
#pragma unroll
            for (int it = 0; it < 4; ++it) { const int idx = t2 + it * 256, d = idx >> 3, i8 = (idx & 7) * 8; float v[8];
#pragma unroll
                for (int k = 0; k < 8; ++k) v[k] = bf2f(ks[(i8 + k) * 136 + d]) * __expf(glast - gc[i8 + k]);
                *(u32x4*)(gi + 8192 + d * 64 + i8) = pack8(v); }
            if (t2 == 0) glb[item] = __expf(glast);
        }
        __syncthreads();
        { int tl2_ = tid; asm volatile("" : "+v"(tl2_)); const int fr = tl2_ & 15, fq = (tl2_ >> 4) & 3, wid = tl2_ >> 6;
#pragma unroll 1
          for (int I = 0; I < 4; ++I) {
              f32x4 racc[2] = {(f32x4){0.f, 0.f, 0.f, 0.f}, (f32x4){0.f, 0.f, 0.f, 0.f}};
              for (int ks2 = 0; ks2 * 32 < I * 16; ++ks2) {
                  const bf16x8 a = *(const LAS bf16x8*)(Mb + (I * 16 + fr) * 72 + ks2 * 32 + fq * 8);
                  const bf16x8 b0 = *(const LAS bf16x8*)(solT + ((wid * 2 + 0) * 16 + fr) * 72 + ks2 * 32 + fq * 8);
                  const bf16x8 b1 = *(const LAS bf16x8*)(solT + ((wid * 2 + 1) * 16 + fr) * 72 + ks2 * 32 + fq * 8);
                  racc[0] = mfma16(a, b0, racc[0]); racc[1] = mfma16(a, b1, racc[1]); }
#pragma unroll
              for (int n2 = 0; n2 < 2; ++n2) { const int col = (wid * 2 + n2) * 16 + fr; float rv[4];
#pragma unroll
                  for (int jj = 0; jj < 4; ++jj) { const int i = I * 16 + fq * 4 + jj; float v = (col < 128 ? bf2f(vs[i * 136 + col]) : bf2f(ks[i * 136 + col - 128]) * gc[128 + i]) * gc[64 + i]; rv[jj] = v - racc[n2][jj]; }
                  u32x2 wv; wv.x = cvt_pk_bf16(rv[0], rv[1]); wv.y = cvt_pk_bf16(rv[2], rv[3]); *(LAS u32x2*)(RT + col * 32 + fq * 4) = wv; }
              __syncthreads();
              { const bf16x8 a = *(const LAS bf16x8*)(TinvB + (I * 16 + fr) * 40 + fq * 8);
                const bf16x8 b0 = *(const LAS bf16x8*)(RT + ((wid * 2 + 0) * 16 + fr) * 32 + fq * 8), b1 = *(const LAS bf16x8*)(RT + ((wid * 2 + 1) * 16 + fr) * 32 + fq * 8);
                f32x4 sv2[2]; sv2[0] = (f32x4){0.f, 0.f, 0.f, 0.f}; sv2[1] = sv2[0];
                sv2[0] = mfma16(a, b0, sv2[0]); sv2[1] = mfma16(a, b1, sv2[1]);
#pragma unroll
                for (int n2 = 0; n2 < 2; ++n2) { const int col = (wid * 2 + n2) * 16 + fr;
                    float s4[4] = {sv2[n2][0] + 0.f, sv2[n2][1] + 0.f, sv2[n2][2] + 0.f, sv2[n2][3] + 0.f};
                    u32x2 wv; wv.x = cvt_pk_bf16(s4[0], s4[1]); wv.y = cvt_pk_bf16(s4[2], s4[3]);
                    *(LAS u32x2*)(solT + col * 72 + I * 16 + fq * 4) = wv;
                    if (col < 128) *(u32x2*)(gi + 16384 + col * 64 + I * 16 + fq * 4) = wv;
                    else {
#pragma unroll
                        for (int jj = 0; jj < 4; ++jj) gi[24576 + (I * 16 + fq * 4 + jj) * 128 + (col - 128)] = f2bf(s4[jj]); } } }
              __syncthreads(); } }
    }
}

__device__ __forceinline__ void hgrn_prep(const Params& p, int l, LAS unsigned char* lds) {
    unsigned char* ws = p.ws;
    bf16_t* hbuf = (bf16_t*)(ws + R_HBUF); float* eh = (float*)(ws + W_EH);
    LAS bf16_t* qt = (LAS bf16_t*)lds;
    LAS bf16_t* kt = qt + 64 * 72;
    LAS float* tot = (LAS float*)(lds + 2 * 64 * 72 * 2);
    LAS bf16_t* sq = (LAS bf16_t*)(lds + 20480);
    LAS bf16_t* sf = sq + 64 * 72; LAS bf16_t* si = sf + 64 * 72;
    int tid = threadIdx.x; asm volatile("" : "+v"(tid)); const int lane = tid & 63, wid = tid >> 6, fr = lane & 15, fq = lane >> 4;
    for (;;) {
        { volatile LAS unsigned* qw = (volatile LAS unsigned*)(lds + LDS_BYTES - 32);
          if (tid == 0) *qw = __hip_atomic_fetch_add((unsigned*)(ws + W_QCTR) + l * 2 + 1, 1u, __ATOMIC_RELAXED, __HIP_MEMORY_SCOPE_AGENT);
          __syncthreads(); }
        const int item = (int)*(volatile LAS unsigned*)(lds + LDS_BYTES - 32);
        if (item >= 2080) break;
        const int h = item & 3; bf16_t* hi = hbuf + (size_t)item * HITEM;
        { const int t_ = tid >> 3, d8 = (tid & 7) * 8; const u32x4 va = *(const u32x4*)(hi + t_ * 64 + d8), vb = *(const u32x4*)(hi + 4096 + t_ * 64 + d8), vc = *(const u32x4*)(hi + 8192 + t_ * 64 + d8);
          *(LAS u32x4*)(sq + t_ * 72 + d8) = va; *(LAS u32x4*)(sf + t_ * 72 + d8) = vb; *(LAS u32x4*)(si + t_ * 72 + d8) = vc; }
        __syncthreads();
        const int d = tid & 63, seg = tid >> 6;
        float lb = 0.f; if (l == 1) lb = sigmoidf_(p.in[24][256 + h * 64 + d] - p.in[24][h * 64 + d]);
        float qc[8], kf[8], bc[8], vv[8]; float run = 0.f;
#pragma unroll
        for (int i = 0; i < 8; ++i) { const int t = seg * 8 + i; const float cq = bf2f(sq[t * 72 + d]), cf = bf2f(sf[t * 72 + d]); vv[i] = bf2f(si[t * 72 + d]);
            qc[i] = siluf_(cq); const float f = lb + (1.0f - lb) * sigmoidf_(cf); kf[i] = 1.0f - f; run += __logf(f); bc[i] = run; }
        tot[seg * 64 + d] = run;
        asm volatile("s_waitcnt vmcnt(0)" ::: "memory");
        __syncthreads();
        float pre = 0.f, ref = 0.f, all = 0.f;
#pragma unroll
        for (int s = 0; s < 8; ++s) { const float tv = tot[s * 64 + d]; if (s < seg) pre += tv; if (s < 4) ref += tv; all += tv; }
        { float qh8[8], kh8[8];
#pragma unroll
          for (int i = 0; i < 8; ++i) { const int t = seg * 8 + i; const float bct = pre + bc[i];
              qt[t * 72 + d] = f2bf(qc[i] * __expf(bct - ref)); kt[t * 72 + d] = f2bf(kf[i] * __expf(ref - bct));
              qh8[i] = qc[i] * __expf(bct); kh8[i] = kf[i] * __expf(all - bct); }
#pragma unroll
          for (int i = 0; i < 8; ++i) sq[(seg * 8 + i) * 72 + d] = f2bf(qh8[i]);
          *(u32x4*)(hi + 4096 + d * 64 + seg * 8) = pack8(kh8);
          *(u32x4*)(hi + 8192 + d * 64 + seg * 8) = pack8(vv);
          if (seg == 0) eh[(size_t)item * 64 + d] = __expf(all); }
        __syncthreads();
        { const int t_ = tid >> 3, d8 = (tid & 7) * 8; *(u32x4*)(hi + t_ * 64 + d8) = *(const LAS u32x4*)(sq + t_ * 72 + d8); }
        { const int ti = wid >> 1;
#pragma unroll
          for (int tjj = 0; tjj < 2; ++tjj) { const int tj = (wid & 1) * 2 + tjj; f32x4 a = (f32x4){0.f, 0.f, 0.f, 0.f};
              if (tj <= ti) {
#pragma unroll
                  for (int kk = 0; kk < 2; ++kk) a = mfma16(*(const LAS bf16x8*)(qt + (ti * 16 + fr) * 72 + kk * 32 + fq * 8), *(const LAS bf16x8*)(kt + (tj * 16 + fr) * 72 + kk * 32 + fq * 8), a); }
#pragma unroll
              for (int jj = 0; jj < 4; ++jj) { const int i = ti * 16 + fq * 4 + jj, j = tj * 16 + fr; sf[i * 72 + j] = f2bf(j <= i ? a[jj] : 0.f); } } }
        __syncthreads();
        { const int t_ = tid >> 3, d8 = (tid & 7) * 8; *(u32x4*)(hi + 12288 + t_ * 64 + d8) = *(const LAS u32x4*)(sf + t_ * 72 + d8); }
    }
    __syncthreads();
}

__device__ __forceinline__ void rg_prep(const Params& p, int l, LAS unsigned char* lds) {
    unsigned char* ws = p.ws;
    const bf16_t* bx = (const bf16_t*)(ws + R_BX); bf16_t* hloc = (bf16_t*)(ws + R_HLOC); bf16_t* pcum = (bf16_t*)(ws + R_PCUM); float* sumA = (float*)(ws + W_SUMA); float* sumH = (float*)(ws + W_SUMH);
    LAS bf16_t* xs = (LAS bf16_t*)lds;
    LAS bf16_t* wT = (LAS bf16_t*)(lds + 64 * 264 * 2);

    int tid = threadIdx.x; asm volatile("" : "+v"(tid)); const int lane = tid & 63, wid = tid >> 6, fr = lane & 15, fq = lane >> 4;
    const float* cw = p.in[17] + (size_t)l * 4 * 256; const float* cb = p.in[18] + l * 256;
    for (int idx = tid; idx < 32768; idx += 512) { const int g = idx >> 14, nb = (idx >> 12) & 3, i = (idx >> 6) & 63, j = idx & 63; const float v = (g ? p.in[21] : p.in[19])[(size_t)l * 16384 + nb * 4096 + i * 64 + j];
        wT[((g * 4 + nb) * 64 + j) * 72 + i] = f2bf(v); }
    for (;;) {
        { volatile LAS unsigned* qw = (volatile LAS unsigned*)(lds + LDS_BYTES - 32);
          __syncthreads();
          if (tid == 0) *qw = __hip_atomic_fetch_add((unsigned*)(ws + W_QCTR) + l * 2, 1u, __ATOMIC_RELAXED, __HIP_MEMORY_SCOPE_AGENT);
          __syncthreads(); }
        const int chunk = (int)*(volatile LAS unsigned*)(lds + LDS_BYTES - 32);
        if (chunk >= NCHUNK) break;
        const bool samp = chunk >= 512; const int b = samp ? chunk - 512 : chunk >> 6, n = samp ? 0 : (chunk & 63);
        __syncthreads();
        { const int row = tid >> 3, cgp = tid & 7;
#pragma unroll
          for (int q8 = 0; q8 < 4; ++q8) { const int c = cgp * 32 + q8 * 8; float a8[8];
              { const f32x4 b0 = *(const f32x4*)(cb + c), b1 = *(const f32x4*)(cb + c + 4); a8[0] = b0[0]; a8[1] = b0[1]; a8[2] = b0[2]; a8[3] = b0[3]; a8[4] = b1[0]; a8[5] = b1[1]; a8[6] = b1[2]; a8[7] = b1[3]; }
#pragma unroll
              for (int j = 0; j < 4; ++j) { const int rr = row - 3 + j; float x8[8] = {0.f, 0.f, 0.f, 0.f, 0.f, 0.f, 0.f, 0.f};
                  if (rr >= 0 || n > 0) unpack8(*(const u32x4*)(bx + ((size_t)chunk * 64 + rr) * 256 + c), x8);
                  else if (samp) { const float* st = p.in[6] + ((size_t)(l * 8 + b) * 3 + (3 + rr)) * 256 + c; const f32x4 s0 = *(const f32x4*)st, s1 = *(const f32x4*)(st + 4); x8[0] = s0[0]; x8[1] = s0[1]; x8[2] = s0[2]; x8[3] = s0[3]; x8[4] = s1[0]; x8[5] = s1[1]; x8[6] = s1[2]; x8[7] = s1[3]; }
                  const f32x4 w0 = *(const f32x4*)(cw + j * 256 + c), w1 = *(const f32x4*)(cw + j * 256 + c + 4);
                  a8[0] += w0[0] * x8[0]; a8[1] += w0[1] * x8[1]; a8[2] += w0[2] * x8[2]; a8[3] += w0[3] * x8[3]; a8[4] += w1[0] * x8[4]; a8[5] += w1[1] * x8[5]; a8[6] += w1[2] * x8[6]; a8[7] += w1[3] * x8[7]; }
              *(LAS u32x4*)(xs + row * 264 + c) = pack8(a8); } }
        if (samp || n == 63) { float* o = p.out + (samp ? OUT_SBC : OUT_PBC) + (size_t)(l * 8 + b) * 3 * 256;
            for (int i = tid; i < 768; i += 512) { const int j = i >> 8, c = i & 255; o[j * 256 + c] = bf2f(bx[((size_t)chunk * 64 + 61 + j) * 256 + c]); } }
        __syncthreads();
#pragma unroll 1
        for (int pp = 0; pp < 2; ++pp) { const int pair = wid * 2 + pp, nb = pair >> 2, tj = pair & 3, ch = nb * 64 + tj * 16 + fr;
            LAS bf16_t* hbL = (LAS bf16_t*)(lds + 107520) + wid * 2048; LAS bf16_t* pbL = hbL + 1024;
            const float br = p.in[20][l * 256 + ch], bi = p.in[22][l * 256 + ch], sp = softplusf_(-p.in[23][l * 256 + ch]);
            float Ac = 1.0f, Hc = 0.0f;
#pragma unroll 1
            for (int ti = 0; ti < 4; ++ti) { f32x4 ar = (f32x4){0.f, 0.f, 0.f, 0.f}, aig = ar;
#pragma unroll
                for (int kk = 0; kk < 2; ++kk) { const bf16x8 a = *(const LAS bf16x8*)(xs + (ti * 16 + fr) * 264 + nb * 64 + kk * 32 + fq * 8);
                    ar = mfma16(a, *(const LAS bf16x8*)(wT + ((0 * 4 + nb) * 64 + tj * 16 + fr) * 72 + kk * 32 + fq * 8), ar);
                    aig = mfma16(a, *(const LAS bf16x8*)(wT + ((1 * 4 + nb) * 64 + tj * 16 + fr) * 72 + kk * 32 + fq * 8), aig); }
                float Aj[4], Hj[4]; float Ar = 1.0f, Hr = 0.0f;
#pragma unroll
                for (int jj = 0; jj < 4; ++jj) { const int tok = ti * 16 + fq * 4 + jj; const float r = sigmoidf_(ar[jj] + br), ig = sigmoidf_(aig[jj] + bi); const float la = -8.0f * r * sp; const float a = __expf(la);
                    const float mult = sqrtf(fmaxf(1.0f - __expf(2.0f * la), 0.0f)); const float uu = mult * ig * bf2f(xs[tok * 264 + ch]);
                    Hr = a * Hr + uu; Ar = a * Ar; Aj[jj] = Ar; Hj[jj] = Hr; }
                float Ap = Ac, Hp = Hc;
#pragma unroll
                for (int qd = 0; qd < 4; ++qd) { const float Aq = __shfl(Ar, qd * 16 + fr), Hq = __shfl(Hr, qd * 16 + fr);
                    if (qd < fq) { Hp = Aq * Hp + Hq; Ap = Aq * Ap; }
                    Hc = Aq * Hc + Hq; Ac = Aq * Ac; }
#pragma unroll
                for (int jj = 0; jj < 4; ++jj) { const int tl = ti * 16 + fq * 4 + jj; hbL[tl * 16 + fr] = f2bf(Hj[jj] + Aj[jj] * Hp); pbL[tl * 16 + fr] = f2bf(Aj[jj] * Ap); } }
#pragma unroll
            for (int r2 = 0; r2 < 2; ++r2) { const int idx = lane + r2 * 64, tok = idx >> 1, hf = idx & 1; const size_t o = ((size_t)chunk * 64 + tok) * 256 + nb * 64 + tj * 16 + hf * 8;
                *(u32x4*)(hloc + o) = *(const LAS u32x4*)(hbL + tok * 16 + hf * 8); *(u32x4*)(pcum + o) = *(const LAS u32x4*)(pbL + tok * 16 + hf * 8); }
            if (fq == 0) { sumA[(size_t)chunk * 256 + ch] = Ac; sumH[(size_t)chunk * 256 + ch] = Hc; } }
    }
    __syncthreads();
}

__device__ __forceinline__ void rg_apply_chunk(const Params& p, int l, int chunk) {
    unsigned char* ws = p.ws; bf16_t* zbuf = (bf16_t*)(ws + R_ZBUF);
    const bf16_t* hloc = (const bf16_t*)(ws + R_HLOC); const bf16_t* pcum = (const bf16_t*)(ws + R_PCUM); const float* sumA = (const float*)(ws + W_SUMA); const float* sumH = (const float*)(ws + W_SUMH);
    int tid = threadIdx.x; asm volatile("" : "+v"(tid));
    const bool samp = chunk >= 512; const int b = samp ? chunk - 512 : chunk >> 6, n = samp ? 0 : (chunk & 63);
    { const int ch = tid & 255, half = tid >> 8;
            float hin = samp ? p.in[7][(size_t)(l * 8 + b) * 256 + ch] : 0.f;
            for (int m = 0; m < n; ++m) { const size_t o = (size_t)(chunk - n + m) * 256 + ch; hin = sumA[o] * hin + sumH[o]; }
#pragma unroll 1
            for (int t0 = half * 32; t0 < half * 32 + 32; t0 += 8) { float hl[8], pc8[8], zg[8];
#pragma unroll
                for (int i = 0; i < 8; ++i) { const size_t row = (size_t)chunk * 64 + t0 + i; hl[i] = bf2f(hloc[row * 256 + ch]); pc8[i] = bf2f(pcum[row * 256 + ch]); zg[i] = bf2f(zbuf[row * 1024 + 512 + ch]); }
#pragma unroll
                for (int i = 0; i < 8; ++i) { const size_t row = (size_t)chunk * 64 + t0 + i; const float hv = hl[i] + pc8[i] * hin; zbuf[row * 1024 + 512 + ch] = f2bf(hv * gelu_tanh(zg[i]));
                    if (t0 + i == 63 && (samp || n == 63)) p.out[(samp ? OUT_SBH : OUT_PBH) + (size_t)(l * 8 + b) * 256 + ch] = hv; } }
    }
}

constexpr size_t OBUF_H_OFF = 2080ull * 8192;
static_assert((OBUF_H_OFF + 2080ull * 4096) * 2 <= (size_t)T_ALL * 1024 * 4, "o buffers must fit in the y region");
__device__ __forceinline__ void gdn_scan(const Params& p, int l, int seq, int h, int slice, LAS unsigned char* lds) {
    unsigned char* ws = p.ws; const bf16_t* gbuf = (const bf16_t*)(ws + R_GBUF); const float* glb = (const float*)(ws + W_GL); bf16_t* obuf = (bf16_t*)(p.out + OUT_Y);
    LAS bf16_t* StL = (LAS bf16_t*)lds;
    LAS bf16_t* VtL = StL + 32 * 136;
    int tid = threadIdx.x; asm volatile("" : "+v"(tid)); const int lane = tid & 63, w = tid >> 6, fr = lane & 15, fq = lane >> 4, mt = w & 3;
    const bool samp = seq >= 8; const int b = seq & 7; const int nsteps = samp ? 1 : 64, chunk0 = samp ? 512 + b : b * 64;
    f32x4 S[2];
#pragma unroll
    for (int nt = 0; nt < 2; ++nt) { S[nt] = (f32x4){0.f, 0.f, 0.f, 0.f};
        if (samp) { const float* s0 = p.in[5] + ((size_t)((l * 8 + b) * 4 + h)) * 16384;
#pragma unroll
            for (int jj = 0; jj < 4; ++jj) S[nt][jj] = s0[(w * 16 + fq * 4 + jj) * 128 + slice * 32 + nt * 16 + fr]; } }
#define GDN_LOAD(A_, KD_, QK_, UU_, GL_, item_) do { const bf16_t* gi_ = gbuf + (size_t)(item_) * GITEM; const bf16_t* Ab_ = gi_ + (w < 4 ? 24576 : 0) + (mt * 16 + fr) * 128 + fq * 8; \
        _Pragma("unroll") for (int kk = 0; kk < 4; ++kk) A_[kk] = *(const bf16x8*)(Ab_ + kk * 32); \
        _Pragma("unroll") for (int kk = 0; kk < 2; ++kk) KD_[kk] = *(const bf16x8*)(gi_ + 8192 + (w * 16 + fr) * 64 + kk * 32 + fq * 8); \
        if (w >= 4) { _Pragma("unroll") for (int kk = 0; kk < 2; ++kk) QK_[kk] = *(const bf16x8*)(gi_ + 32768 + (mt * 16 + fr) * 64 + kk * 32 + fq * 8); } \
        else { _Pragma("unroll") for (int nt = 0; nt < 2; ++nt) UU_[nt] = *(const u32x2*)(gi_ + 16384 + (slice * 32 + nt * 16 + fr) * 64 + mt * 16 + fq * 4); } \
        GL_ = glb[item_]; } while (0)
    bf16x8 ca[4], ckd[2], cqk[2] = {}; u32x2 cuu[2] = {}; float cgl;
    bf16x8 ma[4], mkd[2], mqk[2] = {}; u32x2 muu[2] = {}; float mgl;
    GDN_LOAD(ca, ckd, cqk, cuu, cgl, chunk0 * 4 + h);
    { const int it1 = (nsteps > 1) ? (chunk0 + 1) * 4 + h : chunk0 * 4 + h; GDN_LOAD(ma, mkd, mqk, muu, mgl, it1); }
    for (int step = 0; step < nsteps; ++step) {
        const int item = (chunk0 + step) * 4 + h;
        bf16x8 na[4], nkd[2], nqk[2] = {}; u32x2 nuu[2] = {}; float ngl;
        { const int nit = (step + 2 < nsteps) ? item + 8 : item; GDN_LOAD(na, nkd, nqk, nuu, ngl, nit); }
#pragma unroll
        for (int nt = 0; nt < 2; ++nt) { u32x2 wv; wv.x = cvt_pk_bf16(S[nt][0], S[nt][1]); wv.y = cvt_pk_bf16(S[nt][2], S[nt][3]); *(LAS u32x2*)(StL + (nt * 16 + fr) * 136 + w * 16 + fq * 4) = wv; }
        __syncthreads();
        f32x4 acc[2] = {(f32x4){0.f, 0.f, 0.f, 0.f}, (f32x4){0.f, 0.f, 0.f, 0.f}};
#pragma unroll
        for (int kk = 0; kk < 4; ++kk)
#pragma unroll
            for (int nt = 0; nt < 2; ++nt) acc[nt] = mfma16(ca[kk], *(const LAS bf16x8*)(StL + (nt * 16 + fr) * 136 + kk * 32 + fq * 8), acc[nt]);
        if (w < 4) {
#pragma unroll
            for (int nt = 0; nt < 2; ++nt) { const u32x2 uw = cuu[nt];
                u32x2 vw; vw.x = cvt_pk_bf16(lo_bf(uw.x) - acc[nt][0], hi_bf(uw.x) - acc[nt][1]); vw.y = cvt_pk_bf16(lo_bf(uw.y) - acc[nt][2], hi_bf(uw.y) - acc[nt][3]);
                *(LAS u32x2*)(VtL + (nt * 16 + fr) * 72 + mt * 16 + fq * 4) = vw; } }
        __syncthreads();
        bf16x8 vB[2][2];
#pragma unroll
        for (int nt = 0; nt < 2; ++nt)
#pragma unroll
            for (int kk = 0; kk < 2; ++kk) vB[nt][kk] = *(const LAS bf16x8*)(VtL + (nt * 16 + fr) * 72 + kk * 32 + fq * 8);
        if (w >= 4) {
#pragma unroll
            for (int kk = 0; kk < 2; ++kk)
#pragma unroll
                for (int nt = 0; nt < 2; ++nt) acc[nt] = mfma16(cqk[kk], vB[nt][kk], acc[nt]);
#pragma unroll
            for (int nt = 0; nt < 2; ++nt) { u32x2 ow; ow.x = cvt_pk_bf16(acc[nt][0], acc[nt][1]); ow.y = cvt_pk_bf16(acc[nt][2], acc[nt][3]);
                *(u32x2*)(obuf + (size_t)item * 8192 + (slice * 32 + nt * 16 + fr) * 64 + mt * 16 + fq * 4) = ow; } }
#pragma unroll
        for (int nt = 0; nt < 2; ++nt) S[nt] *= cgl;
#pragma unroll
        for (int kk = 0; kk < 2; ++kk)
#pragma unroll
            for (int nt = 0; nt < 2; ++nt) S[nt] = mfma16(ckd[kk], vB[nt][kk], S[nt]);
#pragma unroll
        for (int kk = 0; kk < 4; ++kk) { ca[kk] = ma[kk]; ma[kk] = na[kk]; }
#pragma unroll
        for (int kk = 0; kk < 2; ++kk) { ckd[kk] = mkd[kk]; cqk[kk] = mqk[kk]; cuu[kk] = muu[kk]; mkd[kk] = nkd[kk]; mqk[kk] = nqk[kk]; muu[kk] = nuu[kk]; }
        cgl = mgl; mgl = ngl;
    }
    float* so = p.out + (samp ? OUT_SAS : OUT_PAS) + ((size_t)((l * 8 + b) * 4 + h)) * 16384;
#pragma unroll
    for (int nt = 0; nt < 2; ++nt)
#pragma unroll
        for (int jj = 0; jj < 4; ++jj) so[(w * 16 + fq * 4 + jj) * 128 + slice * 32 + nt * 16 + fr] = S[nt][jj];
    __syncthreads();
}
__device__ __forceinline__ void hgrn_scan(const Params& p, int l, int seq, int h, int slice, LAS unsigned char* lds) {
    unsigned char* ws = p.ws; const bf16_t* hbuf = (const bf16_t*)(ws + R_HBUF); const float* eh = (const float*)(ws + W_EH); bf16_t* obuf = (bf16_t*)(p.out + OUT_Y) + OBUF_H_OFF;
    int tid = threadIdx.x; asm volatile("" : "+v"(tid)); const int lane = tid & 63, w = tid >> 6, fr = lane & 15, fq = lane >> 4, wd = w & 3;
    const bool samp = seq >= 8; const int b = seq & 7; const int nsteps = samp ? 1 : 64, chunk0 = samp ? 512 + b : b * 64;
    f32x4 S = (f32x4){0.f, 0.f, 0.f, 0.f};
    if (samp) { const float* s0 = p.in[8] + ((size_t)((l * 8 + b) * 4 + h)) * 4096;
#pragma unroll
        for (int jj = 0; jj < 4; ++jj) S[jj] = s0[(wd * 16 + fq * 4 + jj) * 64 + slice * 16 + fr]; }
#define HG_LOAD(QA_, AT_, KH_, VB_, EV_, item_) do { const bf16_t* hi_ = hbuf + (size_t)(item_) * HITEM; \
        _Pragma("unroll") for (int kk = 0; kk < 2; ++kk) VB_[kk] = *(const bf16x8*)(hi_ + 8192 + (slice * 16 + fr) * 64 + kk * 32 + fq * 8); \
        if (w >= 4) { _Pragma("unroll") for (int kk = 0; kk < 2; ++kk) { QA_[kk] = *(const bf16x8*)(hi_ + (wd * 16 + fr) * 64 + kk * 32 + fq * 8); AT_[kk] = *(const bf16x8*)(hi_ + 12288 + (wd * 16 + fr) * 64 + kk * 32 + fq * 8); } } \
        else { _Pragma("unroll") for (int kk = 0; kk < 2; ++kk) KH_[kk] = *(const bf16x8*)(hi_ + 4096 + (wd * 16 + fr) * 64 + kk * 32 + fq * 8); \
            EV_ = *(const f32x4*)(eh + (size_t)(item_) * 64 + wd * 16 + fq * 4); } } while (0)
    bf16x8 cqa[2] = {}, cat[2] = {}, ckh[2] = {}, cvb[2]; f32x4 cev = (f32x4){0.f, 0.f, 0.f, 0.f};
    bf16x8 mqa[2] = {}, mat[2] = {}, mkh[2] = {}, mvb[2]; f32x4 mev = (f32x4){0.f, 0.f, 0.f, 0.f};
    HG_LOAD(cqa, cat, ckh, cvb, cev, chunk0 * 4 + h);
    { const int it1 = (nsteps > 1) ? (chunk0 + 1) * 4 + h : chunk0 * 4 + h; HG_LOAD(mqa, mat, mkh, mvb, mev, it1); }
    for (int step = 0; step < nsteps; ++step) {
        const int item = (chunk0 + step) * 4 + h;
        bf16x8 nqa[2] = {}, nat[2] = {}, nkh[2] = {}, nvb[2]; f32x4 nev = (f32x4){0.f, 0.f, 0.f, 0.f};
        { const int nit = (step + 2 < nsteps) ? item + 8 : item; HG_LOAD(nqa, nat, nkh, nvb, nev, nit); }
        LAS bf16_t* StL = (LAS bf16_t*)lds + (step & 1) * (16 * 72);
        if (w < 4) { u32x2 wv; wv.x = cvt_pk_bf16(S[0], S[1]); wv.y = cvt_pk_bf16(S[2], S[3]); *(LAS u32x2*)(StL + fr * 72 + w * 16 + fq * 4) = wv; }
        __syncthreads();
        if (w >= 4) { f32x4 o = (f32x4){0.f, 0.f, 0.f, 0.f};
#pragma unroll
            for (int kk = 0; kk < 2; ++kk) o = mfma16(cqa[kk], *(const LAS bf16x8*)(StL + fr * 72 + kk * 32 + fq * 8), o);
#pragma unroll
            for (int kk = 0; kk < 2; ++kk) o = mfma16(cat[kk], cvb[kk], o);
            u32x2 ow; ow.x = cvt_pk_bf16(o[0], o[1]); ow.y = cvt_pk_bf16(o[2], o[3]); *(u32x2*)(obuf + (size_t)item * 4096 + (slice * 16 + fr) * 64 + wd * 16 + fq * 4) = ow;
        } else { S = S * cev;
#pragma unroll
            for (int kk = 0; kk < 2; ++kk) S = mfma16(ckh[kk], cvb[kk], S); }
#pragma unroll
        for (int kk = 0; kk < 2; ++kk) { cqa[kk] = mqa[kk]; cat[kk] = mat[kk]; ckh[kk] = mkh[kk]; cvb[kk] = mvb[kk]; mqa[kk] = nqa[kk]; mat[kk] = nat[kk]; mkh[kk] = nkh[kk]; mvb[kk] = nvb[kk]; }
        cev = mev; mev = nev;
    }
    if (w < 4) { float* so = p.out + (samp ? OUT_SCS : OUT_PCS) + ((size_t)((l * 8 + b) * 4 + h)) * 4096;
#pragma unroll
        for (int jj = 0; jj < 4; ++jj) so[(w * 16 + fq * 4 + jj) * 64 + slice * 16 + fr] = S[jj]; }
    __syncthreads();
}
__device__ __forceinline__ void scan_phase(const Params& p, int l, LAS unsigned char* lds) {
    for (int x = blockIdx.x; x < 256; x += gridDim.x) {
        const int y = x & 127, xcd = y & 7, r = y >> 3, chain = xcd * 4 + (r >> 2), slice = r & 3, b = chain >> 2, h = chain & 3;
        if (x < 128) {
#pragma unroll 1
            for (int sq = 0; sq < 2; ++sq) gdn_scan(p, l, sq * 8 + b, h, slice, lds); }
        else {
#pragma unroll 1
            for (int sq = 0; sq < 2; ++sq) hgrn_scan(p, l, sq * 8 + b, h, slice, lds);
#pragma unroll 1
            for (int chunk = x - 128; chunk < NCHUNK; chunk += 128) rg_apply_chunk(p, l, chunk); }
    }
}

__device__ __forceinline__ void apply_phase(const Params& p, int l, LAS unsigned char* lds) {
    unsigned char* ws = p.ws;
    const bf16_t* gbuf = (const bf16_t*)(ws + R_GBUF); const bf16_t* hbuf = (const bf16_t*)(ws + R_HBUF); bf16_t* zbuf = (bf16_t*)(ws + R_ZBUF);
    const bf16_t* hloc = (const bf16_t*)(ws + R_HLOC); const bf16_t* pcum = (const bf16_t*)(ws + R_PCUM); const float* sumA = (const float*)(ws + W_SUMA); const float* sumH = (const float*)(ws + W_SUMH);
    LAS bf16_t* ot = (LAS bf16_t*)lds;
    int tid = threadIdx.x; asm volatile("" : "+v"(tid));
    for (int it = blockIdx.x; it < NCHUNK * 8; it += gridDim.x) {
        const int chunk = it >> 3, sub = it & 7; const bool samp = chunk >= 512; const int b = samp ? chunk - 512 : chunk >> 6, n = samp ? 0 : (chunk & 63);
        if (sub < 4) { const int h = sub; const bf16_t* oT = (const bf16_t*)(p.out + OUT_Y) + (size_t)(chunk * 4 + h) * 8192;
            __syncthreads();
#pragma unroll
            for (int i = 0; i < 2; ++i) { const int pc = tid + i * 512, dv = pc >> 3, t8 = (pc & 7) * 8; *(LAS u32x4*)(ot + dv * 72 + t8) = *(const u32x4*)(oT + dv * 64 + t8); }
            __syncthreads();
            const int tok = tid >> 3, cgp = tid & 7; float v[16]; float ss = 0.f;
#pragma unroll
            for (int i = 0; i < 16; ++i) { v[i] = bf2f(ot[(cgp * 16 + i) * 72 + tok]); ss += v[i] * v[i]; }
            ss += __shfl_xor(ss, 1); ss += __shfl_xor(ss, 2); ss += __shfl_xor(ss, 4);
            const float rn = rsqrtf(ss * (1.0f / 128.0f) + EPS);
            bf16_t* zp = zbuf + ((size_t)chunk * 64 + tok) * 1024 + h * 128 + cgp * 16; const float* an = p.in[16] + l * 128 + cgp * 16;
            float z[16]; unpack8(*(const u32x4*)zp, z); unpack8(*(const u32x4*)(zp + 8), z + 8);
#pragma unroll
            for (int i = 0; i < 16; ++i) v[i] = v[i] * rn * an[i] * siluf_(z[i]);
            *(u32x4*)zp = pack8(v); *(u32x4*)(zp + 8) = pack8(v + 8);
        } else if (sub < 8) { const int h = sub - 4; const bf16_t* oT = (const bf16_t*)(p.out + OUT_Y) + OBUF_H_OFF + (size_t)(chunk * 4 + h) * 4096;
            __syncthreads();
            { const int dv = tid >> 3, t8 = (tid & 7) * 8; *(LAS u32x4*)(ot + dv * 72 + t8) = *(const u32x4*)(oT + dv * 64 + t8); }
            __syncthreads();
            const int tok = tid >> 3, cgp = tid & 7; float v[8]; float ss = 0.f;
#pragma unroll
            for (int i = 0; i < 8; ++i) { v[i] = bf2f(ot[(cgp * 8 + i) * 72 + tok]); ss += v[i] * v[i]; }
            ss += __shfl_xor(ss, 1); ss += __shfl_xor(ss, 2); ss += __shfl_xor(ss, 4);
            const float rn = rsqrtf(ss * (1.0f / 64.0f) + EPS);
            bf16_t* zp = zbuf + ((size_t)chunk * 64 + tok) * 1024 + 768 + h * 64 + cgp * 8; const float* cn = p.in[25] + l * 64 + cgp * 8;
            float z[8]; unpack8(*(const u32x4*)zp, z);
#pragma unroll
            for (int i = 0; i < 8; ++i) v[i] = v[i] * rn * cn[i] * siluf_(z[i]);
            *(u32x4*)zp = pack8(v);
        }
    }
    __syncthreads();
}

__device__ __forceinline__ void attn_phase(const Params& p, int l, LAS unsigned char* lds) {
    unsigned char* ws = p.ws;
    const bf16_t* qbuf = (const bf16_t*)(ws + R_QBUF); bf16_t* oatt = (bf16_t*)(ws + R_OATT);
    int tid = threadIdx.x; asm volatile("" : "+v"(tid)); const int lane = tid & 63, w = tid >> 6, fr = lane & 15, fq = lane >> 4;
    for (int item = blockIdx.x; item < 1056; item += gridDim.x) {
        int row0, seq, h, nw;
        if (item < 1024) { const int tile = item >> 2; h = item & 3; row0 = tile * 128; seq = row0 >> 12; nw = 8; }
        else { const int i2 = item - 1024; seq = 8 + (i2 >> 2); h = i2 & 3; row0 = T_P + (i2 >> 2) * 64; nw = 4; }
        const bf16_t* Kp = (const bf16_t*)(ws + W_KB) + (size_t)(l * 16 + seq) * 256 * 1024 + h * 256;
        const bf16_t* Vp = (const bf16_t*)(ws + W_VT) + (size_t)((l * 16 + seq) * 4 + h) * 65536;
        const bool active = w < nw;
        const int qrow = row0 + (active ? w : 0) * 16 + fr;
        bf16x8 qB[8];
#pragma unroll
        for (int kk = 0; kk < 8; ++kk) qB[kk] = *(const bf16x8*)(qbuf + (size_t)qrow * 1024 + h * 256 + kk * 32 + fq * 8);
        f32x4 sacc[16];
#pragma unroll
        for (int i = 0; i < 16; ++i) sacc[i] = (f32x4){0.f, 0.f, 0.f, 0.f};
        bf16x8 pk[8]; float inv = 0.f;
        u32x4 stA[4], stB[4];
#pragma unroll
        for (int i = 0; i < 4; ++i) { const int idx = tid + i * 512, r = idx >> 5, c8 = (idx & 31) * 8; stA[i] = *(const u32x4*)(Kp + (size_t)r * 1024 + c8); stB[i] = *(const u32x4*)(Kp + (size_t)(64 + r) * 1024 + c8); }
        __syncthreads();
        auto round = [&](auto R8c) __attribute__((always_inline)) {
            constexpr int r8 = decltype(R8c)::value;
            LAS bf16_t* buf = (LAS bf16_t*)(lds + (r8 & 1) * 33792);
#pragma unroll
            for (int i = 0; i < 4; ++i) { const int idx = tid + i * 512, r = idx >> 5, c8 = (idx & 31) * 8; *(LAS u32x4*)(buf + r * 264 + c8) = (r8 & 1) ? stB[i] : stA[i]; }
            __syncthreads();
            if constexpr (r8 < 6) { constexpr int nr = r8 + 2;
#pragma unroll
                for (int i = 0; i < 4; ++i) { const int idx = tid + i * 512, r = idx >> 5, c8 = (idx & 31) * 8;
                    const u32x4 v = nr < 4 ? *(const u32x4*)(Kp + (size_t)(nr * 64 + r) * 1024 + c8) : *(const u32x4*)(Vp + (size_t)((nr - 4) * 64 + r) * 256 + c8);
                    if (r8 & 1) stB[i] = v; else stA[i] = v; } }
            if (active) {
                if constexpr (r8 < 4) {
#pragma unroll
                    for (int mt = 0; mt < 4; ++mt)
#pragma unroll
                        for (int kk = 0; kk < 8; ++kk) sacc[r8 * 4 + mt] = mfma16(*(const LAS bf16x8*)(buf + (mt * 16 + fr) * 264 + kk * 32 + fq * 8), qB[kk], sacc[r8 * 4 + mt]);
                    if constexpr (r8 == 3) { float mx = -3.0e38f;
#pragma unroll
                        for (int i = 0; i < 16; ++i) mx = fmaxf(mx, fmaxf(fmaxf(sacc[i][0], sacc[i][1]), fmaxf(sacc[i][2], sacc[i][3])));
                        mx = fmaxf(mx, __shfl_xor(mx, 16)); mx = fmaxf(mx, __shfl_xor(mx, 32));
                        float sm = 0.f;
#pragma unroll
                        for (int i = 0; i < 16; ++i) {
#pragma unroll
                            for (int jj = 0; jj < 4; ++jj) { const float e = __expf(sacc[i][jj] - mx); sacc[i][jj] = e; sm += e; } }
                        sm += __shfl_xor(sm, 16); sm += __shfl_xor(sm, 32); inv = 1.0f / sm;
#pragma unroll
                        for (int s = 0; s < 8; ++s) { u32x4 wv; wv.x = cvt_pk_bf16(sacc[2 * s][0], sacc[2 * s][1]); wv.y = cvt_pk_bf16(sacc[2 * s][2], sacc[2 * s][3]); wv.z = cvt_pk_bf16(sacc[2 * s + 1][0], sacc[2 * s + 1][1]); wv.w = cvt_pk_bf16(sacc[2 * s + 1][2], sacc[2 * s + 1][3]);
                            pk[s] = __builtin_bit_cast(bf16x8, wv); } }
                } else { constexpr int dt = r8 - 4;
#pragma unroll
                    for (int mt = 0; mt < 4; ++mt) { f32x4 o = (f32x4){0.f, 0.f, 0.f, 0.f};
#pragma unroll
                        for (int s = 0; s < 8; ++s) { const u32x2 lo = *(const LAS u32x2*)(buf + (mt * 16 + fr) * 264 + 32 * s + 4 * fq), hi2 = *(const LAS u32x2*)(buf + (mt * 16 + fr) * 264 + 32 * s + 16 + 4 * fq);
                            u32x4 av; av.x = lo.x; av.y = lo.y; av.z = hi2.x; av.w = hi2.y; o = mfma16(__builtin_bit_cast(bf16x8, av), pk[s], o); }
                        u32x2 ow; ow.x = cvt_pk_bf16(o[0] * inv, o[1] * inv); ow.y = cvt_pk_bf16(o[2] * inv, o[3] * inv);
                        *(u32x2*)(oatt + (size_t)qrow * 1024 + h * 256 + dt * 64 + mt * 16 + fq * 4) = ow; } }
            }
        };
        round(std::integral_constant<int, 0>{}); round(std::integral_constant<int, 1>{}); round(std::integral_constant<int, 2>{}); round(std::integral_constant<int, 3>{});
        round(std::integral_constant<int, 4>{}); round(std::integral_constant<int, 5>{}); round(std::integral_constant<int, 6>{}); round(std::integral_constant<int, 7>{});
    }
    __syncthreads();
}

__device__ __forceinline__ void final_norm(const Params& p) {
    const float* ssq = (const float*)(p.ws + W_SSQ) + 6ull * T_ALL; const float* g = p.in[38]; float* y = p.out + OUT_Y;
    int tidl = threadIdx.x; asm volatile("" : "+v"(tidl)); const int lane = tidl & 63, gw = blockIdx.x * 8 + (tidl >> 6), nw = gridDim.x * 8;
    for (int r = gw; r < T_ALL; r += nw) { const float rs = rsqrtf(ssqv(ssq, r) * (1.0f / 1024.0f) + EPS);
#pragma unroll
        for (int i = 0; i < 4; ++i) { const int c = i * 256 + lane * 4; f32x4 x = *(const f32x4*)(y + (size_t)r * 1024 + c); const f32x4 gg = *(const f32x4*)(g + c); x = x * rs * gg; *(f32x4*)(y + (size_t)r * 1024 + c) = x; } }
}

#define XB_TMO      128
#define XB_XCNT(j)  (256  + 64 * (j))
#define XB_XSUB(j)  (1280 + 64 * (j))
#define XB_XGEN(j)  (2304 + 64 * (j))
#define XB_TOP      3328
#define XB_TOPGEN   3392
#define XB_SPIN_CAP (1u << 18)
constexpr int XB_LDS_OFF = LDS_BYTES - 16;
__device__ __forceinline__ unsigned xb_ld(unsigned* p)              { return __hip_atomic_load(p, __ATOMIC_RELAXED, __HIP_MEMORY_SCOPE_AGENT); }
__device__ __forceinline__ unsigned xb_add(unsigned* p, unsigned v) { return __hip_atomic_fetch_add(p, v, __ATOMIC_RELAXED, __HIP_MEMORY_SCOPE_AGENT); }
__device__ __forceinline__ unsigned xb_xcc_id() { return (unsigned)__builtin_amdgcn_s_getreg((3 << 11) | 20) & 0xFu; }
#define XB_SPIN(cond, bar) do { unsigned _sp = 0; while (cond) { __builtin_amdgcn_s_sleep(1); \
    if ((++_sp & 255u) == 0u) { if (xb_ld(&(bar)[XB_TMO])) break; if (_sp > XB_SPIN_CAP) { atomicAdd(&(bar)[XB_TMO], 1u); break; } } } } while (0)
__device__ __forceinline__ void xcd_barrier_post(unsigned* bar) { if (threadIdx.x == 0) (void)xb_add(&bar[XB_XCNT(xb_xcc_id())], 1u); }
__device__ __forceinline__ void xcd_barrier_complete(unsigned* bar, unsigned x, unsigned& nloc, unsigned& nx) {
    const unsigned G = gridDim.x * gridDim.y * gridDim.z;
    unsigned sum, cnt, mine, sp = 0u;
    for (;;) {
        sum = 0u; cnt = 0u; mine = 0u;
#pragma unroll
        for (unsigned j = 0; j < 16; ++j) { const unsigned c = xb_ld(&bar[XB_XCNT(j)]); sum += c; cnt += (c > 0u) ? 1u : 0u; mine = (j == x) ? c : mine; }
        if (sum == G) break;
        __builtin_amdgcn_s_sleep(1);
        if ((++sp & 255u) == 0u) { if (xb_ld(&bar[XB_TMO])) break; if (sp > XB_SPIN_CAP) { atomicAdd(&bar[XB_TMO], 1u); break; } }
    }
    nloc = mine > 0u ? mine : 1u; nx = cnt > 0u ? cnt : 1u;
}
__device__ __forceinline__ void xcd_barrier(unsigned char* ws, LAS unsigned char* lds) {
    asm volatile("s_waitcnt vmcnt(0)" ::: "memory");
    __syncthreads();
    if (threadIdx.x == 0) {
        unsigned* bar = (unsigned*)(ws + W_BAR); volatile LAS unsigned* st = (volatile LAS unsigned*)(lds + XB_LDS_OFF); const unsigned x = xb_xcc_id();
        __builtin_amdgcn_s_waitcnt(0);
        unsigned nloc = st[0], nx = st[1];
        if (nloc == 0u) { xcd_barrier_complete(bar, x, nloc, nx); st[0] = nloc; st[1] = nx; }
        const unsigned old = xb_add(&bar[XB_XSUB(x)], 1u);
        const unsigned gen = old / nloc;
        if (old + 1u == (gen + 1u) * nloc) {
            __builtin_amdgcn_fence(__ATOMIC_RELEASE, "agent");
            asm volatile("s_waitcnt vmcnt(0)" ::: "memory");
            const unsigned og = xb_add(&bar[XB_TOP], 1u);
            const unsigned tg = og / nx;
            if (og + 1u == (tg + 1u) * nx) xb_add(&bar[XB_TOPGEN], 1u);
            else XB_SPIN(xb_ld(&bar[XB_TOPGEN]) == tg, bar);
            __builtin_amdgcn_fence(__ATOMIC_ACQUIRE, "agent");
            xb_add(&bar[XB_XGEN(x)], 1u);
            asm volatile("s_waitcnt vmcnt(0)" ::: "memory");
        } else {
            XB_SPIN(xb_ld(&bar[XB_XGEN(x)]) == gen, bar);
            __builtin_amdgcn_fence(__ATOMIC_ACQUIRE, "agent");
            asm volatile("s_waitcnt vmcnt(0)" ::: "memory");
        }
    }
    __syncthreads();
}

__global__ void __launch_bounds__(512, 2) hybrid_fwd(Params p) {
    extern __shared__ __attribute__((aligned(16))) unsigned char smem[];
    LAS unsigned char* lds = (LAS unsigned char*)smem;
    cg::grid_group grid = cg::this_grid();
    unsigned char* ws = p.ws;
    float* ssq = (float*)(ws + W_SSQ);
    bf16_t* xb = (bf16_t*)(ws + W_XB) + XB_PRE * 1024;
    float* xf = p.out + OUT_Y;
    if (threadIdx.x == 0) { volatile LAS unsigned* st_ = (volatile LAS unsigned*)(lds + XB_LDS_OFF); st_[0] = 0u; st_[1] = 0u; }
    __syncthreads();
    xcd_barrier_post((unsigned*)(ws + W_BAR));

    if (TIMING && blockIdx.x == 0 && threadIdx.x == 0) { unsigned long long* tmr_ = (unsigned long long*)(p.ws + W_SSQ + (7ull * T_ALL + 4096) * 4); for (int i = 0; i < 31; ++i) tmr_[i] = 0ull; tmr_[31] = __builtin_amdgcn_s_memrealtime(); tmr_[30] = tmr_[31]; }
    phase0(p, lds);
    if (p.ws == nullptr) grid.sync();
    xcd_barrier(ws, lds); TMARK(0);
    { EpiKV E{p.out, ssq + 7ull * T_ALL}; pg8::gemm_phase<EpiKV, 0>(lds, (const bf16_t*)(ws + W_MEMB), (const bf16_t*)(ws + W_BKV), 1024, 8, 16, E); }
    xcd_barrier(ws, lds); TMARK(1);
#pragma unroll 1
    for (int l_ = 0; l_ < 2; ++l_) {
        int l = l_; asm volatile("" : "+s"(l));
        { EpiProj E{ws, ssq + (size_t)(3 * l) * T_ALL}; pg8::gemm_phase<EpiProj, 0>(lds, xb, (const bf16_t*)(ws + W_BIN) + (size_t)l * NINP * 1024, 1024, 130, 15, E); }
        if (l == 0) kv_prompt_convert(p, lds);
        xcd_barrier(ws, lds); TMARK(2);
        if (STOP_AFTER <= 1) return;
        gdn_prep(p, l, lds); TMARK(3); rg_prep(p, l, lds); TMARK(4); hgrn_prep(p, l, lds);
        xcd_barrier(ws, lds); TMARK(5);
        if (STOP_AFTER <= 2) return;
        scan_phase(p, l, lds);
        xcd_barrier(ws, lds); TMARK(6);
        if (STOP_AFTER <= 3) return;
        apply_phase(p, l, lds);
        xcd_barrier(ws, lds); TMARK(7);
        if (STOP_AFTER <= 4) return;
        { EpiRes E{nullptr, xb, ssq + (size_t)(3 * l + 1) * T_ALL}; pg8::gemm_phase<EpiRes, 0>(lds, (const bf16_t*)(ws + R_ZBUF), (const bf16_t*)(ws + W_BOUT) + (size_t)l * 1024 * 1024, 1024, 128, 4, E);
          small_gemm<0>((const bf16_t*)(ws + R_ZBUF), (const bf16_t*)(ws + W_BOUT) + (size_t)l * 1024 * 1024, 1024, xb, nullptr, ssq + (size_t)(3 * l + 1) * T_ALL, nullptr); }
        xcd_barrier(ws, lds); TMARK(8);
        { EpiQ E{(bf16_t*)(ws + R_QBUF), ssq + (size_t)(3 * l + 1) * T_ALL}; pg8::gemm_phase<EpiQ, 0>(lds, xb, (const bf16_t*)(ws + W_BQ) + (size_t)l * 1024 * 1024, 1024, 128, 4, E);
          small_gemm<1>(xb, (const bf16_t*)(ws + W_BQ) + (size_t)l * 1024 * 1024, 1024, (bf16_t*)(ws + R_QBUF), nullptr, nullptr, ssq + (size_t)(3 * l + 1) * T_ALL); }
        xcd_barrier(ws, lds); TMARK(9);
        if (STOP_AFTER <= 5) return;
        attn_phase(p, l, lds);
        xcd_barrier(ws, lds); TMARK(10);
        if (STOP_AFTER <= 6) return;
        { EpiRes E{nullptr, xb, ssq + (size_t)(3 * l + 2) * T_ALL}; pg8::gemm_phase<EpiRes, 0>(lds, (const bf16_t*)(ws + R_OATT), (const bf16_t*)(ws + W_BO) + (size_t)l * 1024 * 1024, 1024, 128, 4, E);
          small_gemm<0>((const bf16_t*)(ws + R_OATT), (const bf16_t*)(ws + W_BO) + (size_t)l * 1024 * 1024, 1024, xb, nullptr, ssq + (size_t)(3 * l + 2) * T_ALL, nullptr); }
        xcd_barrier(ws, lds); TMARK(11);
        { EpiUp E{(bf16_t*)(ws + R_ACT), ssq + (size_t)(3 * l + 2) * T_ALL, p.in[35] + (size_t)l * 3 * DFF2, p.in[36] + (size_t)l * DFF2, p.in[9] + (size_t)l * 8 * 2 * DFF2, p.out + OUT_PFC + (size_t)l * 8 * 2 * DFF2, p.out + OUT_SFC + (size_t)l * 8 * 2 * DFF2};
          if (STOP_AFTER <= 7) return;
          pg8::gemm_phase<EpiUp, 1>(lds, xb - 2 * 1024, (const bf16_t*)(ws + W_BUP) + (size_t)l * DFF2 * 1024, 1024, 133, 22, E); }
        xcd_barrier(ws, lds); TMARK(12);
        if (STOP_AFTER <= 8) return;
        { EpiRes E{l == 1 ? xf : nullptr, xb, ssq + (size_t)(3 * l + 3) * T_ALL}; pg8::gemm_phase<EpiRes, 0>(lds, (const bf16_t*)(ws + R_ACT), (const bf16_t*)(ws + W_BDN) + (size_t)l * 1024 * DFF, DFF, 128, 4, E);
          small_gemm<0>((const bf16_t*)(ws + R_ACT), (const bf16_t*)(ws + W_BDN) + (size_t)l * 1024 * DFF, DFF, xb, l == 1 ? xf : nullptr, ssq + (size_t)(3 * l + 3) * T_ALL, nullptr); }
        xcd_barrier(ws, lds); TMARK(13);
    }
    final_norm(p);
    if (TIMING) { xcd_barrier(ws, lds); TMARK(14);
        if (blockIdx.x == 0) { const unsigned long long* tmr_ = (const unsigned long long*)(p.ws + W_SSQ + (7ull * T_ALL + 4096) * 4);
#pragma unroll 1
            for (int k = 0; k < 16; ++k) { unsigned long long d = (k < 15) ? tmr_[(TIMING == 2 && k < 4) ? 20 + k : k] : (tmr_[31] - tmr_[30]); unsigned n = (unsigned)(d / 100ull); if (k == 15) n /= 2; if (n < 1) n = 1; if (n > 4000) n = 4000;
                const size_t off_ = k == 0 ? OUT_Y : k == 1 ? OUT_Y + (size_t)T_P * 1024 : k == 2 ? OUT_PMK : k == 3 ? OUT_PMV : k == 4 ? OUT_PAC : k == 5 ? OUT_PAS : k == 6 ? OUT_PBC : k == 7 ? OUT_PBH : k == 8 ? OUT_PCS : k == 9 ? OUT_PFC : k == 10 ? OUT_SAC : k == 11 ? OUT_SAS : k == 12 ? OUT_SBC : k == 13 ? OUT_SBH : k == 14 ? OUT_SCS : OUT_SFC; unsigned* o = (unsigned*)(p.out + off_); for (unsigned i = threadIdx.x; i < 4096; i += 512) o[i] = (i < n) ? 0xAAAAAAAAu : 0u; } } }
}

extern "C" void kernel_launch(void* const* d_in, const int* in_sizes, int n_in, void* d_out, int out_size, void* d_ws, size_t ws_size, hipStream_t stream) {
    static int grid = 0;
    if (grid == 0) {
        if (n_in != 39 || (size_t)out_size != OUT_TOTAL || ws_size < WS_NEED) { fprintf(stderr, "kernel_launch: unexpected shapes (n_in %d out %d ws %zu need %zu)\n", n_in, out_size, ws_size, (size_t)WS_NEED); grid = -1; return; }
        int dev = 0, cus = 0, per_cu = 0;
        hipGetDevice(&dev); hipDeviceGetAttribute(&cus, hipDeviceAttributeMultiprocessorCount, dev);
        hipFuncSetAttribute((const void*)hybrid_fwd, hipFuncAttributeMaxDynamicSharedMemorySize, LDS_BYTES);
        hipOccupancyMaxActiveBlocksPerMultiprocessor(&per_cu, (const void*)hybrid_fwd, 512, LDS_BYTES);
        if (per_cu < 1) per_cu = 1;
        (void)hipGetLastError();
        grid = cus * 1;
        if (grid > 256) grid = 256;
    }
    if (grid < 0) return;
    Params p{};
    for (int i = 0; i < 39; ++i) p.in[i] = (const float*)d_in[i];
    p.out = (float*)d_out; p.ws = (unsigned char*)d_ws;
    (void)hipMemsetAsync((unsigned char*)d_ws + W_BAR, 0, XCD_BAR_BYTES, stream);
    void* args[] = {&p};
    hipError_t e = hipLaunchCooperativeKernel((const void*)hybrid_fwd, dim3(grid), dim3(512), args, LDS_BYTES, stream);
    if (e != hipSuccess) fprintf(stderr, "cooperative launch failed: %s (grid %d)\n", hipGetErrorString(e), grid);
}
```
